# Optimizing an MI355X kernel written in HIP

```python
import math
import jax, jax.numpy as jnp
from jax import lax
import numpy as np

D_MODEL = 4096
BATCH = 4
SEQ = 2048
DEPTH = 1

MEM_TOKENS = 256
FFN_DIM = 256 * ((8 * D_MODEL // 3 + 255) // 256)
CONV_WIDTH = D_MODEL // 2
CONV_K = 3
DN_HEAD_DIM = 128
DN_HEADS = (D_MODEL // 2) // DN_HEAD_DIM
DN_WIDTH = DN_HEADS * DN_HEAD_DIM
DN_CONV_K = 4
DN_CHUNK = 64
XATTN_HEADS = 4
XATTN_HEAD_DIM = 128
XATTN_WIDTH = XATTN_HEADS * XATTN_HEAD_DIM
EPS = 1e-6
IN_SPLIT_SIZES = (CONV_WIDTH, CONV_WIDTH, CONV_WIDTH, 3 * DN_WIDTH, DN_WIDTH, DN_HEADS, DN_HEADS, D_MODEL, D_MODEL)
IN_PROJ_DIM = 3 * CONV_WIDTH + 4 * DN_WIDTH + 2 * DN_HEADS + 2 * D_MODEL

kernel_name = "hybrid_conv_deltanet_macaron_memxattn"


def rms_norm(x, w):
    xf = x.astype(jnp.float32)
    y = xf * lax.rsqrt(jnp.mean(xf * xf, axis=-1, keepdims=True) + EPS)
    return (y * w.astype(jnp.float32)).astype(x.dtype)


def l2_norm(x):
    xf = x.astype(jnp.float32)
    return xf * lax.rsqrt(jnp.sum(xf * xf, axis=-1, keepdims=True) + EPS)


def swiglu(x, w_gate, w_up, w_down):
    return (jax.nn.silu(x @ w_gate) * (x @ w_up)) @ w_down


def causal_dwconv(x, w):
    K = w.shape[0]
    S = x.shape[1]
    xp = jnp.pad(x, ((0, 0), (K - 1, 0), (0, 0)))
    y = xp[:, 0:S, :] * w[0]
    for i in range(1, K):
        y = y + xp[:, i:i + S, :] * w[i]
    return y


def gated_delta_rule_chunked(q, k, v, g, beta):
    Bsz, S, H, DK = q.shape
    DV = v.shape[-1]
    C = DN_CHUNK
    NC = S // C

    def chunk(t):
        t = t.astype(jnp.float32).reshape((Bsz, NC, C, H) + t.shape[3:])
        return jnp.moveaxis(t, 3, 1)

    q, k, v, g, beta = chunk(q), chunk(k), chunk(v), chunk(g), chunk(beta)
    gc = jnp.cumsum(g, axis=-1)
    idx = jnp.arange(C)
    incl = idx[:, None] >= idx[None, :]
    strict = idx[:, None] > idx[None, :]
    decay = jnp.exp(jnp.where(incl, gc[..., :, None] - gc[..., None, :], -jnp.inf))
    k_beta = k * beta[..., None]
    v_beta = v * beta[..., None]
    L = jnp.where(strict, jnp.einsum('bhnid,bhnjd->bhnij', k_beta, k) * decay, 0.0)
    rhs = jnp.concatenate([v_beta, k_beta * jnp.exp(gc)[..., None]], axis=-1)
    sol = lax.linalg.triangular_solve(L + jnp.eye(C, dtype=jnp.float32), rhs,
                                      left_side=True, lower=True, unit_diagonal=True)
    u_base, w_dec = sol[..., :DV], sol[..., DV:]
    a_qk = jnp.einsum('bhnid,bhnjd->bhnij', q, k) * decay
    q_dec = q * jnp.exp(gc)[..., None]
    k_tail = k * jnp.exp(gc[..., -1:] - gc)[..., None]
    g_last = jnp.exp(gc[..., -1])

    xs = tuple(jnp.moveaxis(t, 2, 0) for t in (u_base, w_dec, a_qk, q_dec, k_tail, g_last))

    def step(state, inp):
        ub, wc, aqk, qd, kt, gl = inp
        u = ub - jnp.einsum('bhck,bhkv->bhcv', wc, state)
        o = jnp.einsum('bhck,bhkv->bhcv', qd, state) + jnp.einsum('bhij,bhjv->bhiv', aqk, u)
        state = state * gl[..., None, None] + jnp.einsum('bhck,bhcv->bhkv', kt, u)
        return state, o

    s0 = jnp.zeros((Bsz, H, DK, DV), jnp.float32)
    _, o = lax.scan(step, s0, xs)
    o = jnp.moveaxis(o, 0, 2).reshape(Bsz, H, S, DV)
    return jnp.transpose(o, (0, 2, 1, 3))


def memory_cross_attention(hn, mn, wq, wk, wv, wo):
    Bsz, S, _ = hn.shape
    M = mn.shape[1]
    qh = (hn @ wq).reshape(Bsz, S, XATTN_HEADS, XATTN_HEAD_DIM)
    kh = (mn @ wk).reshape(Bsz, M, XATTN_HEADS, XATTN_HEAD_DIM)
    vh = (mn @ wv).reshape(Bsz, M, XATTN_HEADS, XATTN_HEAD_DIM)
    scores = jnp.einsum('bshd,bmhd->bhsm', qh.astype(jnp.float32), kh.astype(jnp.float32))
    p = jax.nn.softmax(scores * (XATTN_HEAD_DIM ** -0.5), axis=-1)
    o = jnp.einsum('bhsm,bmhd->bshd', p, vh.astype(jnp.float32)).astype(hn.dtype)
    return o.reshape(Bsz, S, XATTN_WIDTH) @ wo


def setup_inputs(seed: int = 0) -> dict:
    key = jax.random.key(seed)
    ks = jax.random.split(key, 32)

    def dense(k, shape, fan_in):
        return jax.random.normal(k, (DEPTH,) + shape, jnp.float32) * (fan_in ** -0.5)

    def gain(k, n):
        return 1.0 + 0.02 * jax.random.normal(k, (DEPTH, n), jnp.float32)

    dt = jnp.exp(jax.random.uniform(ks[14], (DEPTH, DN_HEADS), jnp.float32,
                                    math.log(1e-3), math.log(1e-1)))
    return {
        "x": jax.random.normal(ks[0], (BATCH, SEQ, D_MODEL), jnp.float32),
        "mem": jax.random.normal(ks[1], (BATCH, MEM_TOKENS, D_MODEL), jnp.float32),
        "ffn1_norm": gain(ks[2], D_MODEL),
        "ffn1_w_gate": dense(ks[3], (D_MODEL, FFN_DIM), D_MODEL),
        "ffn1_w_up": dense(ks[4], (D_MODEL, FFN_DIM), D_MODEL),
        "ffn1_w_down": dense(ks[5], (FFN_DIM, D_MODEL), FFN_DIM),
        "mix_norm": gain(ks[6], D_MODEL),
        "w_in": dense(ks[7], (D_MODEL, IN_PROJ_DIM), D_MODEL),
        "conv_w": dense(ks[8], (CONV_K, CONV_WIDTH), CONV_K),
        "qkv_conv_w": dense(ks[9], (DN_CONV_K, 3 * DN_WIDTH), DN_CONV_K),
        "a_log": jnp.log(jax.random.uniform(ks[10], (DEPTH, DN_HEADS), jnp.float32, 1.0, 16.0)),
        "dt_bias": dt + jnp.log(-jnp.expm1(-dt)),
        "dn_out_norm": gain(ks[11], DN_HEAD_DIM),
        "w_out_conv": dense(ks[12], (CONV_WIDTH, D_MODEL), CONV_WIDTH),
        "w_out_delta": dense(ks[13], (DN_WIDTH, D_MODEL), DN_WIDTH),
        "w_o": dense(ks[15], (D_MODEL, D_MODEL), D_MODEL),
        "xattn_norm": gain(ks[16], D_MODEL),
        "mem_norm": gain(ks[17], D_MODEL),
        "xattn_wq": dense(ks[18], (D_MODEL, XATTN_WIDTH), D_MODEL),
        "xattn_wk": dense(ks[19], (D_MODEL, XATTN_WIDTH), D_MODEL),
        "xattn_wv": dense(ks[20], (D_MODEL, XATTN_WIDTH), D_MODEL),
        "xattn_wo": dense(ks[21], (XATTN_WIDTH, D_MODEL), XATTN_WIDTH),
        "ffn2_norm": gain(ks[22], D_MODEL),
        "ffn2_w_gate": dense(ks[23], (D_MODEL, FFN_DIM), D_MODEL),
        "ffn2_w_up": dense(ks[24], (D_MODEL, FFN_DIM), D_MODEL),
        "ffn2_w_down": dense(ks[25], (FFN_DIM, D_MODEL), FFN_DIM),
        "final_norm": 1.0 + 0.02 * jax.random.normal(ks[26], (D_MODEL,), jnp.float32),
    }


def reference(x, mem, ffn1_norm, ffn1_w_gate, ffn1_w_up, ffn1_w_down, mix_norm, w_in,
              conv_w, qkv_conv_w, a_log, dt_bias, dn_out_norm, w_out_conv, w_out_delta, w_o,
              xattn_norm, mem_norm, xattn_wq, xattn_wk, xattn_wv, xattn_wo,
              ffn2_norm, ffn2_w_gate, ffn2_w_up, ffn2_w_down, final_norm):
    Bsz, S, _ = x.shape
    split_points = [int(v) for v in np.cumsum(IN_SPLIT_SIZES)[:-1]]
    h = x
    for l in range(DEPTH):
        h = h + 0.5 * swiglu(rms_norm(h, ffn1_norm[l]), ffn1_w_gate[l], ffn1_w_up[l], ffn1_w_down[l])

        u = rms_norm(h, mix_norm[l])
        proj = u @ w_in[l]
        c_x, c_c, c_b, qkv, z, b_logit, a_logit, gate_a, gate_b = jnp.split(proj, split_points, axis=-1)

        y_conv = (c_b * causal_dwconv(c_c * c_x, conv_w[l])) @ w_out_conv[l]

        qkv = jax.nn.silu(causal_dwconv(qkv, qkv_conv_w[l]))
        q, k, v = jnp.split(qkv, 3, axis=-1)
        q = l2_norm(q.reshape(Bsz, S, DN_HEADS, DN_HEAD_DIM)) * (DN_HEAD_DIM ** -0.5)
        k = l2_norm(k.reshape(Bsz, S, DN_HEADS, DN_HEAD_DIM))
        v = v.reshape(Bsz, S, DN_HEADS, DN_HEAD_DIM)
        beta = jax.nn.sigmoid(b_logit.astype(jnp.float32))
        g = -jnp.exp(a_log[l].astype(jnp.float32)) * jax.nn.softplus(
            a_logit.astype(jnp.float32) + dt_bias[l].astype(jnp.float32))
        o = gated_delta_rule_chunked(q, k, v, g, beta)
        zf = z.astype(jnp.float32).reshape(Bsz, S, DN_HEADS, DN_HEAD_DIM)
        o = o * lax.rsqrt(jnp.mean(o * o, axis=-1, keepdims=True) + EPS) \
            * dn_out_norm[l].astype(jnp.float32) * jax.nn.silu(zf)
        y_delta = o.reshape(Bsz, S, DN_WIDTH).astype(x.dtype) @ w_out_delta[l]

        merged = jax.nn.sigmoid(gate_a) * y_conv + jax.nn.sigmoid(gate_b) * y_delta
        h = h + merged @ w_o[l]

        h = h + memory_cross_attention(rms_norm(h, xattn_norm[l]), rms_norm(mem, mem_norm[l]),
                                       xattn_wq[l], xattn_wk[l], xattn_wv[l], xattn_wo[l])

        h = h + 0.5 * swiglu(rms_norm(h, ffn2_norm[l]), ffn2_w_gate[l], ffn2_w_up[l], ffn2_w_down[l])
    return rms_norm(h, final_norm)
```

```cpp
#include <hip/hip_runtime.h>
#include <cstdio>
#include <cstdint>
#ifndef MK_N_LAUNCHES
#define MK_N_LAUNCHES 1
#endif
namespace pg8 {
#define PG8_LAS __attribute__((address_space(3)))
typedef unsigned short bf16_t;
typedef short bf16x8 __attribute__((ext_vector_type(8)));
typedef float f32x4 __attribute__((ext_vector_type(4)));
typedef unsigned u32x4 __attribute__((ext_vector_type(4)));
constexpr int BM = 256, BK = 64, HALF = 128, HTB = HALF * BK * 2  , STAGE_BYTES = 8 * HTB, NXCD = 8, WGM = 8;

__host__ __device__ __forceinline__ int lds_byte(int r, int c) { const int st = (r >> 4) * 2 + (c >> 5), rr = r & 15, cc = c & 31, ob = rr * 64 + cc * 2; return st * 1024 + (ob ^ (((ob >> 9) & 1) << 5)); }
__host__ __device__ __forceinline__ void stage_rc(int b, int& R, int& C) { const int st = b / 1024, sb = b % 1024, swz = sb ^ (((sb >> 9) & 1) << 5); R = (st >> 1) * 16 + swz / 64; C = (st & 1) * 32 + (swz % 64) / 2; }
__host__ __device__ __forceinline__ int perm32(int rho) { const int n = rho >> 4, i = rho & 15; return 8 * (i >> 2) + 4 * n + (i & 3); }

struct Unit { int pm, pn; };
struct Gemm { const bf16_t* A; const bf16_t* Bt; int M, N, K, lda, ldb; };

struct StaticOrder {
    int nM, nN, nwg, G, c;
    __host__ __device__ void init(int M, int N, int G_, int c_) { nM = M / BM; nN = N / BM; nwg = nM * nN; G = G_; c = c_; }
    __host__ __device__ bool next(int i, Unit& u) const {
        const long L = (long)i * G + c; if (L >= nwg) return false;
        int wgid = (int)L; { const int q = nwg / NXCD, r = nwg % NXCD, xcd = wgid % NXCD, off = wgid / NXCD; wgid = (xcd < r ? xcd * (q + 1) : r * (q + 1) + (xcd - r) * q) + off; }
        const int nig = WGM * nN, gid = wgid / nig, fm = gid * WGM, gsz = (nM - fm) < WGM ? (nM - fm) : WGM;
        u.pm = fm + ((wgid % nig) % gsz); u.pn = (wgid % nig) / gsz; return true;
    }
    __device__ __forceinline__ void a_ready(const Unit&) const {}
    __device__ __forceinline__ void done(const Unit&) const {}
};

__device__ __forceinline__ unsigned cvt_pk_bf16(float lo, float hi) { unsigned r; asm volatile("v_cvt_pk_bf16_f32 %0, %1, %2" : "=v"(r) : "v"(lo), "v"(hi)); return r; }
__device__ __forceinline__ float bf_lo(unsigned w) { return __uint_as_float(w << 16); }
__device__ __forceinline__ float bf_hi(unsigned w) { return __uint_as_float(w & 0xffff0000u); }
__device__ __forceinline__ float fast_sigmoid(float x) { return __builtin_amdgcn_rcpf(1.0f + __builtin_amdgcn_exp2f(-1.4426950408889634f * x)); }
__device__ __forceinline__ float fast_silu(float x) { return x * fast_sigmoid(x); }

struct EpiSwiGLU {
    static constexpr bool PERM = true, AFTER_DRAIN = false;
    bf16_t* O; int ldc;
    __device__ __forceinline__ void operator()(const f32x4 (&acc)[2][2][4][2], const Unit& u, int wr, int wc, int fr, int fq) const {
        const int row0 = u.pm * BM + wr * 64 + fr, col0 = u.pn * HALF + wc * 32 + 8 * fq;
#pragma unroll
        for (int ai = 0; ai < 2; ++ai)
#pragma unroll
            for (int m = 0; m < 4; ++m) { bf16_t* rowp = O + (size_t)(row0 + ai * HALF + m * 16) * ldc + col0;
                const f32x4 g0 = acc[ai][0][m][0], g1 = acc[ai][0][m][1], u0 = acc[ai][1][m][0], u1 = acc[ai][1][m][1];
                f32x4 v0, v1;
#pragma unroll
                for (int j = 0; j < 4; ++j) { v0[j] = fast_silu(g0[j]) * u0[j]; v1[j] = fast_silu(g1[j]) * u1[j]; }
                u32x4 w; w.x = cvt_pk_bf16(v0[0], v0[1]); w.y = cvt_pk_bf16(v0[2], v0[3]); w.z = cvt_pk_bf16(v1[0], v1[1]); w.w = cvt_pk_bf16(v1[2], v1[3]);
                *(u32x4*)rowp = w; }
    }
};
struct EpiResid {
    static constexpr bool PERM = false, AFTER_DRAIN = false;
    const float* base; float* out; int ldc; float alpha;
    __device__ __forceinline__ void operator()(const f32x4 (&acc)[2][2][4][2], const Unit& u, int wr, int wc, int fr, int fq) const {
        const int row0 = u.pm * BM + wr * 64 + fr, col0 = u.pn * BM + wc * 32 + 4 * fq;
#pragma unroll
        for (int ai = 0; ai < 2; ++ai)
#pragma unroll
            for (int m = 0; m < 4; ++m) { const size_t off = (size_t)(row0 + ai * HALF + m * 16) * ldc + col0;
#pragma unroll
                for (int bj = 0; bj < 2; ++bj)
#pragma unroll
                    for (int n = 0; n < 2; ++n) { const f32x4 b = *(const f32x4*)(base + off + bj * HALF + n * 16); *(f32x4*)(out + off + bj * HALF + n * 16) = b + acc[ai][bj][m][n] * alpha; } }
    }
};
struct EpiStoreBf16 {
    static constexpr bool PERM = true, AFTER_DRAIN = false;
    bf16_t* O; int ldc; float scale;
    __device__ __forceinline__ void operator()(const f32x4 (&acc)[2][2][4][2], const Unit& u, int wr, int wc, int fr, int fq) const {
        const int row0 = u.pm * BM + wr * 64 + fr, col0 = u.pn * BM + wc * 32 + 8 * fq;
#pragma unroll
        for (int ai = 0; ai < 2; ++ai)
#pragma unroll
            for (int m = 0; m < 4; ++m) { bf16_t* rowp = O + (size_t)(row0 + ai * HALF + m * 16) * ldc + col0;
#pragma unroll
                for (int bj = 0; bj < 2; ++bj) { const f32x4 v0 = acc[ai][bj][m][0] * scale, v1 = acc[ai][bj][m][1] * scale;
                    u32x4 w; w.x = cvt_pk_bf16(v0[0], v0[1]); w.y = cvt_pk_bf16(v0[2], v0[3]); w.z = cvt_pk_bf16(v1[0], v1[1]); w.w = cvt_pk_bf16(v1[2], v1[3]);
                    *(u32x4*)(rowp + bj * HALF) = w; } }
    }
};
struct EpiKV {
    static constexpr bool PERM = true, AFTER_DRAIN = false;
    bf16_t* KB; bf16_t* VT;
    __device__ __forceinline__ void operator()(const f32x4 (&acc)[2][2][4][2], const Unit& u, int wr, int wc, int fr, int fq) const {
        const int rl0 = wr * 64 + fr;
        if (u.pn < 2) {
            const int col0 = u.pn * BM + wc * 32 + 8 * fq;
#pragma unroll
            for (int ai = 0; ai < 2; ++ai)
#pragma unroll
                for (int m = 0; m < 4; ++m) { bf16_t* rowp = KB + (size_t)(u.pm * BM + rl0 + ai * HALF + m * 16) * 512 + col0;
#pragma unroll
                    for (int bj = 0; bj < 2; ++bj) { const f32x4 v0 = acc[ai][bj][m][0], v1 = acc[ai][bj][m][1];
                        u32x4 w; w.x = cvt_pk_bf16(v0[0], v0[1]); w.y = cvt_pk_bf16(v0[2], v0[3]); w.z = cvt_pk_bf16(v1[0], v1[1]); w.w = cvt_pk_bf16(v1[2], v1[3]);
                        *(u32x4*)(rowp + bj * HALF) = w; } }
        } else {
            const int colv0 = (u.pn - 2) * BM + wc * 32 + 8 * fq;
#pragma unroll
            for (int ai = 0; ai < 2; ++ai)
#pragma unroll
                for (int m = 0; m < 4; ++m) { const int key = rl0 + ai * HALF + m * 16;
#pragma unroll
                    for (int bj = 0; bj < 2; ++bj)
#pragma unroll
                        for (int n = 0; n < 2; ++n)
#pragma unroll
                            for (int e = 0; e < 4; ++e) { const int cv = colv0 + bj * HALF + 4 * n + e;
                                VT[((size_t)u.pm * 512 + cv) * 256 + key] = (bf16_t)(cvt_pk_bf16(acc[ai][bj][m][n][e], 0.f) & 0xffffu); } }
        }
    }
};
struct EpiGateA {
    static constexpr bool PERM = true, AFTER_DRAIN = false;
    float* T; int ldc; const bf16_t* G; int ldg;
    __device__ __forceinline__ void operator()(const f32x4 (&acc)[2][2][4][2], const Unit& u, int wr, int wc, int fr, int fq) const {
        const int row0 = u.pm * BM + wr * 64 + fr, col0 = u.pn * BM + wc * 32 + 8 * fq;
#pragma unroll
        for (int ai = 0; ai < 2; ++ai)
#pragma unroll
            for (int m = 0; m < 4; ++m) { const size_t row = (size_t)(row0 + ai * HALF + m * 16);
#pragma unroll
                for (int bj = 0; bj < 2; ++bj) { const int c = col0 + bj * HALF; const u32x4 gw = *(const u32x4*)(G + row * ldg + c);
                    f32x4 v0 = acc[ai][bj][m][0], v1 = acc[ai][bj][m][1];
                    v0[0] *= fast_sigmoid(bf_lo(gw.x)); v0[1] *= fast_sigmoid(bf_hi(gw.x)); v0[2] *= fast_sigmoid(bf_lo(gw.y)); v0[3] *= fast_sigmoid(bf_hi(gw.y));
                    v1[0] *= fast_sigmoid(bf_lo(gw.z)); v1[1] *= fast_sigmoid(bf_hi(gw.z)); v1[2] *= fast_sigmoid(bf_lo(gw.w)); v1[3] *= fast_sigmoid(bf_hi(gw.w));
                    *(f32x4*)(T + row * ldc + c) = v0; *(f32x4*)(T + row * ldc + c + 4) = v1; } }
    }
};
struct EpiGateB {
    static constexpr bool PERM = true, AFTER_DRAIN = false;
    const float* T; bf16_t* O; int ldc; const bf16_t* G; int ldg;
    __device__ __forceinline__ void operator()(const f32x4 (&acc)[2][2][4][2], const Unit& u, int wr, int wc, int fr, int fq) const {
        const int row0 = u.pm * BM + wr * 64 + fr, col0 = u.pn * BM + wc * 32 + 8 * fq;
#pragma unroll
        for (int ai = 0; ai < 2; ++ai)
#pragma unroll
            for (int m = 0; m < 4; ++m) { const size_t row = (size_t)(row0 + ai * HALF + m * 16);
#pragma unroll
                for (int bj = 0; bj < 2; ++bj) { const int c = col0 + bj * HALF; const u32x4 gw = *(const u32x4*)(G + row * ldg + c);
                    const f32x4 t0 = *(const f32x4*)(T + row * ldc + c), t1 = *(const f32x4*)(T + row * ldc + c + 4);
                    f32x4 v0 = acc[ai][bj][m][0], v1 = acc[ai][bj][m][1];
                    v0[0] = t0[0] + v0[0] * fast_sigmoid(bf_lo(gw.x)); v0[1] = t0[1] + v0[1] * fast_sigmoid(bf_hi(gw.x)); v0[2] = t0[2] + v0[2] * fast_sigmoid(bf_lo(gw.y)); v0[3] = t0[3] + v0[3] * fast_sigmoid(bf_hi(gw.y));
                    v1[0] = t1[0] + v1[0] * fast_sigmoid(bf_lo(gw.z)); v1[1] = t1[1] + v1[1] * fast_sigmoid(bf_hi(gw.z)); v1[2] = t1[2] + v1[2] * fast_sigmoid(bf_lo(gw.w)); v1[3] = t1[3] + v1[3] * fast_sigmoid(bf_hi(gw.w));
                    u32x4 w; w.x = cvt_pk_bf16(v0[0], v0[1]); w.y = cvt_pk_bf16(v0[2], v0[3]); w.z = cvt_pk_bf16(v1[0], v1[1]); w.w = cvt_pk_bf16(v1[2], v1[3]);
                    *(u32x4*)(O + row * ldc + c) = w; } }
    }
};


template <class Epi, class Sched, bool ALIGN_EPI = false, bool SP2 = false>
__device__ __forceinline__ void gemm_phase(PG8_LAS unsigned char* lds, const Gemm g, const Sched& S, const Epi& E) {
    const int tid = threadIdx.x, wid = __builtin_amdgcn_readfirstlane(tid >> 6), lane = tid & 63, wr = wid >> 2, wc = wid & 3, fr = lane & 15, fq = lane >> 4;
    const int K = g.K, nt = K / BK;
    unsigned voffA[2], voffB[2];
#pragma unroll
    for (int i = 0; i < 2; ++i) { int R, C; stage_rc(tid * 16 + i * 8192, R, C); const int Rb = Epi::PERM ? ((R & ~31) + perm32(R & 31)) : R;
        voffA[i] = (unsigned)(R * g.lda + C) * 2u; voffB[i] = (unsigned)(Rb * g.ldb + C) * 2u; }
    const size_t kstep = (size_t)(BK * 2);
    const size_t hstepA = (size_t)HALF * g.lda * 2, hstepB = (size_t)HALF * g.ldb * 2;
    const size_t tstepA = 2 * hstepA, tstepB = 2 * hstepB;
    const unsigned ldsw = (unsigned)wid * 1024u;
    const int aoff = lds_byte(wr * 64 + fr, fq * 8), boff = lds_byte(wc * 32 + fr, fq * 8);
#define PG8_SA(b, h) (((b) * 2 + (h)) * HTB)
#define PG8_SB(b, h) ((4 + (b) * 2 + (h)) * HTB)
#define PG8_STAGE(bufoff, gbase, voff) do { _Pragma("unroll") for (int _i = 0; _i < 2; ++_i) \
        __builtin_amdgcn_global_load_lds((const unsigned*)((const char*)(gbase) + (voff)[_i]), (PG8_LAS unsigned*)(lds + (bufoff) + ldsw + _i * 8192), 16, 0, 0); } while (0)
#define PG8_LDA(dst, b, h) do { _Pragma("unroll") for (int m = 0; m < 4; ++m) _Pragma("unroll") for (int k = 0; k < 2; ++k) dst[m][k] = *(const PG8_LAS bf16x8*)(lds + PG8_SA(b, h) + aoff + m * 2048 + k * 1024); } while (0)
#define PG8_LDB(dst, b, h) do { _Pragma("unroll") for (int n = 0; n < 2; ++n) _Pragma("unroll") for (int k = 0; k < 2; ++k) dst[n][k] = *(const PG8_LAS bf16x8*)(lds + PG8_SB(b, h) + boff + n * 2048 + k * 1024); } while (0)
#define PG8_MMA(ai, bj, At, Bt) do { __builtin_amdgcn_s_setprio(1); _Pragma("unroll") for (int m = 0; m < 4; ++m) _Pragma("unroll") for (int n = 0; n < 2; ++n) _Pragma("unroll") for (int k = 0; k < 2; ++k) \
        acc[ai][bj][m][n] = __builtin_amdgcn_mfma_f32_16x16x32_bf16(Bt[n][k], At[m][k], acc[ai][bj][m][n], 0, 0, 0); __builtin_amdgcn_s_setprio(0); } while (0)
#define PG8_WAIT_V(n) asm volatile("s_waitcnt vmcnt(" #n ")" ::: "memory")
#define PG8_WAIT_L(n) asm volatile("s_waitcnt lgkmcnt(" #n ")" ::: "memory")
#define PG8_BAR __builtin_amdgcn_s_barrier()
#define PG8_SCHED __builtin_amdgcn_sched_barrier(0)
    Unit cur, nxt; int ui = 0;
    if (!S.next(0, cur)) return;
    f32x4 acc[2][2][4][2];
#pragma unroll
    for (int a = 0; a < 2; ++a)
#pragma unroll
        for (int b = 0; b < 2; ++b)
#pragma unroll
            for (int m = 0; m < 4; ++m)
#pragma unroll
                for (int n = 0; n < 2; ++n) acc[a][b][m][n] = (f32x4){0.f, 0.f, 0.f, 0.f};
    bf16x8 At[4][2], B0[2][2], B1[2][2];
    const char* cA = (const char*)g.A + (size_t)cur.pm * tstepA; const char* cB = (const char*)g.Bt + (size_t)cur.pn * tstepB;
    S.a_ready(cur);
    if constexpr (SP2) {
        PG8_STAGE(PG8_SB(0, 0), cB, voffB); PG8_STAGE(PG8_SB(0, 1), cB + hstepB, voffB); PG8_STAGE(PG8_SA(0, 0), cA, voffA); PG8_STAGE(PG8_SA(0, 1), cA + hstepA, voffA);
        if (wr == 1) PG8_BAR;
        PG8_WAIT_V(2); PG8_BAR;
        PG8_STAGE(PG8_SB(1, 0), cB + kstep, voffB); PG8_STAGE(PG8_SA(1, 0), cA + kstep, voffA); PG8_STAGE(PG8_SB(1, 1), cB + hstepB + kstep, voffB);
        PG8_WAIT_V(6); PG8_BAR;
    } else {
        PG8_STAGE(PG8_SB(0, 0), cB, voffB); PG8_STAGE(PG8_SA(0, 0), cA, voffA); PG8_STAGE(PG8_SB(0, 1), cB + hstepB, voffB); PG8_STAGE(PG8_SA(0, 1), cA + hstepA, voffA);
        if (wr == 1) PG8_BAR;
        PG8_WAIT_V(4); PG8_BAR;
        PG8_STAGE(PG8_SB(1, 0), cB + kstep, voffB); PG8_STAGE(PG8_SA(1, 0), cA + kstep, voffA); PG8_STAGE(PG8_SB(1, 1), cB + hstepB + kstep, voffB);
        PG8_WAIT_V(6); PG8_BAR;
    }
    for (;;) {
        const bool has_next = S.next(ui + 1, nxt);
        const char* nA = has_next ? (const char*)g.A + (size_t)nxt.pm * tstepA : cA; const char* nB = has_next ? (const char*)g.Bt + (size_t)nxt.pn * tstepB : cB;
        for (int t = 0; t < nt; t += 2) {
            const bool last = (t == nt - 2);
            const char* a1 = cA + (size_t)(t + 1) * kstep;
            const char* a2 = last ? nA : cA + (size_t)(t + 2) * kstep; const char* b2 = last ? nB : cB + (size_t)(t + 2) * kstep;
            const char* a3 = a2 + kstep; const char* b3 = b2 + kstep;
            if (last && has_next) S.a_ready(nxt);
            if constexpr (SP2) {
            PG8_LDB(B0, 0, 0); PG8_LDB(B1, 0, 1); PG8_SCHED; PG8_LDA(At, 0, 0); PG8_STAGE(PG8_SA(1, 1), a1 + hstepA, voffA);
            PG8_WAIT_V(8); PG8_WAIT_L(0); PG8_BAR; PG8_MMA(0, 0, At, B0); PG8_MMA(0, 1, At, B1); PG8_BAR; PG8_SCHED;
            PG8_LDA(At, 0, 1); PG8_STAGE(PG8_SB(0, 0), b2, voffB); PG8_STAGE(PG8_SB(0, 1), b2 + hstepB, voffB); PG8_STAGE(PG8_SA(0, 0), a2, voffA);
            PG8_WAIT_V(8); PG8_WAIT_L(0); PG8_BAR; PG8_MMA(1, 0, At, B0); PG8_MMA(1, 1, At, B1); PG8_BAR; PG8_SCHED;
            PG8_LDB(B0, 1, 0); PG8_LDB(B1, 1, 1); PG8_SCHED; PG8_LDA(At, 1, 0); PG8_STAGE(PG8_SA(0, 1), a2 + hstepA, voffA);
            PG8_WAIT_V(8); PG8_WAIT_L(0); PG8_BAR; PG8_MMA(0, 0, At, B0); PG8_MMA(0, 1, At, B1); PG8_BAR; PG8_SCHED;
            PG8_LDA(At, 1, 1); PG8_STAGE(PG8_SB(1, 0), b3, voffB); PG8_STAGE(PG8_SB(1, 1), b3 + hstepB, voffB); PG8_STAGE(PG8_SA(1, 0), a3, voffA);
            PG8_WAIT_V(8); PG8_WAIT_L(0); PG8_BAR; PG8_MMA(1, 0, At, B0); PG8_MMA(1, 1, At, B1); PG8_BAR; PG8_SCHED;
            } else {
            PG8_LDB(B0, 0, 0); PG8_SCHED; PG8_LDA(At, 0, 0); PG8_STAGE(PG8_SA(1, 1), a1 + hstepA, voffA);
            PG8_WAIT_L(8); PG8_BAR; PG8_WAIT_L(0); PG8_MMA(0, 0, At, B0); PG8_BAR; PG8_SCHED;
            PG8_LDB(B1, 0, 1); PG8_STAGE(PG8_SB(0, 0), b2, voffB);
            PG8_BAR; PG8_WAIT_L(0); PG8_MMA(0, 1, At, B1); PG8_BAR;
            PG8_LDA(At, 0, 1); PG8_STAGE(PG8_SA(0, 0), a2, voffA);
            PG8_BAR; PG8_WAIT_L(0); PG8_MMA(1, 0, At, B0); PG8_BAR; PG8_SCHED;
            PG8_STAGE(PG8_SB(0, 1), b2 + hstepB, voffB);
            PG8_WAIT_V(6); PG8_BAR; PG8_MMA(1, 1, At, B1); PG8_BAR;
            PG8_LDB(B0, 1, 0); PG8_SCHED; PG8_LDA(At, 1, 0); PG8_STAGE(PG8_SA(0, 1), a2 + hstepA, voffA);
            PG8_WAIT_L(8); PG8_BAR; PG8_WAIT_L(0); PG8_MMA(0, 0, At, B0); PG8_BAR; PG8_SCHED;
            PG8_LDB(B1, 1, 1); PG8_STAGE(PG8_SB(1, 0), b3, voffB);
            PG8_BAR; PG8_WAIT_L(0); PG8_MMA(0, 1, At, B1); PG8_BAR;
            PG8_LDA(At, 1, 1); PG8_STAGE(PG8_SA(1, 0), a3, voffA);
            PG8_BAR; PG8_WAIT_L(0); PG8_MMA(1, 0, At, B0); PG8_BAR; PG8_SCHED;
            PG8_STAGE(PG8_SB(1, 1), b3 + hstepB, voffB);
            PG8_WAIT_V(6); PG8_BAR; PG8_MMA(1, 1, At, B1); PG8_BAR;
            }
        }
        if constexpr (ALIGN_EPI) { if (wr == 0) PG8_BAR; }
        if constexpr (!Epi::AFTER_DRAIN) { E(acc, cur, wr, wc, fr, fq); S.done(cur); }
        if (!has_next) break;
#pragma unroll
        for (int a = 0; a < 2; ++a)
#pragma unroll
            for (int b = 0; b < 2; ++b)
#pragma unroll
                for (int m = 0; m < 4; ++m)
#pragma unroll
                    for (int n = 0; n < 2; ++n) acc[a][b][m][n] = (f32x4){0.f, 0.f, 0.f, 0.f};
        cur = nxt; cA = nA; cB = nB; ++ui;
        if constexpr (ALIGN_EPI) { if (wr == 1) PG8_BAR; }
    }
    PG8_WAIT_V(0);
    if constexpr (!ALIGN_EPI) { if (wr == 0) PG8_BAR; }
    PG8_BAR;
    if constexpr (Epi::AFTER_DRAIN) { E.fused(acc, cur, wr, wc, fr, fq, lds, wid, lane); S.done(cur); }
#undef PG8_SA
#undef PG8_SB
#undef PG8_STAGE
#undef PG8_LDA
#undef PG8_LDB
#undef PG8_MMA
#undef PG8_WAIT_V
#undef PG8_WAIT_L
#undef PG8_BAR
#undef PG8_SCHED
}
}
#define GAS __attribute__((address_space(1)))
#define LAS __attribute__((address_space(3)))
typedef unsigned short bf16;
typedef unsigned v4u __attribute__((ext_vector_type(4)));
typedef float f32x4 __attribute__((ext_vector_type(4)));
typedef short bf16x8 __attribute__((ext_vector_type(8)));
typedef GAS unsigned gu32;
typedef GAS unsigned long long gu64;
#define RLX_AGENT __ATOMIC_RELAXED, __HIP_MEMORY_SCOPE_AGENT
#define LDS_WAIT() asm volatile("s_waitcnt lgkmcnt(0)" ::: "memory")
#define VM_WAIT() asm volatile("s_waitcnt vmcnt(0)" ::: "memory")
__device__ __forceinline__ unsigned long long rt() { return __builtin_amdgcn_s_memrealtime(); }
__device__ __forceinline__ unsigned f2bf(float f) { unsigned u = __builtin_bit_cast(unsigned, f); return (u + 0x7fffu + ((u >> 16) & 1u)) >> 16; }
__device__ __forceinline__ unsigned pk2(float lo, float hi) { return f2bf(lo) | (f2bf(hi) << 16); }

#define XB_TMO      128
#define XB_XCNT(j)  (256  + 64 * (j))
#define XB_XSUB(j)  (1280 + 64 * (j))
#define XB_XGEN(j)  (2304 + 64 * (j))
#define XB_TOP      3328
#define XB_TOPGEN   3392
#define XCD_BAR_WORDS 3456
#define XB_SPIN_CAP (1u << 18)

__device__ __forceinline__ unsigned xb_ld(unsigned* p)              { return __hip_atomic_load(p, __ATOMIC_RELAXED, __HIP_MEMORY_SCOPE_AGENT); }
__device__ __forceinline__ unsigned xb_add(unsigned* p, unsigned v) { return __hip_atomic_fetch_add(p, v, __ATOMIC_RELAXED, __HIP_MEMORY_SCOPE_AGENT); }
__device__ __forceinline__ unsigned xb_xcc_id() { return (unsigned)__builtin_amdgcn_s_getreg((3 << 11) | 20) & 0xFu; }
#define XB_SPIN(cond, bar) do { unsigned _sp = 0; while (cond) { __builtin_amdgcn_s_sleep(1); \
    if ((++_sp & 255u) == 0u) { if (xb_ld(&(bar)[XB_TMO])) break; if (_sp > XB_SPIN_CAP) { atomicAdd(&(bar)[XB_TMO], 1u); break; } } } } while (0)

struct XcdBarrier {
    unsigned* bar; unsigned x;
    volatile LAS unsigned* st;
};

__device__ __forceinline__ XcdBarrier xcd_barrier_post(unsigned* bar, volatile LAS unsigned* st) {
    XcdBarrier b; b.bar = bar; b.x = xb_xcc_id(); b.st = st;
    if (threadIdx.x == 0) (void)xb_add(&bar[XB_XCNT(b.x)], 1u);
    return b;
}
__device__ __forceinline__ void xcd_barrier_complete(unsigned* bar, unsigned x, unsigned& nloc, unsigned& nx) {
    const unsigned G = gridDim.x * gridDim.y * gridDim.z;
    unsigned sum, cnt, mine, sp = 0u;
    for (;;) {
        sum = 0u; cnt = 0u; mine = 0u;
#pragma unroll
        for (unsigned j = 0; j < 16; ++j) { const unsigned c = xb_ld(&bar[XB_XCNT(j)]); sum += c; cnt += (c > 0u) ? 1u : 0u; mine = (j == x) ? c : mine; }
        if (sum == G) break;
        __builtin_amdgcn_s_sleep(1);
        if ((++sp & 255u) == 0u) { if (xb_ld(&bar[XB_TMO])) break; if (sp > XB_SPIN_CAP) { atomicAdd(&bar[XB_TMO], 1u); break; } }
    }
    nloc = mine > 0u ? mine : 1u; nx = cnt > 0u ? cnt : 1u;
}

__device__ __forceinline__ void xcd_barrier(const XcdBarrier& b) {
    asm volatile("s_waitcnt vmcnt(0)" ::: "memory");
    __syncthreads();
    if (threadIdx.x == 0) {
        unsigned* bar = b.bar;
        __builtin_amdgcn_s_waitcnt(0);
        unsigned nloc = b.st[0], nx = b.st[1];
        if (nloc == 0u) { xcd_barrier_complete(bar, b.x, nloc, nx); b.st[0] = nloc; b.st[1] = nx; }
        const unsigned old = xb_add(&bar[XB_XSUB(b.x)], 1u);
        const unsigned gen = old / nloc;
        if (old + 1u == (gen + 1u) * nloc) {
            __builtin_amdgcn_fence(__ATOMIC_RELEASE, "agent");
            asm volatile("s_waitcnt vmcnt(0)" ::: "memory");
            const unsigned og = xb_add(&bar[XB_TOP], 1u);
            const unsigned tg = og / nx;
            if (og + 1u == (tg + 1u) * nx) xb_add(&bar[XB_TOPGEN], 1u);
            else XB_SPIN(xb_ld(&bar[XB_TOPGEN]) == tg, bar);
            __builtin_amdgcn_fence(__ATOMIC_ACQUIRE, "agent");
            xb_add(&bar[XB_XGEN(b.x)], 1u);
            asm volatile("s_waitcnt vmcnt(0)" ::: "memory");
        } else {
            XB_SPIN(xb_ld(&bar[XB_XGEN(b.x)]) == gen, bar);
            __builtin_amdgcn_fence(__ATOMIC_ACQUIRE, "agent");
            asm volatile("s_waitcnt vmcnt(0)" ::: "memory");
        }
    }
    __syncthreads();
}

constexpr int NWAVES = 8, NTHREADS = NWAVES * 64;
constexpr int BATCH = 4, SEQ = 2048, D = 4096, FF = 11008, M = BATCH * SEQ;
constexpr int CW = 2048, DNW = 2048, NH = 16, HD = 128, CH = 64, NCH = SEQ / CH;
constexpr int NPROJ = 22560, NPP = 22784;
constexpr int OFF_CX = 0, OFF_CC = 2048, OFF_CB = 4096, OFF_Q = 6144, OFF_Z = 12288, OFF_BL = 14336, OFF_AL = 14352, OFF_GA = 14368, OFF_GB = 18464;
constexpr int MEMT = 256, XW = 512;
constexpr float EPS = 1e-6f;
constexpr int NPH = 20;

constexpr size_t MiB = 1u << 20;
constexpr size_t WS_CTL = 0, CTL_ZERO_BYTES = 1 * MiB;
constexpr size_t WS_W1GU = 1 * MiB, WS_W1D = 173 * MiB, WS_W2GU = 259 * MiB, WS_W2D = 431 * MiB, WS_WIN = 517 * MiB;
constexpr size_t WS_WA = 695 * MiB, WS_WB = 711 * MiB, WS_WO = 727 * MiB, WS_WQ = 759 * MiB, WS_WKV = 763 * MiB, WS_WXO = 771 * MiB;
constexpr size_t WS_XN = 775 * MiB;
constexpr size_t WS_R = 839 * MiB;
constexpr size_t WS_DN = 1195 * MiB;
constexpr size_t WS_WC = WS_DN, WS_UB = WS_DN + 64 * MiB, WS_QD = WS_DN + 128 * MiB, WS_KTT = WS_DN + 192 * MiB, WS_AQK = WS_DN + 256 * MiB, WS_GL = WS_DN + 288 * MiB;
constexpr size_t WS_TMP = WS_DN;
constexpr size_t WS_MN = 1484 * MiB, WS_KB = 1492 * MiB, WS_VT = 1493 * MiB, WS_END = 1494 * MiB;
constexpr size_t WS_O = WS_W1GU, WS_CONVA = WS_W1GU + 64 * MiB, WS_ON = WS_W1GU + 96 * MiB, WS_XQ = WS_W1GU + 128 * MiB, WS_XO = WS_W1GU + 136 * MiB;
constexpr int CW_TMO = 0, CW_BAR = 4096;
constexpr int RING_BYTES = 131072;
constexpr int ATT_LDS = 256 * 272 + 128 * 528;
constexpr int MISC_OFF = 147456;
constexpr int LDS_BYTES = 151552;
static_assert(ATT_LDS <= MISC_OFF && MISC_OFF + 128 <= LDS_BYTES, "LDS map");

__device__ __forceinline__ float bfl(unsigned w) { return __uint_as_float(w << 16); }
__device__ __forceinline__ float bfh(unsigned w) { return __uint_as_float(w & 0xffff0000u); }
__device__ __forceinline__ float bf1(bf16 v) { return __uint_as_float(((unsigned)v) << 16); }
__device__ __forceinline__ float sigm(float x) { return __builtin_amdgcn_rcpf(1.0f + __builtin_amdgcn_exp2f(-1.4426950408889634f * x)); }
__device__ __forceinline__ float wave_sum(float v) {
#pragma unroll
    for (int o = 1; o < 64; o <<= 1) v += __shfl_xor(v, o);
    return v;
}

__device__ __forceinline__ void transpose_weight(const float* W, int K, int N, bf16* WT, int ldk, int mode, int roff, LAS float* scr, int gw, int NGW, int lane) {
    const int nblk = N / 32, nitems = (K / 64) * nblk;
    for (int item = gw; item < nitems; item += NGW) {
        const int kb = item / nblk, nb = item - kb * nblk, k0 = 64 * kb, n0 = 32 * nb;
        const int drow0 = (mode == 0) ? (roff + n0) : (256 * (n0 >> 7) + 128 * (mode - 1) + (n0 & 127));
#pragma unroll 8
        for (int i = 0; i < 32; ++i) { const int kk = 2 * i + (lane >> 5); scr[kk * 33 + (lane & 31)] = W[(size_t)(k0 + kk) * N + n0 + (lane & 31)]; }
        LDS_WAIT(); asm volatile("" ::: "memory");
        const int c = lane & 7;
#pragma unroll
        for (int j = 0; j < 4; ++j) { const int n = (lane >> 3) + 8 * j; const LAS float* s = scr + (8 * c) * 33 + n;
            v4u o; o.x = pk2(s[0 * 33], s[1 * 33]); o.y = pk2(s[2 * 33], s[3 * 33]); o.z = pk2(s[4 * 33], s[5 * 33]); o.w = pk2(s[6 * 33], s[7 * 33]);
            *(v4u*)(WT + (size_t)(drow0 + n) * ldk + k0 + 8 * c) = o; }
        LDS_WAIT(); asm volatile("" ::: "memory");
    }
}
template <bool OUT_F32>
__device__ __forceinline__ void rms_rows(const float* X, const float* w, void* out, int nrows, int gw, int NGW, int lane) {
    for (int m = gw; m < nrows; m += NGW) {
        const f32x4* xr = (const f32x4*)(X + (size_t)m * D) + lane;
        f32x4 v[16]; float s = 0.f;
#pragma unroll
        for (int j = 0; j < 16; ++j) { v[j] = xr[64 * j]; s += (v[j].x * v[j].x + v[j].y * v[j].y) + (v[j].z * v[j].z + v[j].w * v[j].w); }
        const float rstd = 1.0f / sqrtf(wave_sum(s) * (1.0f / D) + EPS);
        const f32x4* wr = (const f32x4*)w + lane;
        if (OUT_F32) { f32x4* o = (f32x4*)((float*)out + (size_t)m * D) + lane;
#pragma unroll
            for (int j = 0; j < 16; ++j) { const f32x4 g = wr[64 * j]; o[64 * j] = v[j] * rstd * g; }
        } else { unsigned long long* o8 = (unsigned long long*)((bf16*)out + (size_t)m * D) + lane;
#pragma unroll
            for (int j = 0; j < 16; ++j) { const f32x4 g = wr[64 * j]; const f32x4 y = v[j] * rstd * g;
                o8[64 * j] = (unsigned long long)pk2(y.x, y.y) | ((unsigned long long)pk2(y.z, y.w) << 32); } }
    }
}

__device__ __forceinline__ void conv_branch_a(const bf16* proj, const float* conv_w, bf16* outA, int gtid, int NT) {
    for (int idx = gtid; idx < M * (CW / 8); idx += NT) {
        const int row = idx >> 8, c0 = (idx & 255) * 8, s = row & (SEQ - 1);
        float y[8];
#pragma unroll
        for (int e = 0; e < 8; ++e) y[e] = 0.f;
#pragma unroll
        for (int k = 0; k < 3; ++k) {
            const int sk = s - 2 + k;
            if (sk >= 0) {
                const bf16* pr = proj + (size_t)(row - 2 + k) * NPP;
                const v4u xc = *(const v4u*)(pr + OFF_CX + c0), cc = *(const v4u*)(pr + OFF_CC + c0);
                const f32x4 w0 = *(const f32x4*)(conv_w + k * CW + c0), w1 = *(const f32x4*)(conv_w + k * CW + c0 + 4);
                y[0] += w0.x * (bfl(xc.x) * bfl(cc.x)); y[1] += w0.y * (bfh(xc.x) * bfh(cc.x)); y[2] += w0.z * (bfl(xc.y) * bfl(cc.y)); y[3] += w0.w * (bfh(xc.y) * bfh(cc.y));
                y[4] += w1.x * (bfl(xc.z) * bfl(cc.z)); y[5] += w1.y * (bfh(xc.z) * bfh(cc.z)); y[6] += w1.z * (bfl(xc.w) * bfl(cc.w)); y[7] += w1.w * (bfh(xc.w) * bfh(cc.w));
            }
        }
        const v4u cb = *(const v4u*)(proj + (size_t)row * NPP + OFF_CB + c0);
        v4u o; o.x = pk2(y[0] * bfl(cb.x), y[1] * bfh(cb.x)); o.y = pk2(y[2] * bfl(cb.y), y[3] * bfh(cb.y)); o.z = pk2(y[4] * bfl(cb.z), y[5] * bfh(cb.z)); o.w = pk2(y[6] * bfl(cb.w), y[7] * bfh(cb.w));
        *(v4u*)(outA + (size_t)row * CW + c0) = o;
    }
}

constexpr int QS = 132, LS = 68;
__device__ __forceinline__ void dn_chunk_unit(const bf16* proj, const float* qkv_w, const float* a_log, const float* dt_bias, unsigned char* ws, LAS unsigned char* lds, int cid, int tid) {
    const int lane = tid & 63, wave = __builtin_amdgcn_readfirstlane(tid >> 6);
    const int bh = cid >> 5, n = cid & 31, b = bh >> 4, h = bh & 15;
    LAS float* Qs = (LAS float*)lds; LAS float* Ks = Qs + 64 * QS; LAS float* Vs = Ks + 64 * QS; LAS float* Lt = Vs + 64 * QS;
    LAS float* GC = Lt + 64 * LS; LAS float* BETA = GC + 64; LAS float* EGC = BETA + 64; LAS float* ETAIL = EGC + 64;
    const size_t rowb = (size_t)b * SEQ;
    float* WC = (float*)(ws + WS_WC) + (size_t)cid * 8192; float* UB = (float*)(ws + WS_UB) + (size_t)cid * 8192; float* QD = (float*)(ws + WS_QD) + (size_t)cid * 8192;
    float* KTT = (float*)(ws + WS_KTT) + (size_t)cid * 8192; float* AQK = (float*)(ws + WS_AQK) + (size_t)cid * 4096; float* GL = (float*)(ws + WS_GL);
    {
        const int c0 = (tid & 15) * 8;
#pragma unroll
        for (int mat = 0; mat < 3; ++mat) {
            const int wcol = mat * DNW + h * HD + c0;
            f32x4 w[4][2];
#pragma unroll
            for (int j = 0; j < 4; ++j) { w[j][0] = *(const f32x4*)(qkv_w + j * (3 * DNW) + wcol); w[j][1] = *(const f32x4*)(qkv_w + j * (3 * DNW) + wcol + 4); }
            LAS float* X = (mat == 0) ? Qs : (mat == 1) ? Ks : Vs;
#pragma unroll
            for (int half = 0; half < 2; ++half) {
                const int i = half * 32 + (tid >> 4), s = n * CH + i;
                f32x4 a0 = {0.f, 0.f, 0.f, 0.f}, a1 = {0.f, 0.f, 0.f, 0.f};
#pragma unroll
                for (int j = 0; j < 4; ++j) { const int sj = s - 3 + j;
                    if (sj >= 0) { const v4u r = *(const v4u*)(proj + (rowb + sj) * NPP + OFF_Q + wcol);
                        a0.x += w[j][0].x * bfl(r.x); a0.y += w[j][0].y * bfh(r.x); a0.z += w[j][0].z * bfl(r.y); a0.w += w[j][0].w * bfh(r.y);
                        a1.x += w[j][1].x * bfl(r.z); a1.y += w[j][1].y * bfh(r.z); a1.z += w[j][1].z * bfl(r.w); a1.w += w[j][1].w * bfh(r.w); } }
#pragma unroll
                for (int e = 0; e < 4; ++e) { a0[e] = a0[e] * sigm(a0[e]); a1[e] = a1[e] * sigm(a1[e]); }
                if (mat < 2) {
                    float ss = (a0.x * a0.x + a0.y * a0.y) + (a0.z * a0.z + a0.w * a0.w) + (a1.x * a1.x + a1.y * a1.y) + (a1.z * a1.z + a1.w * a1.w);
                    ss += __shfl_xor(ss, 1); ss += __shfl_xor(ss, 2); ss += __shfl_xor(ss, 4); ss += __shfl_xor(ss, 8);
                    float sc = 1.0f / sqrtf(ss + EPS); if (mat == 0) sc *= 0.08838834764831845f;
                    a0 = a0 * sc; a1 = a1 * sc;
                }
                *(LAS f32x4*)(X + i * QS + c0) = a0; *(LAS f32x4*)(X + i * QS + c0 + 4) = a1;
            }
        }
    }
    if (wave == 0) {
        const size_t row = rowb + n * CH + lane;
        const float al = bf1(proj[row * NPP + OFF_AL + h]), bl = bf1(proj[row * NPP + OFF_BL + h]);
        const float xx = al + dt_bias[h];
        const float sp = fmaxf(xx, 0.f) + log1pf(expf(-fabsf(xx)));
        float g = -expf(a_log[h]) * sp;
#pragma unroll
        for (int d = 1; d < 64; d <<= 1) { const float t = __shfl_up(g, d); if (lane >= d) g += t; }
        const float glast = __shfl(g, 63);
        GC[lane] = g; BETA[lane] = 1.0f / (1.0f + expf(-bl)); EGC[lane] = expf(g); ETAIL[lane] = expf(glast - g);
        if (lane == 63) GL[cid] = expf(glast);
    }
    __syncthreads();
    {
        const int r = lane & 15, kq = lane >> 4;
        const int prod = wave >> 2, it = wave & 3;
        const LAS float* Ab = (prod ? Qs : Ks) + (16 * it + r) * QS + 4 * kq;
#pragma unroll
        for (int jt = 0; jt < 4; ++jt) {
            f32x4 acc = {0.f, 0.f, 0.f, 0.f};
            if (jt <= it) {
                const LAS float* Bb = Ks + (16 * jt + r) * QS + 4 * kq;
#pragma unroll
                for (int g = 0; g < 8; ++g) { const f32x4 a4 = *(const LAS f32x4*)(Ab + 16 * g), b4 = *(const LAS f32x4*)(Bb + 16 * g);
#pragma unroll
                    for (int j = 0; j < 4; ++j) acc = __builtin_amdgcn_mfma_f32_16x16x4f32(a4[j], b4[j], acc, 0, 0, 0); }
            }
            const int jx = 16 * jt + r; const float gcj = GC[jx];
            f32x4 o;
#pragma unroll
            for (int reg = 0; reg < 4; ++reg) { const int ix = 16 * it + 4 * kq + reg; const float dec = expf(GC[ix] - gcj);
                if (prod == 0) o[reg] = (ix > jx) ? BETA[ix] * acc[reg] * dec : 0.f;
                else o[reg] = (ix >= jx) ? acc[reg] * dec : 0.f; }
            if (prod == 0) *(LAS f32x4*)(Lt + jx * LS + 16 * it + 4 * kq) = o;
            else {
#pragma unroll
                for (int reg = 0; reg < 4; ++reg) AQK[(16 * it + 4 * kq + reg) * 64 + jx] = o[reg]; }
        }
    }
    __syncthreads();
    if (wave < 4) {
        const int col = tid;
        int zv = 0; asm volatile("" : "+v"(zv));
        const LAS float* LtV = Lt + zv; const LAS float* BV = BETA + zv; const LAS float* EV = EGC + zv;
        const LAS float* src = (col < 128) ? (Vs + col) : (Ks + (col - 128));
        float x[64];
#pragma unroll
        for (int i = 0; i < 64; ++i) { float sc = BV[i]; if (col >= 128) sc *= EV[i]; x[i] = src[i * QS] * sc; }
#pragma unroll
        for (int j = 0; j < 63; ++j) {
            const float xj = x[j];
#pragma unroll
            for (int ii = (j + 1) >> 2; ii < 16; ++ii) { const f32x4 l4 = *(const LAS f32x4*)(LtV + j * LS + 4 * ii);
#pragma unroll
                for (int e = 0; e < 4; ++e) { if (4 * ii + e > j) x[4 * ii + e] -= l4[e] * xj; } }
        }
        float* dst = (col < 128) ? (UB + col) : (WC + (col - 128));
#pragma unroll
        for (int i = 0; i < 64; ++i) dst[i * 128] = x[i];
    } else {
        const int t2 = tid - 256;
        { const int d4 = (t2 & 31) * 4;
#pragma unroll
          for (int p = 0; p < 8; ++p) { const int i = (t2 >> 5) + 8 * p; const f32x4 q4 = *(const LAS f32x4*)(Qs + i * QS + d4); *(f32x4*)(QD + i * 128 + d4) = q4 * EGC[i]; } }
        { const int i = t2 & 63; const float et = ETAIL[i];
#pragma unroll 8
          for (int p = 0; p < 32; ++p) { const int d = (t2 >> 6) + 4 * p; KTT[d * 64 + i] = Ks[i * QS + d] * et; } }
    }
    __syncthreads();
}

constexpr int SS = 132, US = 68;
__device__ __forceinline__ void dn_scan_unit(unsigned char* ws, LAS unsigned char* lds, float* O, int unit, int tid) {
    const int lane = tid & 63, wave = __builtin_amdgcn_readfirstlane(tid >> 6), r = lane & 15, kq = lane >> 4;
    const int bh = unit >> 2, vs = unit & 3, b = bh >> 4, h = bh & 15;
    const int rt = wave >> 1, ct = wave & 1;
    LAS float* St = (LAS float*)lds; LAS float* Ut = St + 32 * SS;
    for (int i = tid; i < 32 * SS; i += NTHREADS) St[i] = 0.f;
    f32x4 s0 = {0.f, 0.f, 0.f, 0.f}, s1 = {0.f, 0.f, 0.f, 0.f};
    __syncthreads();
    for (int n = 0; n < NCH; ++n) {
        const size_t cid = (size_t)bh * NCH + n;
        const float* WC = (const float*)(ws + WS_WC) + cid * 8192; const float* UB = (const float*)(ws + WS_UB) + cid * 8192; const float* QD = (const float*)(ws + WS_QD) + cid * 8192;
        const float* KTT = (const float*)(ws + WS_KTT) + cid * 8192; const float* AQK = (const float*)(ws + WS_AQK) + cid * 4096; const float gl = ((const float*)(ws + WS_GL))[cid];
        f32x4 accU = {0.f, 0.f, 0.f, 0.f}, accO = {0.f, 0.f, 0.f, 0.f};
        const float* wrow = WC + (16 * rt + r) * 128 + 4 * kq; const float* qrow = QD + (16 * rt + r) * 128 + 4 * kq;
        const LAS float* srow = St + (16 * ct + r) * SS + 4 * kq;
#pragma unroll
        for (int g = 0; g < 8; ++g) { const f32x4 a4 = *(const f32x4*)(wrow + 16 * g), q4 = *(const f32x4*)(qrow + 16 * g), s4 = *(const LAS f32x4*)(srow + 16 * g);
#pragma unroll
            for (int j = 0; j < 4; ++j) { accU = __builtin_amdgcn_mfma_f32_16x16x4f32(a4[j], s4[j], accU, 0, 0, 0); accO = __builtin_amdgcn_mfma_f32_16x16x4f32(q4[j], s4[j], accO, 0, 0, 0); } }
        f32x4 u;
#pragma unroll
        for (int reg = 0; reg < 4; ++reg) u[reg] = UB[(16 * rt + 4 * kq + reg) * 128 + vs * 32 + 16 * ct + r] - accU[reg];
        *(LAS f32x4*)(Ut + (16 * ct + r) * US + 16 * rt + 4 * kq) = u;
        __syncthreads();
        const float* arow = AQK + (16 * rt + r) * 64 + 4 * kq; const LAS float* urow = Ut + (16 * ct + r) * US + 4 * kq;
#pragma unroll
        for (int g = 0; g < 4; ++g) { const f32x4 a4 = *(const f32x4*)(arow + 16 * g), u4 = *(const LAS f32x4*)(urow + 16 * g);
#pragma unroll
            for (int j = 0; j < 4; ++j) accO = __builtin_amdgcn_mfma_f32_16x16x4f32(a4[j], u4[j], accO, 0, 0, 0); }
        { float* orow = O + ((size_t)b * SEQ + n * CH + 16 * rt + 4 * kq) * DNW + h * HD + vs * 32 + 16 * ct + r;
#pragma unroll
          for (int reg = 0; reg < 4; ++reg) orow[(size_t)reg * DNW] = accO[reg]; }
        s0 = s0 * gl; s1 = s1 * gl;
        const float* krow = KTT + (16 * wave + r) * 64 + 4 * kq; const LAS float* u0 = Ut + r * US + 4 * kq; const LAS float* u1 = Ut + (16 + r) * US + 4 * kq;
#pragma unroll
        for (int g = 0; g < 4; ++g) { const f32x4 k4 = *(const f32x4*)(krow + 16 * g), a4 = *(const LAS f32x4*)(u0 + 16 * g), b4 = *(const LAS f32x4*)(u1 + 16 * g);
#pragma unroll
            for (int j = 0; j < 4; ++j) { s0 = __builtin_amdgcn_mfma_f32_16x16x4f32(k4[j], a4[j], s0, 0, 0, 0); s1 = __builtin_amdgcn_mfma_f32_16x16x4f32(k4[j], b4[j], s1, 0, 0, 0); } }
        *(LAS f32x4*)(St + r * SS + 16 * wave + 4 * kq) = s0; *(LAS f32x4*)(St + (16 + r) * SS + 16 * wave + 4 * kq) = s1;
        __syncthreads();
    }
}

__device__ __forceinline__ void dn_gated_norm(const float* O, const bf16* proj, const float* wn, bf16* ON, int gtid, int NT) {
    for (int idx = gtid; idx < M * NH * 16; idx += NT) {
        const int pair = idx >> 4, sub = idx & 15, row = pair >> 4, h = pair & 15, c = h * HD + sub * 8;
        const f32x4 o0 = *(const f32x4*)(O + (size_t)row * DNW + c), o1 = *(const f32x4*)(O + (size_t)row * DNW + c + 4);
        float ss = (o0.x * o0.x + o0.y * o0.y) + (o0.z * o0.z + o0.w * o0.w) + (o1.x * o1.x + o1.y * o1.y) + (o1.z * o1.z + o1.w * o1.w);
        ss += __shfl_xor(ss, 1); ss += __shfl_xor(ss, 2); ss += __shfl_xor(ss, 4); ss += __shfl_xor(ss, 8);
        const float rstd = 1.0f / sqrtf(ss * (1.0f / HD) + EPS);
        const v4u z = *(const v4u*)(proj + (size_t)row * NPP + OFF_Z + c);
        const f32x4 w0 = *(const f32x4*)(wn + sub * 8), w1 = *(const f32x4*)(wn + sub * 8 + 4);
        const float z0 = bfl(z.x), z1 = bfh(z.x), z2 = bfl(z.y), z3 = bfh(z.y), z4 = bfl(z.z), z5 = bfh(z.z), z6 = bfl(z.w), z7 = bfh(z.w);
        v4u o; o.x = pk2(o0.x * rstd * w0.x * (z0 * sigm(z0)), o0.y * rstd * w0.y * (z1 * sigm(z1))); o.y = pk2(o0.z * rstd * w0.z * (z2 * sigm(z2)), o0.w * rstd * w0.w * (z3 * sigm(z3)));
        o.z = pk2(o1.x * rstd * w1.x * (z4 * sigm(z4)), o1.y * rstd * w1.y * (z5 * sigm(z5))); o.w = pk2(o1.z * rstd * w1.z * (z6 * sigm(z6)), o1.w * rstd * w1.w * (z7 * sigm(z7)));
        *(v4u*)(ON + (size_t)row * DNW + c) = o;
    }
}

__device__ __forceinline__ void xattn_unit(const bf16* XQ, const bf16* KB, const bf16* VT, bf16* XO, LAS unsigned char* lds, int unit, int tid) {
    const int lane = tid & 63, wave = __builtin_amdgcn_readfirstlane(tid >> 6), r = lane & 15, kq = lane >> 4;
    const int b = unit >> 6, hd = (unit >> 4) & 3, qt = unit & 15;
    LAS unsigned char* Ksm = lds; LAS unsigned char* Vtm = lds + 256 * 272;
    {
        const int seg = tid & 15, rr = tid >> 4;
#pragma unroll
        for (int p = 0; p < 8; ++p) { const int key = rr + 32 * p; const v4u v = *(const v4u*)(KB + (size_t)(b * MEMT + key) * XW + hd * HD + seg * 8); *(LAS v4u*)(Ksm + key * 272 + seg * 16) = v; }
        const int seg2 = tid & 31, r2 = tid >> 5;
#pragma unroll
        for (int p = 0; p < 8; ++p) { const int d = r2 + 16 * p; const v4u v = *(const v4u*)(VT + ((size_t)(b * 4 + hd) * HD + d) * MEMT + seg2 * 8); *(LAS v4u*)(Vtm + d * 528 + seg2 * 16) = v; }
    }
    const size_t qrow = (size_t)b * SEQ + qt * 128 + wave * 16 + r;
    bf16x8 qf[4];
#pragma unroll
    for (int ks = 0; ks < 4; ++ks) qf[ks] = *(const bf16x8*)(XQ + qrow * XW + hd * HD + 32 * ks + 8 * kq);
    __syncthreads();
    f32x4 sc[16];
#pragma unroll
    for (int t = 0; t < 16; ++t) { sc[t] = (f32x4){0.f, 0.f, 0.f, 0.f};
#pragma unroll
        for (int ks = 0; ks < 4; ++ks) { const bf16x8 kf = *(const LAS bf16x8*)(Ksm + (16 * t + r) * 272 + (32 * ks + 8 * kq) * 2);
            sc[t] = __builtin_amdgcn_mfma_f32_16x16x32_bf16(kf, qf[ks], sc[t], 0, 0, 0); } }
    float mx = -3.0e38f;
#pragma unroll
    for (int t = 0; t < 16; ++t) mx = fmaxf(mx, fmaxf(fmaxf(sc[t].x, sc[t].y), fmaxf(sc[t].z, sc[t].w)));
    mx = fmaxf(mx, __shfl_xor(mx, 16)); mx = fmaxf(mx, __shfl_xor(mx, 32));
    float sum = 0.f;
#pragma unroll
    for (int t = 0; t < 16; ++t) {
#pragma unroll
        for (int e = 0; e < 4; ++e) { sc[t][e] = __builtin_amdgcn_exp2f(sc[t][e] - mx); sum += sc[t][e]; } }
    sum += __shfl_xor(sum, 16); sum += __shfl_xor(sum, 32);
    const float inv = 1.0f / sum;
    bf16x8 pf[8];
#pragma unroll
    for (int s = 0; s < 8; ++s) { v4u w; w.x = pk2(sc[2 * s].x, sc[2 * s].y); w.y = pk2(sc[2 * s].z, sc[2 * s].w); w.z = pk2(sc[2 * s + 1].x, sc[2 * s + 1].y); w.w = pk2(sc[2 * s + 1].z, sc[2 * s + 1].w);
        pf[s] = __builtin_bit_cast(bf16x8, w); }
#pragma unroll
    for (int dt = 0; dt < 8; ++dt) { f32x4 o = {0.f, 0.f, 0.f, 0.f};
#pragma unroll
        for (int s = 0; s < 8; ++s) { const LAS unsigned char* vp = Vtm + (16 * dt + r) * 528 + (32 * s + 4 * kq) * 2;
            const unsigned long long lo = *(const LAS unsigned long long*)vp, hi = *(const LAS unsigned long long*)(vp + 32);
            v4u w; w.x = (unsigned)lo; w.y = (unsigned)(lo >> 32); w.z = (unsigned)hi; w.w = (unsigned)(hi >> 32);
            o = __builtin_amdgcn_mfma_f32_16x16x32_bf16(__builtin_bit_cast(bf16x8, w), pf[s], o, 0, 0, 0); }
        o = o * inv;
        *(unsigned long long*)(XO + qrow * XW + hd * HD + 16 * dt + 4 * kq) = (unsigned long long)pk2(o.x, o.y) | ((unsigned long long)pk2(o.z, o.w) << 32); }
    __syncthreads();
}

struct Args { const float* in[27]; float* out; unsigned char* ws; int ph_lo, ph_hi; };
enum { I_X = 0, I_MEM, I_F1N, I_F1G, I_F1U, I_F1D, I_MIXN, I_WIN, I_CONVW, I_QKVW, I_ALOG, I_DTB, I_DNN, I_WOC, I_WOD, I_WO, I_XAN, I_MEMN, I_XWQ, I_XWK, I_XWV, I_XWO, I_F2N, I_F2G, I_F2U, I_F2D, I_FINN };

typedef const __attribute__((address_space(4))) Args* KArgs;
__device__ __forceinline__ KArgs kargs() { KArgs p = (KArgs)__builtin_amdgcn_kernarg_segment_ptr(); asm volatile("" : "+s"(p)); return p; }
#define PH_BEGIN KArgs A = kargs(); unsigned char* const ws = A->ws; (void)ws;
#define W1GU ((bf16*)(ws + WS_W1GU))
#define W1D ((bf16*)(ws + WS_W1D))
#define W2GU ((bf16*)(ws + WS_W2GU))
#define W2D ((bf16*)(ws + WS_W2D))
#define WIN ((bf16*)(ws + WS_WIN))
#define WA ((bf16*)(ws + WS_WA))
#define WB ((bf16*)(ws + WS_WB))
#define WO ((bf16*)(ws + WS_WO))
#define WQ ((bf16*)(ws + WS_WQ))
#define WKV ((bf16*)(ws + WS_WKV))
#define WXO ((bf16*)(ws + WS_WXO))
#define XN ((bf16*)(ws + WS_XN))
#define ACT ((bf16*)(ws + WS_R))
#define PROJ ((bf16*)(ws + WS_R))
#define MN ((bf16*)(ws + WS_MN))
#define KB ((bf16*)(ws + WS_KB))
#define VT ((bf16*)(ws + WS_VT))
#define OB ((float*)(ws + WS_O))
#define CONVA ((bf16*)(ws + WS_CONVA))
#define ON ((bf16*)(ws + WS_ON))
#define XQ ((bf16*)(ws + WS_XQ))
#define XO ((bf16*)(ws + WS_XO))
#define TMP ((float*)(ws + WS_TMP))
#define H (A->out)
#define INP(i) (A->in[i])
__global__ void __launch_bounds__(NTHREADS, 2) fwd_kernel(Args args) {
    extern __shared__ __attribute__((aligned(16))) unsigned char lds_raw[];
    LAS unsigned char* lds = (LAS unsigned char*)lds_raw;
    volatile LAS unsigned* MISC = (volatile LAS unsigned*)(lds + MISC_OFF);
    const int tid = threadIdx.x, lane = tid & 63, wave = __builtin_amdgcn_readfirstlane(tid >> 6);
    const int G = gridDim.x, bx = blockIdx.x;
    const int vcu = (G % 8 == 0) ? (bx % 8) * (G / 8) + bx / 8 : bx;
    const int gw = vcu * NWAVES + wave, NGW = G * NWAVES, gtid = vcu * NTHREADS + tid, NT = G * NTHREADS;
    gu32* ctl = (gu32*)(args.ws + WS_CTL);
    for (int u = tid; u < (LDS_BYTES - MISC_OFF) / 4; u += NTHREADS) ((LAS unsigned*)(lds + MISC_OFF))[u] = 0u;
    __syncthreads();
    XcdBarrier bar; bar.bar = (unsigned*)(ctl + CW_BAR); bar.x = 0; bar.st = nullptr;
    const int lo = args.ph_lo, hi = args.ph_hi;
    if (hi - lo > 1) bar = xcd_barrier_post((unsigned*)(ctl + CW_BAR), MISC + 8);
#define IN(k) (lo <= (k) && (k) < hi)
#define SEAM(k) do { if (IN(k) && IN((k) + 1)) xcd_barrier(bar); } while (0)
    if (IN(0)) { PH_BEGIN
        LAS float* scr = (LAS float*)(lds + wave * 16384);
        transpose_weight(INP(I_F1G), D, FF, W1GU, D, 1, 0, scr, gw, NGW, lane);
        transpose_weight(INP(I_F1U), D, FF, W1GU, D, 2, 0, scr, gw, NGW, lane);
        transpose_weight(INP(I_F1D), FF, D, W1D, FF, 0, 0, scr, gw, NGW, lane);
        transpose_weight(INP(I_WIN), D, NPROJ, WIN, D, 0, 0, scr, gw, NGW, lane);
        transpose_weight(INP(I_WOC), CW, D, WA, CW, 0, 0, scr, gw, NGW, lane);
        transpose_weight(INP(I_WOD), DNW, D, WB, DNW, 0, 0, scr, gw, NGW, lane);
        transpose_weight(INP(I_WO), D, D, WO, D, 0, 0, scr, gw, NGW, lane);
        transpose_weight(INP(I_XWQ), D, XW, WQ, D, 0, 0, scr, gw, NGW, lane);
        transpose_weight(INP(I_XWK), D, XW, WKV, D, 0, 0, scr, gw, NGW, lane);
        transpose_weight(INP(I_XWV), D, XW, WKV, D, 0, XW, scr, gw, NGW, lane);
        transpose_weight(INP(I_XWO), XW, D, WXO, XW, 0, 0, scr, gw, NGW, lane);
        transpose_weight(INP(I_F2G), D, FF, W2GU, D, 1, 0, scr, gw, NGW, lane);
        transpose_weight(INP(I_F2U), D, FF, W2GU, D, 2, 0, scr, gw, NGW, lane);
        transpose_weight(INP(I_F2D), FF, D, W2D, FF, 0, 0, scr, gw, NGW, lane);
        for (int i = gtid; i < (NPP - NPROJ) * D / 8; i += NT) ((v4u*)(WIN + (size_t)NPROJ * D))[i] = (v4u){0u, 0u, 0u, 0u};
        rms_rows<false>(INP(I_X), INP(I_F1N), XN, M, gw, NGW, lane);
        rms_rows<false>(INP(I_MEM), INP(I_MEMN), MN, BATCH * MEMT, gw, NGW, lane);
    }
    SEAM(0);
    if (IN(1)) { PH_BEGIN
        pg8::Gemm g{XN, W1GU, M, 2 * FF, D, D, D}; pg8::StaticOrder S; S.init(M, 2 * FF, G, bx);
        pg8::EpiSwiGLU E{ACT, FF};
        pg8::gemm_phase<pg8::EpiSwiGLU, pg8::StaticOrder, true, true>(lds, g, S, E);
    }
    SEAM(1);
    if (IN(2)) { PH_BEGIN
        pg8::Gemm g{MN, WKV, BATCH * MEMT, 2 * XW, D, D, D}; pg8::StaticOrder S; S.init(BATCH * MEMT, 2 * XW, G, bx);
        pg8::EpiKV E{KB, VT};
        pg8::gemm_phase<pg8::EpiKV, pg8::StaticOrder, true, true>(lds, g, S, E);
    }
    SEAM(2);
    if (IN(3)) { PH_BEGIN
        pg8::Gemm g{ACT, W1D, M, D, FF, FF, FF}; pg8::StaticOrder S; S.init(M, D, G, bx);
        pg8::EpiResid E{INP(I_X), H, D, 0.5f};
        pg8::gemm_phase<pg8::EpiResid, pg8::StaticOrder, true, true>(lds, g, S, E);
    }
    SEAM(3);
    if (IN(4)) { PH_BEGIN rms_rows<false>(H, INP(I_MIXN), XN, M, gw, NGW, lane); }
    SEAM(4);
    if (IN(5)) { PH_BEGIN
        pg8::Gemm g{XN, WIN, M, NPP, D, D, D}; pg8::StaticOrder S; S.init(M, NPP, G, bx);
        pg8::EpiStoreBf16 E{PROJ, NPP, 1.0f};
        pg8::gemm_phase<pg8::EpiStoreBf16, pg8::StaticOrder, true, true>(lds, g, S, E);
    }
    SEAM(5);
    if (IN(6)) { PH_BEGIN
        conv_branch_a(PROJ, INP(I_CONVW), CONVA, gtid, NT);
        for (int cid = vcu; cid < BATCH * NH * NCH; cid += G) dn_chunk_unit(PROJ, INP(I_QKVW), INP(I_ALOG), INP(I_DTB), ws, lds, cid, tid);
    }
    SEAM(6);
    if (IN(7)) { PH_BEGIN for (int unit = vcu; unit < BATCH * NH * 4; unit += G) dn_scan_unit(ws, lds, OB, unit, tid); }
    SEAM(7);
    if (IN(8)) { PH_BEGIN dn_gated_norm(OB, PROJ, INP(I_DNN), ON, gtid, NT); }
    SEAM(8);
    if (IN(9)) { PH_BEGIN
        pg8::Gemm g{CONVA, WA, M, D, CW, CW, CW}; pg8::StaticOrder S; S.init(M, D, G, bx);
        pg8::EpiGateA E{TMP, D, PROJ + OFF_GA, NPP};
        pg8::gemm_phase<pg8::EpiGateA, pg8::StaticOrder, true, true>(lds, g, S, E);
    }
    SEAM(9);
    if (IN(10)) { PH_BEGIN
        pg8::Gemm g{ON, WB, M, D, DNW, DNW, DNW}; pg8::StaticOrder S; S.init(M, D, G, bx);
        pg8::EpiGateB E{TMP, XN, D, PROJ + OFF_GB, NPP};
        pg8::gemm_phase<pg8::EpiGateB, pg8::StaticOrder, true, true>(lds, g, S, E);
    }
    SEAM(10);
    if (IN(11)) { PH_BEGIN
        pg8::Gemm g{XN, WO, M, D, D, D, D}; pg8::StaticOrder S; S.init(M, D, G, bx);
        pg8::EpiResid E{H, H, D, 1.0f};
        pg8::gemm_phase<pg8::EpiResid, pg8::StaticOrder, true, true>(lds, g, S, E);
    }
    SEAM(11);
    if (IN(12)) { PH_BEGIN rms_rows<false>(H, INP(I_XAN), XN, M, gw, NGW, lane); }
    SEAM(12);
    if (IN(13)) { PH_BEGIN
        pg8::Gemm g{XN, WQ, M, XW, D, D, D}; pg8::StaticOrder S; S.init(M, XW, G, bx);
        pg8::EpiStoreBf16 E{XQ, XW, 0.08838834764831845f * 1.4426950408889634f};
        pg8::gemm_phase<pg8::EpiStoreBf16, pg8::StaticOrder, true, true>(lds, g, S, E);
    }
    SEAM(13);
    if (IN(14)) { PH_BEGIN for (int unit = vcu; unit < BATCH * 4 * (SEQ / 128); unit += G) xattn_unit(XQ, KB, VT, XO, lds, unit, tid); }
    SEAM(14);
    if (IN(15)) { PH_BEGIN
        pg8::Gemm g{XO, WXO, M, D, XW, XW, XW}; pg8::StaticOrder S; S.init(M, D, G, bx);
        pg8::EpiResid E{H, H, D, 1.0f};
        pg8::gemm_phase<pg8::EpiResid, pg8::StaticOrder, true, true>(lds, g, S, E);
    }
    SEAM(15);
    if (IN(16)) { PH_BEGIN rms_rows<false>(H, INP(I_F2N), XN, M, gw, NGW, lane); }
    SEAM(16);
    if (IN(17)) { PH_BEGIN
        pg8::Gemm g{XN, W2GU, M, 2 * FF, D, D, D}; pg8::StaticOrder S; S.init(M, 2 * FF, G, bx);
        pg8::EpiSwiGLU E{ACT, FF};
        pg8::gemm_phase<pg8::EpiSwiGLU, pg8::StaticOrder, true, true>(lds, g, S, E);
    }
    SEAM(17);
    if (IN(18)) { PH_BEGIN
        pg8::Gemm g{ACT, W2D, M, D, FF, FF, FF}; pg8::StaticOrder S; S.init(M, D, G, bx);
        pg8::EpiResid E{H, H, D, 0.5f};
        pg8::gemm_phase<pg8::EpiResid, pg8::StaticOrder, true, true>(lds, g, S, E);
    }
    SEAM(18);
    if (IN(19)) { PH_BEGIN rms_rows<true>(H, INP(I_FINN), H, M, gw, NGW, lane); }
#undef IN
#undef SEAM
}

extern "C" void kernel_launch(void* const* d_in, const int* in_sizes, int n_in, void* d_out, int out_size, void* d_ws, size_t ws_size, hipStream_t stream) {
    static int grid = 0;
    if (grid == 0) {
        if (n_in != 27 || out_size != M * D || ws_size < WS_END) { fprintf(stderr, "kernel_launch: unexpected problem (n_in %d, out %d, ws %zu < %zu)\n", n_in, out_size, ws_size, (size_t)WS_END); grid = -1; return; }
        int dev = 0, cus = 0, per_cu = 0;
        if (hipGetDevice(&dev) != hipSuccess || hipDeviceGetAttribute(&cus, hipDeviceAttributeMultiprocessorCount, dev) != hipSuccess) { grid = -1; return; }
        if (hipFuncSetAttribute((const void*)fwd_kernel, hipFuncAttributeMaxDynamicSharedMemorySize, LDS_BYTES) != hipSuccess) { fprintf(stderr, "kernel_launch: hipFuncSetAttribute failed\n"); grid = -1; return; }
        if (hipOccupancyMaxActiveBlocksPerMultiprocessor(&per_cu, (const void*)fwd_kernel, NTHREADS, LDS_BYTES) != hipSuccess || per_cu < 1) { fprintf(stderr, "kernel_launch: occupancy query reports %d blocks per CU\n", per_cu); (void)hipGetLastError(); grid = -1; return; }
        grid = cus;
    }
    if (grid < 0) return;
    (void)hipMemsetAsync((char*)d_ws + WS_CTL, 0, CTL_ZERO_BYTES, stream);
    Args a{};
    for (int i = 0; i < 27; ++i) a.in[i] = (const float*)d_in[i];
    a.out = (float*)d_out; a.ws = (unsigned char*)d_ws;
#if MK_N_LAUNCHES == 1
    a.ph_lo = 0; a.ph_hi = NPH;
    hipLaunchKernelGGL(fwd_kernel, dim3(grid), dim3(NTHREADS), LDS_BYTES, stream, a);
#else
    for (int p = 0; p < NPH; ++p) { a.ph_lo = p; a.ph_hi = p + 1; hipLaunchKernelGGL(fwd_kernel, dim3(grid), dim3(NTHREADS), LDS_BYTES, stream, a); }
#endif
}
```

```cpp
#include <hip/hip_runtime.h>
#include <cstdio>
#include <cstdint>
#ifndef MK_N_LAUNCHES
#define MK_N_LAUNCHES 1
#endif
namespace pg8 {
#define PG8_LAS __attribute__((address_space(3)))
typedef unsigned short bf16_t;
typedef short bf16x8 __attribute__((ext_vector_type(8)));
typedef float f32x4 __attribute__((ext_vector_type(4)));
typedef unsigned u32x4 __attribute__((ext_vector_type(4)));
constexpr int BM = 256, BK = 64, HALF = 128, HTB = HALF * BK * 2  , STAGE_BYTES = 8 * HTB, NXCD = 8, WGM = 8;

__host__ __device__ __forceinline__ int lds_byte(int r, int c) { const int st = (r >> 4) * 2 + (c >> 5), rr = r & 15, cc = c & 31, ob = rr * 64 + cc * 2; return st * 1024 + (ob ^ (((ob >> 9) & 1) << 5)); }
__host__ __device__ __forceinline__ void stage_rc(int b, int& R, int& C) { const int st = b / 1024, sb = b % 1024, swz = sb ^ (((sb >> 9) & 1) << 5); R = (st >> 1) * 16 + swz / 64; C = (st & 1) * 32 + (swz % 64) / 2; }
__host__ __device__ __forceinline__ int perm32(int rho) { const int n = rho >> 4, i = rho & 15; return 8 * (i >> 2) + 4 * n + (i & 3); }

struct Unit { int pm, pn, g; };
struct Gemm { const bf16_t* A; const bf16_t* Bt; int M, N, K, lda, ldb; };

struct StaticOrder {
    int nM, nN, nwg, G, c;
    __host__ __device__ void init(int M, int N, int G_, int c_) { nM = M / BM; nN = N / BM; nwg = nM * nN; G = G_; c = c_; }
    __host__ __device__ bool next(int i, Unit& u) const {
        const long L = (long)i * G + c; if (L >= nwg) return false;
        int wgid = (int)L; { const int q = nwg / NXCD, r = nwg % NXCD, xcd = wgid % NXCD, off = wgid / NXCD; wgid = (xcd < r ? xcd * (q + 1) : r * (q + 1) + (xcd - r) * q) + off; }
        const int nig = WGM * nN, gid = wgid / nig, fm = gid * WGM, gsz = (nM - fm) < WGM ? (nM - fm) : WGM;
        u.pm = fm + ((wgid % nig) % gsz); u.pn = (wgid % nig) / gsz; u.g = 0; return true;
    }
    __device__ __forceinline__ const char* pa(const Gemm& g, const Unit& u, size_t tstepA) const { return (const char*)g.A + (size_t)u.pm * tstepA; }
    __device__ __forceinline__ const char* pb(const Gemm& g, const Unit& u, size_t tstepB) const { return (const char*)g.Bt + (size_t)u.pn * tstepB; }
    __device__ __forceinline__ bool keep(const Unit&) const { return false; }
    __device__ __forceinline__ void a_ready(const Unit&) const {}
    __device__ __forceinline__ void done(const Unit&) const {}
};

__device__ __forceinline__ unsigned cvt_pk_bf16(float lo, float hi) { unsigned r; asm volatile("v_cvt_pk_bf16_f32 %0, %1, %2" : "=v"(r) : "v"(lo), "v"(hi)); return r; }
__device__ __forceinline__ float bf_lo(unsigned w) { return __uint_as_float(w << 16); }
__device__ __forceinline__ float bf_hi(unsigned w) { return __uint_as_float(w & 0xffff0000u); }
__device__ __forceinline__ float fast_sigmoid(float x) { return __builtin_amdgcn_rcpf(1.0f + __builtin_amdgcn_exp2f(-1.4426950408889634f * x)); }
__device__ __forceinline__ float fast_silu(float x) { return x * fast_sigmoid(x); }

struct EpiSwiGLU {
    static constexpr bool PERM = true, AFTER_DRAIN = false;
    bf16_t* O; int ldc; const unsigned long long* ssq; float inv_k, eps;
    __device__ __forceinline__ void operator()(const f32x4 (&acc)[2][2][4][2], const Unit& u, int wr, int wc, int fr, int fq) const {
        const int row0 = u.pm * BM + wr * 64 + fr, col0 = u.pn * HALF + wc * 32 + 8 * fq;
        float rsv[2][4];
#pragma unroll
        for (int ai = 0; ai < 2; ++ai)
#pragma unroll
            for (int m = 0; m < 4; ++m) rsv[ai][m] = ssq ? (float)ssq[row0 + ai * HALF + m * 16] : 0.f;
#pragma unroll
        for (int ai = 0; ai < 2; ++ai)
#pragma unroll
            for (int m = 0; m < 4; ++m) { bf16_t* rowp = O + (size_t)(row0 + ai * HALF + m * 16) * ldc + col0;
                const float rs = ssq ? 1.0f / sqrtf(rsv[ai][m] * inv_k + eps) : 1.0f;
                const f32x4 g0 = acc[ai][0][m][0] * rs, g1 = acc[ai][0][m][1] * rs, u0 = acc[ai][1][m][0] * rs, u1 = acc[ai][1][m][1] * rs;
                f32x4 v0, v1;
#pragma unroll
                for (int j = 0; j < 4; ++j) { v0[j] = fast_silu(g0[j]) * u0[j]; v1[j] = fast_silu(g1[j]) * u1[j]; }
                u32x4 w; w.x = cvt_pk_bf16(v0[0], v0[1]); w.y = cvt_pk_bf16(v0[2], v0[3]); w.z = cvt_pk_bf16(v1[0], v1[1]); w.w = cvt_pk_bf16(v1[2], v1[3]);
                *(u32x4*)rowp = w; }
    }
};
template <bool XF32> struct EpiResidBf {
    static constexpr bool PERM = true, AFTER_DRAIN = false;
    const void* base; bf16_t* out; int ldc; float alpha; unsigned long long* ssq;
    __device__ __forceinline__ void operator()(const f32x4 (&acc)[2][2][4][2], const Unit& u, int wr, int wc, int fr, int fq) const {
        const int row0 = u.pm * BM + wr * 64 + fr, col0 = u.pn * BM + wc * 32 + 8 * fq;
#pragma unroll
        for (int ai = 0; ai < 2; ++ai) {
            f32x4 b[4][2][2];
#pragma unroll
            for (int m = 0; m < 4; ++m) { const size_t off = (size_t)(row0 + ai * HALF + m * 16) * ldc + col0;
#pragma unroll
                for (int bj = 0; bj < 2; ++bj) {
                    if (XF32) { b[m][bj][0] = *(const f32x4*)((const float*)base + off + bj * HALF); b[m][bj][1] = *(const f32x4*)((const float*)base + off + bj * HALF + 4); }
                    else { const u32x4 w = *(const u32x4*)((const bf16_t*)base + off + bj * HALF);
                        b[m][bj][0] = (f32x4){bf_lo(w.x), bf_hi(w.x), bf_lo(w.y), bf_hi(w.y)}; b[m][bj][1] = (f32x4){bf_lo(w.z), bf_hi(w.z), bf_lo(w.w), bf_hi(w.w)}; } } }
#pragma unroll
            for (int m = 0; m < 4; ++m) { const size_t off = (size_t)(row0 + ai * HALF + m * 16) * ldc + col0; float ss = 0.f;
#pragma unroll
                for (int bj = 0; bj < 2; ++bj) { const f32x4 o0 = b[m][bj][0] + acc[ai][bj][m][0] * alpha, o1 = b[m][bj][1] + acc[ai][bj][m][1] * alpha;
                    ss += ((o0[0] * o0[0] + o0[1] * o0[1]) + (o0[2] * o0[2] + o0[3] * o0[3])) + ((o1[0] * o1[0] + o1[1] * o1[1]) + (o1[2] * o1[2] + o1[3] * o1[3]));
                    u32x4 w; w.x = cvt_pk_bf16(o0[0], o0[1]); w.y = cvt_pk_bf16(o0[2], o0[3]); w.z = cvt_pk_bf16(o1[0], o1[1]); w.w = cvt_pk_bf16(o1[2], o1[3]);
                    *(u32x4*)(out + off + bj * HALF) = w; }
                ss += __shfl_xor(ss, 16); ss += __shfl_xor(ss, 32);
                if (fq == 0) __hip_atomic_fetch_add(ssq + row0 + ai * HALF + m * 16, (unsigned long long)(ss * 1048576.0f + 0.5f), __ATOMIC_RELAXED, __HIP_MEMORY_SCOPE_AGENT); }
        }
    }
};
struct EpiStoreBf16 {
    static constexpr bool PERM = true, AFTER_DRAIN = false;
    bf16_t* O; int ldc; const unsigned long long* ssq; float inv_k, eps;
    __device__ __forceinline__ void operator()(const f32x4 (&acc)[2][2][4][2], const Unit& u, int wr, int wc, int fr, int fq) const {
        const int row0 = u.pm * BM + wr * 64 + fr, col0 = u.pn * BM + wc * 32 + 8 * fq;
        float rsv[2][4];
#pragma unroll
        for (int ai = 0; ai < 2; ++ai)
#pragma unroll
            for (int m = 0; m < 4; ++m) rsv[ai][m] = ssq ? (float)ssq[row0 + ai * HALF + m * 16] : 0.f;
#pragma unroll
        for (int ai = 0; ai < 2; ++ai)
#pragma unroll
            for (int m = 0; m < 4; ++m) { bf16_t* rowp = O + (size_t)(row0 + ai * HALF + m * 16) * ldc + col0;
                const float scale = ssq ? 1.0f / sqrtf(rsv[ai][m] * inv_k + eps) : 1.0f;
#pragma unroll
                for (int bj = 0; bj < 2; ++bj) { const f32x4 v0 = acc[ai][bj][m][0] * scale, v1 = acc[ai][bj][m][1] * scale;
                    u32x4 w; w.x = cvt_pk_bf16(v0[0], v0[1]); w.y = cvt_pk_bf16(v0[2], v0[3]); w.z = cvt_pk_bf16(v1[0], v1[1]); w.w = cvt_pk_bf16(v1[2], v1[3]);
                    *(u32x4*)(rowp + bj * HALF) = w; } }
    }
};
struct EpiKV {
    static constexpr bool PERM = true, AFTER_DRAIN = false;
    bf16_t* KB; bf16_t* VT;
    __device__ __forceinline__ void operator()(const f32x4 (&acc)[2][2][4][2], const Unit& u, int wr, int wc, int fr, int fq) const {
        const int rl0 = wr * 64 + fr;
        if (u.pn < 2) {
            const int col0 = u.pn * BM + wc * 32 + 8 * fq;
#pragma unroll
            for (int ai = 0; ai < 2; ++ai)
#pragma unroll
                for (int m = 0; m < 4; ++m) { bf16_t* rowp = KB + (size_t)(u.pm * BM + rl0 + ai * HALF + m * 16) * 512 + col0;
#pragma unroll
                    for (int bj = 0; bj < 2; ++bj) { const f32x4 v0 = acc[ai][bj][m][0], v1 = acc[ai][bj][m][1];
                        u32x4 w; w.x = cvt_pk_bf16(v0[0], v0[1]); w.y = cvt_pk_bf16(v0[2], v0[3]); w.z = cvt_pk_bf16(v1[0], v1[1]); w.w = cvt_pk_bf16(v1[2], v1[3]);
                        *(u32x4*)(rowp + bj * HALF) = w; } }
        } else {
            const int colv0 = (u.pn - 2) * BM + wc * 32 + 8 * fq;
#pragma unroll
            for (int ai = 0; ai < 2; ++ai)
#pragma unroll
                for (int m = 0; m < 4; ++m) { const int key = rl0 + ai * HALF + m * 16;
#pragma unroll
                    for (int bj = 0; bj < 2; ++bj)
#pragma unroll
                        for (int n = 0; n < 2; ++n)
#pragma unroll
                            for (int e = 0; e < 4; ++e) { const int cv = colv0 + bj * HALF + 4 * n + e;
                                VT[((size_t)u.pm * 512 + cv) * 256 + key] = (bf16_t)(cvt_pk_bf16(acc[ai][bj][m][n][e], 0.f) & 0xffffu); } }
        }
    }
};
struct EpiGateA {
    static constexpr bool PERM = true, AFTER_DRAIN = false;
    float* T; int ldc; const bf16_t* G; int ldg;
    __device__ __forceinline__ void operator()(const f32x4 (&acc)[2][2][4][2], const Unit& u, int wr, int wc, int fr, int fq) const {
        const int row0 = u.pm * BM + wr * 64 + fr, col0 = u.pn * BM + wc * 32 + 8 * fq;
#pragma unroll
        for (int ai = 0; ai < 2; ++ai)
#pragma unroll
            for (int m = 0; m < 4; ++m) { const size_t row = (size_t)(row0 + ai * HALF + m * 16);
#pragma unroll
                for (int bj = 0; bj < 2; ++bj) { const int c = col0 + bj * HALF; const u32x4 gw = *(const u32x4*)(G + row * ldg + c);
                    f32x4 v0 = acc[ai][bj][m][0], v1 = acc[ai][bj][m][1];
                    v0[0] *= fast_sigmoid(bf_lo(gw.x)); v0[1] *= fast_sigmoid(bf_hi(gw.x)); v0[2] *= fast_sigmoid(bf_lo(gw.y)); v0[3] *= fast_sigmoid(bf_hi(gw.y));
                    v1[0] *= fast_sigmoid(bf_lo(gw.z)); v1[1] *= fast_sigmoid(bf_hi(gw.z)); v1[2] *= fast_sigmoid(bf_lo(gw.w)); v1[3] *= fast_sigmoid(bf_hi(gw.w));
                    *(f32x4*)(T + row * ldc + c) = v0; *(f32x4*)(T + row * ldc + c + 4) = v1; } }
    }
};
struct EpiGateB {
    static constexpr bool PERM = true, AFTER_DRAIN = false;
    const float* T; bf16_t* O; int ldc; const bf16_t* G; int ldg;
    __device__ __forceinline__ void operator()(const f32x4 (&acc)[2][2][4][2], const Unit& u, int wr, int wc, int fr, int fq) const {
        const int row0 = u.pm * BM + wr * 64 + fr, col0 = u.pn * BM + wc * 32 + 8 * fq;
#pragma unroll
        for (int ai = 0; ai < 2; ++ai)
#pragma unroll
            for (int m = 0; m < 4; ++m) { const size_t row = (size_t)(row0 + ai * HALF + m * 16);
#pragma unroll
                for (int bj = 0; bj < 2; ++bj) { const int c = col0 + bj * HALF; const u32x4 gw = *(const u32x4*)(G + row * ldg + c);
                    const f32x4 t0 = *(const f32x4*)(T + row * ldc + c), t1 = *(const f32x4*)(T + row * ldc + c + 4);
                    f32x4 v0 = acc[ai][bj][m][0], v1 = acc[ai][bj][m][1];
                    v0[0] = t0[0] + v0[0] * fast_sigmoid(bf_lo(gw.x)); v0[1] = t0[1] + v0[1] * fast_sigmoid(bf_hi(gw.x)); v0[2] = t0[2] + v0[2] * fast_sigmoid(bf_lo(gw.y)); v0[3] = t0[3] + v0[3] * fast_sigmoid(bf_hi(gw.y));
                    v1[0] = t1[0] + v1[0] * fast_sigmoid(bf_lo(gw.z)); v1[1] = t1[1] + v1[1] * fast_sigmoid(bf_hi(gw.z)); v1[2] = t1[2] + v1[2] * fast_sigmoid(bf_lo(gw.w)); v1[3] = t1[3] + v1[3] * fast_sigmoid(bf_hi(gw.w));
                    u32x4 w; w.x = cvt_pk_bf16(v0[0], v0[1]); w.y = cvt_pk_bf16(v0[2], v0[3]); w.z = cvt_pk_bf16(v1[0], v1[1]); w.w = cvt_pk_bf16(v1[2], v1[3]);
                    *(u32x4*)(O + row * ldc + c) = w; } }
    }
};

struct OrderFfnKv : StaticOrder {
    const bf16_t* A1; const bf16_t* B1;
    __device__ __forceinline__ bool next(int i, Unit& u) const {
        if (StaticOrder::next(i, u)) return true;
        const long L = (long)i * G + c - nwg; if (L < 0 || L >= 16) return false;
        u.g = 1; u.pm = (int)(L >> 2); u.pn = (int)(L & 3); return true; }
    __device__ __forceinline__ const char* pa(const Gemm& g, const Unit& u, size_t tstepA) const { return (const char*)(u.g ? A1 : g.A) + (size_t)u.pm * tstepA; }
    __device__ __forceinline__ const char* pb(const Gemm& g, const Unit& u, size_t tstepB) const { return (const char*)(u.g ? B1 : g.Bt) + (size_t)u.pn * tstepB; }
};
struct EpiSwiGLUKV {
    static constexpr bool PERM = true, AFTER_DRAIN = false;
    EpiSwiGLU e0; EpiKV e1;
    __device__ __forceinline__ void operator()(const f32x4 (&acc)[2][2][4][2], const Unit& u, int wr, int wc, int fr, int fq) const { if (u.g == 0) e0(acc, u, wr, wc, fr, fq); else e1(acc, u, wr, wc, fr, fq); }
};
struct OrderSplitK4 {
    int G, c, ks_bytes;
    __device__ __forceinline__ bool next(int i, Unit& u) const { const int cc = (G % 8 == 0) ? (c % 8) * (G / 8) + c / 8 : c;
        const long L = (long)i * G + cc; if (L >= 256) return false; u.pm = (int)(L >> 3); u.pn = (int)((L >> 2) & 1); u.g = (int)(L & 3); return true; }
    __device__ __forceinline__ const char* pa(const Gemm& g, const Unit& u, size_t tstepA) const { return (const char*)g.A + (size_t)u.pm * tstepA + (size_t)u.g * ks_bytes; }
    __device__ __forceinline__ const char* pb(const Gemm& g, const Unit& u, size_t tstepB) const { return (const char*)g.Bt + (size_t)u.pn * tstepB + (size_t)u.g * ks_bytes; }
    __device__ __forceinline__ bool keep(const Unit&) const { return false; }
    __device__ __forceinline__ void a_ready(const Unit&) const {}
    __device__ __forceinline__ void done(const Unit&) const {}
};
struct EpiPartF32 {
    static constexpr bool PERM = false, AFTER_DRAIN = false;
    float* P; int ldc; size_t gstride;
    __device__ __forceinline__ void operator()(const f32x4 (&acc)[2][2][4][2], const Unit& u, int wr, int wc, int fr, int fq) const {
        const int row0 = u.pm * BM + wr * 64 + fr, col0 = u.pn * BM + wc * 32 + 4 * fq; float* out = P + (size_t)u.g * gstride;
#pragma unroll
        for (int ai = 0; ai < 2; ++ai)
#pragma unroll
            for (int m = 0; m < 4; ++m) { const size_t off = (size_t)(row0 + ai * HALF + m * 16) * ldc + col0;
#pragma unroll
                for (int bj = 0; bj < 2; ++bj)
#pragma unroll
                    for (int n = 0; n < 2; ++n) *(f32x4*)(out + off + bj * HALF + n * 16) = acc[ai][bj][m][n]; }
    }
};
struct OrderTwoPass : StaticOrder {
    const bf16_t* A1; const bf16_t* B1;
    __device__ __forceinline__ bool next(int i, Unit& u) const { if (!StaticOrder::next(i >> 1, u)) return false; u.g = i & 1; return true; }
    __device__ __forceinline__ const char* pa(const Gemm& g, const Unit& u, size_t tstepA) const { return (const char*)(u.g ? A1 : g.A) + (size_t)u.pm * tstepA; }
    __device__ __forceinline__ const char* pb(const Gemm& g, const Unit& u, size_t tstepB) const { return (const char*)(u.g ? B1 : g.Bt) + (size_t)u.pn * tstepB; }
    __device__ __forceinline__ bool keep(const Unit& u) const { return u.g == 0; }
};
struct EpiGateFused {
    static constexpr bool PERM = true, AFTER_DRAIN = false;
    bf16_t* O; int ldc; const bf16_t* GA; const bf16_t* GB; int ldg;
    __device__ __forceinline__ void operator()(f32x4 (&acc)[2][2][4][2], const Unit& u, int wr, int wc, int fr, int fq) const {
        const int row0 = u.pm * BM + wr * 64 + fr, col0 = u.pn * BM + wc * 32 + 8 * fq;
#pragma unroll
        for (int ai = 0; ai < 2; ++ai)
#pragma unroll
            for (int m = 0; m < 4; ++m) { const size_t row = (size_t)(row0 + ai * HALF + m * 16);
#pragma unroll
                for (int bj = 0; bj < 2; ++bj) { const int c = col0 + bj * HALF; const u32x4 gb = *(const u32x4*)(GB + row * ldg + c);
                    float eb[8] = {bf_lo(gb.x), bf_hi(gb.x), bf_lo(gb.y), bf_hi(gb.y), bf_lo(gb.z), bf_hi(gb.z), bf_lo(gb.w), bf_hi(gb.w)};
#pragma unroll
                    for (int e = 0; e < 8; ++e) eb[e] = 1.0f + __builtin_amdgcn_exp2f(-1.4426950408889634f * eb[e]);
                    if (u.g == 0) { const u32x4 ga = *(const u32x4*)(GA + row * ldg + c);
                        float ea[8] = {bf_lo(ga.x), bf_hi(ga.x), bf_lo(ga.y), bf_hi(ga.y), bf_lo(ga.z), bf_hi(ga.z), bf_lo(ga.w), bf_hi(ga.w)};
#pragma unroll
                        for (int e = 0; e < 8; ++e) { const float rt = eb[e] * __builtin_amdgcn_rcpf(1.0f + __builtin_amdgcn_exp2f(-1.4426950408889634f * ea[e]));
                            acc[ai][bj][m][e >> 2][e & 3] *= rt; }
                    } else { f32x4 v0 = acc[ai][bj][m][0], v1 = acc[ai][bj][m][1];
#pragma unroll
                        for (int e = 0; e < 4; ++e) { v0[e] *= __builtin_amdgcn_rcpf(eb[e]); v1[e] *= __builtin_amdgcn_rcpf(eb[4 + e]); }
                        u32x4 w; w.x = cvt_pk_bf16(v0[0], v0[1]); w.y = cvt_pk_bf16(v0[2], v0[3]); w.z = cvt_pk_bf16(v1[0], v1[1]); w.w = cvt_pk_bf16(v1[2], v1[3]);
                        *(u32x4*)(O + row * ldc + c) = w; } } }
    }
};


template <class Epi, class Sched, bool ALIGN_EPI = false, bool SP2 = false>
__device__ __forceinline__ void gemm_phase(PG8_LAS unsigned char* lds, const Gemm g, const Sched& S, const Epi& E) {
    const int tid = threadIdx.x, wid = __builtin_amdgcn_readfirstlane(tid >> 6), lane = tid & 63, wr = wid >> 2, wc = wid & 3, fr = lane & 15, fq = lane >> 4;
    const int K = g.K, nt = K / BK;
    unsigned voffA[2], voffB[2];
#pragma unroll
    for (int i = 0; i < 2; ++i) { int R, C; stage_rc(tid * 16 + i * 8192, R, C); const int Rb = Epi::PERM ? ((R & ~31) + perm32(R & 31)) : R;
        voffA[i] = (unsigned)(R * g.lda + C) * 2u; voffB[i] = (unsigned)(Rb * g.ldb + C) * 2u; }
    const size_t kstep = (size_t)(BK * 2);
    const size_t hstepA = (size_t)HALF * g.lda * 2, hstepB = (size_t)HALF * g.ldb * 2;
    const size_t tstepA = 2 * hstepA, tstepB = 2 * hstepB;
    const unsigned ldsw = (unsigned)wid * 1024u;
    const int aoff = lds_byte(wr * 64 + fr, fq * 8), boff = lds_byte(wc * 32 + fr, fq * 8);
#define PG8_SA(b, h) (((b) * 2 + (h)) * HTB)
#define PG8_SB(b, h) ((4 + (b) * 2 + (h)) * HTB)
#define PG8_STAGE(bufoff, gbase, voff) do { _Pragma("unroll") for (int _i = 0; _i < 2; ++_i) \
        __builtin_amdgcn_global_load_lds((const unsigned*)((const char*)(gbase) + (voff)[_i]), (PG8_LAS unsigned*)(lds + (bufoff) + ldsw + _i * 8192), 16, 0, 0); } while (0)
#define PG8_LDA(dst, b, h) do { _Pragma("unroll") for (int m = 0; m < 4; ++m) _Pragma("unroll") for (int k = 0; k < 2; ++k) dst[m][k] = *(const PG8_LAS bf16x8*)(lds + PG8_SA(b, h) + aoff + m * 2048 + k * 1024); } while (0)
#define PG8_LDB(dst, b, h) do { _Pragma("unroll") for (int n = 0; n < 2; ++n) _Pragma("unroll") for (int k = 0; k < 2; ++k) dst[n][k] = *(const PG8_LAS bf16x8*)(lds + PG8_SB(b, h) + boff + n * 2048 + k * 1024); } while (0)
#define PG8_MMA(ai, bj, At, Bt) do { __builtin_amdgcn_s_setprio(1); _Pragma("unroll") for (int m = 0; m < 4; ++m) _Pragma("unroll") for (int n = 0; n < 2; ++n) _Pragma("unroll") for (int k = 0; k < 2; ++k) \
        acc[ai][bj][m][n] = __builtin_amdgcn_mfma_f32_16x16x32_bf16(Bt[n][k], At[m][k], acc[ai][bj][m][n], 0, 0, 0); __builtin_amdgcn_s_setprio(0); } while (0)
#define PG8_WAIT_V(n) asm volatile("s_waitcnt vmcnt(" #n ")" ::: "memory")
#define PG8_WAIT_L(n) asm volatile("s_waitcnt lgkmcnt(" #n ")" ::: "memory")
#define PG8_BAR __builtin_amdgcn_s_barrier()
#define PG8_SCHED __builtin_amdgcn_sched_barrier(0)
    Unit cur, nxt; int ui = 0;
    if (!S.next(0, cur)) return;
    f32x4 acc[2][2][4][2];
#pragma unroll
    for (int a = 0; a < 2; ++a)
#pragma unroll
        for (int b = 0; b < 2; ++b)
#pragma unroll
            for (int m = 0; m < 4; ++m)
#pragma unroll
                for (int n = 0; n < 2; ++n) acc[a][b][m][n] = (f32x4){0.f, 0.f, 0.f, 0.f};
    bf16x8 At[4][2], B0[2][2], B1[2][2];
    const char* cA = S.pa(g, cur, tstepA); const char* cB = S.pb(g, cur, tstepB);
    S.a_ready(cur);
    if constexpr (SP2) {
        PG8_STAGE(PG8_SB(0, 0), cB, voffB); PG8_STAGE(PG8_SB(0, 1), cB + hstepB, voffB); PG8_STAGE(PG8_SA(0, 0), cA, voffA); PG8_STAGE(PG8_SA(0, 1), cA + hstepA, voffA);
        if (wr == 1) PG8_BAR;
        PG8_WAIT_V(2); PG8_BAR;
        PG8_STAGE(PG8_SB(1, 0), cB + kstep, voffB); PG8_STAGE(PG8_SA(1, 0), cA + kstep, voffA); PG8_STAGE(PG8_SB(1, 1), cB + hstepB + kstep, voffB);
        PG8_WAIT_V(6); PG8_BAR;
    } else {
        PG8_STAGE(PG8_SB(0, 0), cB, voffB); PG8_STAGE(PG8_SA(0, 0), cA, voffA); PG8_STAGE(PG8_SB(0, 1), cB + hstepB, voffB); PG8_STAGE(PG8_SA(0, 1), cA + hstepA, voffA);
        if (wr == 1) PG8_BAR;
        PG8_WAIT_V(4); PG8_BAR;
        PG8_STAGE(PG8_SB(1, 0), cB + kstep, voffB); PG8_STAGE(PG8_SA(1, 0), cA + kstep, voffA); PG8_STAGE(PG8_SB(1, 1), cB + hstepB + kstep, voffB);
        PG8_WAIT_V(6); PG8_BAR;
    }
    for (;;) {
        const bool has_next = S.next(ui + 1, nxt);
        const char* nA = has_next ? S.pa(g, nxt, tstepA) : cA; const char* nB = has_next ? S.pb(g, nxt, tstepB) : cB;
        for (int t = 0; t < nt; t += 2) {
            const bool last = (t == nt - 2);
            const char* a1 = cA + (size_t)(t + 1) * kstep;
            const char* a2 = last ? nA : cA + (size_t)(t + 2) * kstep; const char* b2 = last ? nB : cB + (size_t)(t + 2) * kstep;
            const char* a3 = a2 + kstep; const char* b3 = b2 + kstep;
            if (last && has_next) S.a_ready(nxt);
            if constexpr (SP2) {
            PG8_LDB(B0, 0, 0); PG8_LDB(B1, 0, 1); PG8_SCHED; PG8_LDA(At, 0, 0); PG8_STAGE(PG8_SA(1, 1), a1 + hstepA, voffA);
            PG8_WAIT_V(8); PG8_WAIT_L(0); PG8_BAR; PG8_MMA(0, 0, At, B0); PG8_MMA(0, 1, At, B1); PG8_BAR; PG8_SCHED;
            PG8_LDA(At, 0, 1); PG8_STAGE(PG8_SB(0, 0), b2, voffB); PG8_STAGE(PG8_SB(0, 1), b2 + hstepB, voffB); PG8_STAGE(PG8_SA(0, 0), a2, voffA);
            PG8_WAIT_V(8); PG8_WAIT_L(0); PG8_BAR; PG8_MMA(1, 0, At, B0); PG8_MMA(1, 1, At, B1); PG8_BAR; PG8_SCHED;
            PG8_LDB(B0, 1, 0); PG8_LDB(B1, 1, 1); PG8_SCHED; PG8_LDA(At, 1, 0); PG8_STAGE(PG8_SA(0, 1), a2 + hstepA, voffA);
            PG8_WAIT_V(8); PG8_WAIT_L(0); PG8_BAR; PG8_MMA(0, 0, At, B0); PG8_MMA(0, 1, At, B1); PG8_BAR; PG8_SCHED;
            PG8_LDA(At, 1, 1); PG8_STAGE(PG8_SB(1, 0), b3, voffB); PG8_STAGE(PG8_SB(1, 1), b3 + hstepB, voffB); PG8_STAGE(PG8_SA(1, 0), a3, voffA);
            PG8_WAIT_V(8); PG8_WAIT_L(0); PG8_BAR; PG8_MMA(1, 0, At, B0); PG8_MMA(1, 1, At, B1); PG8_BAR; PG8_SCHED;
            } else {
            PG8_LDB(B0, 0, 0); PG8_SCHED; PG8_LDA(At, 0, 0); PG8_STAGE(PG8_SA(1, 1), a1 + hstepA, voffA);
            PG8_WAIT_L(8); PG8_BAR; PG8_WAIT_L(0); PG8_MMA(0, 0, At, B0); PG8_BAR; PG8_SCHED;
            PG8_LDB(B1, 0, 1); PG8_STAGE(PG8_SB(0, 0), b2, voffB);
            PG8_BAR; PG8_WAIT_L(0); PG8_MMA(0, 1, At, B1); PG8_BAR;
            PG8_LDA(At, 0, 1); PG8_STAGE(PG8_SA(0, 0), a2, voffA);
            PG8_BAR; PG8_WAIT_L(0); PG8_MMA(1, 0, At, B0); PG8_BAR; PG8_SCHED;
            PG8_STAGE(PG8_SB(0, 1), b2 + hstepB, voffB);
            PG8_WAIT_V(6); PG8_BAR; PG8_MMA(1, 1, At, B1); PG8_BAR;
            PG8_LDB(B0, 1, 0); PG8_SCHED; PG8_LDA(At, 1, 0); PG8_STAGE(PG8_SA(0, 1), a2 + hstepA, voffA);
            PG8_WAIT_L(8); PG8_BAR; PG8_WAIT_L(0); PG8_MMA(0, 0, At, B0); PG8_BAR; PG8_SCHED;
            PG8_LDB(B1, 1, 1); PG8_STAGE(PG8_SB(1, 0), b3, voffB);
            PG8_BAR; PG8_WAIT_L(0); PG8_MMA(0, 1, At, B1); PG8_BAR;
            PG8_LDA(At, 1, 1); PG8_STAGE(PG8_SA(1, 0), a3, voffA);
            PG8_BAR; PG8_WAIT_L(0); PG8_MMA(1, 0, At, B0); PG8_BAR; PG8_SCHED;
            PG8_STAGE(PG8_SB(1, 1), b3 + hstepB, voffB);
            PG8_WAIT_V(6); PG8_BAR; PG8_MMA(1, 1, At, B1); PG8_BAR;
            }
        }
        if constexpr (ALIGN_EPI) { if (wr == 0) PG8_BAR; }
        if constexpr (!Epi::AFTER_DRAIN) { E(acc, cur, wr, wc, fr, fq); S.done(cur); }
        if (!has_next) break;
        if (!S.keep(cur))
#pragma unroll
        for (int a = 0; a < 2; ++a)
#pragma unroll
            for (int b = 0; b < 2; ++b)
#pragma unroll
                for (int m = 0; m < 4; ++m)
#pragma unroll
                    for (int n = 0; n < 2; ++n) acc[a][b][m][n] = (f32x4){0.f, 0.f, 0.f, 0.f};
        cur = nxt; cA = nA; cB = nB; ++ui;
        if constexpr (ALIGN_EPI) { if (wr == 1) PG8_BAR; }
    }
    PG8_WAIT_V(0);
    if constexpr (!ALIGN_EPI) { if (wr == 0) PG8_BAR; }
    PG8_BAR;
    if constexpr (Epi::AFTER_DRAIN) { E.fused(acc, cur, wr, wc, fr, fq, lds, wid, lane); S.done(cur); }
#undef PG8_SA
#undef PG8_SB
#undef PG8_STAGE
#undef PG8_LDA
#undef PG8_LDB
#undef PG8_MMA
#undef PG8_WAIT_V
#undef PG8_WAIT_L
#undef PG8_BAR
#undef PG8_SCHED
}
}
#define GAS __attribute__((address_space(1)))
#define LAS __attribute__((address_space(3)))
typedef unsigned short bf16;
typedef unsigned v4u __attribute__((ext_vector_type(4)));
typedef float f32x4 __attribute__((ext_vector_type(4)));
typedef short bf16x8 __attribute__((ext_vector_type(8)));
typedef GAS unsigned gu32;
typedef GAS unsigned long long gu64;
#define RLX_AGENT __ATOMIC_RELAXED, __HIP_MEMORY_SCOPE_AGENT
#define LDS_WAIT() asm volatile("s_waitcnt lgkmcnt(0)" ::: "memory")
#define VM_WAIT() asm volatile("s_waitcnt vmcnt(0)" ::: "memory")
__device__ __forceinline__ unsigned long long rt() { return __builtin_amdgcn_s_memrealtime(); }
__device__ __forceinline__ unsigned f2bf(float f) { unsigned u = __builtin_bit_cast(unsigned, f); return (u + 0x7fffu + ((u >> 16) & 1u)) >> 16; }
__device__ __forceinline__ unsigned pk2(float lo, float hi) { return f2bf(lo) | (f2bf(hi) << 16); }

#define XB_TMO      128
#define XB_XCNT(j)  (256  + 64 * (j))
#define XB_XSUB(j)  (1280 + 64 * (j))
#define XB_XGEN(j)  (2304 + 64 * (j))
#define XB_TOP      3328
#define XB_TOPGEN   3392
#define XCD_BAR_WORDS 3456
#define XB_SPIN_CAP (1u << 18)

__device__ __forceinline__ unsigned xb_ld(unsigned* p)              { return __hip_atomic_load(p, __ATOMIC_RELAXED, __HIP_MEMORY_SCOPE_AGENT); }
__device__ __forceinline__ unsigned xb_add(unsigned* p, unsigned v) { return __hip_atomic_fetch_add(p, v, __ATOMIC_RELAXED, __HIP_MEMORY_SCOPE_AGENT); }
__device__ __forceinline__ unsigned xb_xcc_id() { return (unsigned)__builtin_amdgcn_s_getreg((3 << 11) | 20) & 0xFu; }
#define XB_SPIN(cond, bar) do { unsigned _sp = 0; while (cond) { __builtin_amdgcn_s_sleep(1); \
    if ((++_sp & 255u) == 0u) { if (xb_ld(&(bar)[XB_TMO])) break; if (_sp > XB_SPIN_CAP) { atomicAdd(&(bar)[XB_TMO], 1u); break; } } } } while (0)

struct XcdBarrier {
    unsigned* bar; unsigned x;
    volatile LAS unsigned* st;
};

__device__ __forceinline__ XcdBarrier xcd_barrier_post(unsigned* bar, volatile LAS unsigned* st) {
    XcdBarrier b; b.bar = bar; b.x = xb_xcc_id(); b.st = st;
    if (threadIdx.x == 0) (void)xb_add(&bar[XB_XCNT(b.x)], 1u);
    return b;
}
__device__ __forceinline__ void xcd_barrier_complete(unsigned* bar, unsigned x, unsigned& nloc, unsigned& nx) {
    const unsigned G = gridDim.x * gridDim.y * gridDim.z;
    unsigned sum, cnt, mine, sp = 0u;
    for (;;) {
        sum = 0u; cnt = 0u; mine = 0u;
#pragma unroll
        for (unsigned j = 0; j < 16; ++j) { const unsigned c = xb_ld(&bar[XB_XCNT(j)]); sum += c; cnt += (c > 0u) ? 1u : 0u; mine = (j == x) ? c : mine; }
        if (sum == G) break;
        __builtin_amdgcn_s_sleep(1);
        if ((++sp & 255u) == 0u) { if (xb_ld(&bar[XB_TMO])) break; if (sp > XB_SPIN_CAP) { atomicAdd(&bar[XB_TMO], 1u); break; } }
    }
    nloc = mine > 0u ? mine : 1u; nx = cnt > 0u ? cnt : 1u;
}

__device__ __forceinline__ void xcd_barrier(const XcdBarrier& b) {
    asm volatile("s_waitcnt vmcnt(0)" ::: "memory");
    __syncthreads();
    if (threadIdx.x == 0) {
        unsigned* bar = b.bar;
        __builtin_amdgcn_s_waitcnt(0);
        unsigned nloc = b.st[0], nx = b.st[1];
        if (nloc == 0u) { xcd_barrier_complete(bar, b.x, nloc, nx); b.st[0] = nloc; b.st[1] = nx; }
        const unsigned old = xb_add(&bar[XB_XSUB(b.x)], 1u);
        const unsigned gen = old / nloc;
        if (old + 1u == (gen + 1u) * nloc) {
            __builtin_amdgcn_fence(__ATOMIC_RELEASE, "agent");
            asm volatile("s_waitcnt vmcnt(0)" ::: "memory");
            const unsigned og = xb_add(&bar[XB_TOP], 1u);
            const unsigned tg = og / nx;
            if (og + 1u == (tg + 1u) * nx) xb_add(&bar[XB_TOPGEN], 1u);
            else XB_SPIN(xb_ld(&bar[XB_TOPGEN]) == tg, bar);
            __builtin_amdgcn_fence(__ATOMIC_ACQUIRE, "agent");
            xb_add(&bar[XB_XGEN(b.x)], 1u);
            asm volatile("s_waitcnt vmcnt(0)" ::: "memory");
        } else {
            XB_SPIN(xb_ld(&bar[XB_XGEN(b.x)]) == gen, bar);
            __builtin_amdgcn_fence(__ATOMIC_ACQUIRE, "agent");
            asm volatile("s_waitcnt vmcnt(0)" ::: "memory");
        }
    }
    __syncthreads();
}

constexpr int NWAVES = 8, NTHREADS = NWAVES * 64;
constexpr int BATCH = 4, SEQ = 2048, D = 4096, FF = 11008, M = BATCH * SEQ;
constexpr int CW = 2048, DNW = 2048, NH = 16, HD = 128, CH = 64, NCH = SEQ / CH;
constexpr int NPROJ = 22560, NPP = 22528;
constexpr int OFF_CX = 0, OFF_CC = 2048, OFF_CB = 4096, OFF_Q = 6144, OFF_Z = 12288, OFF_GA = 14336, OFF_GB = 18432;
constexpr int MEMT = 256, XW = 512;
constexpr float EPS = 1e-6f;
constexpr float SSQ_INVK = 1.0f / (4096.0f * 1048576.0f);
#ifndef PROBE_PHASE
#define PROBE_REPS 3
#define PROBE_SUB 0
#define PROBE_PHASE -1
#endif
constexpr int NPH = 15;

constexpr size_t MiB = 1u << 20;
constexpr size_t WS_CTL = 0, CTL_ZERO_BYTES = 1 * MiB;
constexpr size_t WS_W1GU = 1 * MiB, WS_W1D = 173 * MiB, WS_W2GU = 259 * MiB, WS_W2D = 431 * MiB, WS_WIN = 517 * MiB;
constexpr size_t WS_WA = 695 * MiB, WS_WB = 711 * MiB, WS_WO = 727 * MiB, WS_WQ = 759 * MiB, WS_WKV = 763 * MiB, WS_WXO = 771 * MiB;
constexpr size_t WS_XN = 775 * MiB;
constexpr size_t WS_R = 839 * MiB;
constexpr size_t WS_DN = 1195 * MiB;
constexpr size_t WS_WC = WS_DN, WS_UB = WS_DN + 64 * MiB, WS_QD = WS_DN + 128 * MiB, WS_KTT = WS_DN + 192 * MiB, WS_AQK = WS_DN + 256 * MiB, WS_GL = WS_DN + 288 * MiB;
constexpr size_t WS_TMP = WS_DN;
constexpr size_t WS_MN = 1484 * MiB, WS_KB = 1492 * MiB, WS_VT = 1493 * MiB, WS_AB = 1494 * MiB, WS_XNB = 1498 * MiB, WS_END = 1562 * MiB;
constexpr size_t WS_O = WS_W1GU, WS_CONVA = WS_W1GU + 64 * MiB, WS_ON = WS_W1GU + 96 * MiB, WS_XO = WS_W1GU + 136 * MiB;
constexpr size_t WS_QP = WS_O;
constexpr int CW_TMO = 0, CW_BAR = 4096;
constexpr size_t WS_SSQ = 65536;
constexpr int RING_BYTES = 131072;
constexpr int ATT_LDS = 256 * 272 + 128 * 528;
constexpr int MISC_OFF = 147456;
constexpr int LDS_BYTES = 151552;
static_assert(ATT_LDS <= MISC_OFF && MISC_OFF + 128 <= LDS_BYTES, "LDS map");

__device__ __forceinline__ float bfl(unsigned w) { return __uint_as_float(w << 16); }
__device__ __forceinline__ float bfh(unsigned w) { return __uint_as_float(w & 0xffff0000u); }
__device__ __forceinline__ float bf1(bf16 v) { return __uint_as_float(((unsigned)v) << 16); }
__device__ __forceinline__ float sigm(float x) { return __builtin_amdgcn_rcpf(1.0f + __builtin_amdgcn_exp2f(-1.4426950408889634f * x)); }
__device__ __forceinline__ float wave_sum(float v) {
#pragma unroll
    for (int o = 1; o < 64; o <<= 1) v += __shfl_xor(v, o);
    return v;
}

struct TwItem { int k0, n0, drow0; };
__device__ __forceinline__ TwItem tw_item(int item, int nblk, int mode, int roff) {
    TwItem t; const int kb = item / nblk, nb = item - kb * nblk; t.k0 = 64 * kb; t.n0 = 32 * nb;
    t.drow0 = (mode == 0) ? (roff + t.n0) : (mode == 3) ? ((t.n0 < 14336) ? t.n0 : (t.n0 < 14368) ? (NPP + t.n0 - 14336) : (t.n0 - 32))
                                          : (256 * (t.n0 >> 7) + 128 * (mode - 1) + (t.n0 & 127));
    return t;
}
__device__ __forceinline__ void tw_load(float (&r)[32], const float* W, int N, const TwItem& t, int lane) {
    const float* p = W + (size_t)(t.k0 + (lane >> 5)) * N + t.n0 + (lane & 31);
#pragma unroll
    for (int i = 0; i < 32; ++i) r[i] = __builtin_nontemporal_load(p + (size_t)(2 * i) * N);
}
__device__ __forceinline__ void tw_store(const float (&r)[32], bf16* WT, int ldk, const float* gain, const TwItem& t, LAS float* scr, int lane) {
#pragma unroll
    for (int i = 0; i < 32; ++i) scr[(2 * i + (lane >> 5)) * 33 + (lane & 31)] = r[i];
    LDS_WAIT(); asm volatile("" ::: "memory");
    const int c = lane & 7;
    f32x4 g0 = {1.f, 1.f, 1.f, 1.f}, g1 = {1.f, 1.f, 1.f, 1.f};
    if (gain) { g0 = *(const f32x4*)(gain + t.k0 + 8 * c); g1 = *(const f32x4*)(gain + t.k0 + 8 * c + 4); }
#pragma unroll
    for (int j = 0; j < 4; ++j) { const int n = (lane >> 3) + 8 * j; const LAS float* s = scr + (8 * c) * 33 + n;
        v4u o; o.x = pk2(s[0 * 33] * g0.x, s[1 * 33] * g0.y); o.y = pk2(s[2 * 33] * g0.z, s[3 * 33] * g0.w); o.z = pk2(s[4 * 33] * g1.x, s[5 * 33] * g1.y); o.w = pk2(s[6 * 33] * g1.z, s[7 * 33] * g1.w);
        *(v4u*)(WT + (size_t)(t.drow0 + n) * ldk + t.k0 + 8 * c) = o; }
    LDS_WAIT(); asm volatile("" ::: "memory");
}
__device__ __forceinline__ void transpose_weight(const float* W, int K, int N, bf16* WT, int ldk, int mode, int roff, const float* gain, LAS float* scr, int gw, int NGW, int lane) {
    const int nblk = N / 32, nitems = (K / 64) * nblk;
    int item = gw; if (item >= nitems) return;
    float ra[32], rb[32];
    TwItem ta = tw_item(item, nblk, mode, roff), tb = ta;
    tw_load(ra, W, N, ta, lane);
    for (;;) {
        bool hn = item + NGW < nitems;
        if (hn) { tb = tw_item(item + NGW, nblk, mode, roff); tw_load(rb, W, N, tb, lane); }
        tw_store(ra, WT, ldk, gain, ta, scr, lane);
        if (!hn) break;
        item += NGW; hn = item + NGW < nitems;
        if (hn) { ta = tw_item(item + NGW, nblk, mode, roff); tw_load(ra, W, N, ta, lane); }
        tw_store(rb, WT, ldk, gain, tb, scr, lane);
        if (!hn) break;
        item += NGW;
    }
}
template <bool OUT_F32>
__device__ __forceinline__ void rms_rows(const float* X, const float* w, void* out, int nrows, int gw, int NGW, int lane) {
    for (int m = gw; m < nrows; m += NGW) {
        const f32x4* xr = (const f32x4*)(X + (size_t)m * D) + lane;
        f32x4 v[16]; float s = 0.f;
#pragma unroll
        for (int j = 0; j < 16; ++j) { v[j] = xr[64 * j]; s += (v[j].x * v[j].x + v[j].y * v[j].y) + (v[j].z * v[j].z + v[j].w * v[j].w); }
        const float rstd = 1.0f / sqrtf(wave_sum(s) * (1.0f / D) + EPS);
        const f32x4* wr = (const f32x4*)w + lane;
        if (OUT_F32) { f32x4* o = (f32x4*)((float*)out + (size_t)m * D) + lane;
#pragma unroll
            for (int j = 0; j < 16; ++j) { const f32x4 g = wr[64 * j]; o[64 * j] = v[j] * rstd * g; }
        } else { unsigned long long* o8 = (unsigned long long*)((bf16*)out + (size_t)m * D) + lane;
#pragma unroll
            for (int j = 0; j < 16; ++j) { const f32x4 g = wr[64 * j]; const f32x4 y = v[j] * rstd * g;
                o8[64 * j] = (unsigned long long)pk2(y.x, y.y) | ((unsigned long long)pk2(y.z, y.w) << 32); } }
    }
}

__device__ __forceinline__ void final_norm(const bf16* HBp, const unsigned long long* ssq, const float* w, float* out, int gw, int NGW, int lane) {
    for (int m = gw; m < M; m += NGW) {
        const float rstd = 1.0f / sqrtf((float)ssq[m] * SSQ_INVK + EPS);
        const v4u* hr = (const v4u*)(HBp + (size_t)m * D) + lane; f32x4* o = (f32x4*)(out + (size_t)m * D) + 2 * lane; const f32x4* wr = (const f32x4*)w + 2 * lane;
#pragma unroll
        for (int j = 0; j < 8; ++j) { const v4u h = hr[64 * j]; const f32x4 g0 = wr[128 * j], g1 = wr[128 * j + 1];
            o[128 * j] = (f32x4){bfl(h.x), bfh(h.x), bfl(h.y), bfh(h.y)} * rstd * g0; o[128 * j + 1] = (f32x4){bfl(h.z), bfh(h.z), bfl(h.w), bfh(h.w)} * rstd * g1; }
    }
}

__device__ __forceinline__ void conv_branch_a(const bf16* proj, const float* conv_w, bf16* outA, int gtid, int NT) {
    for (int idx = gtid; idx < M * (CW / 8); idx += NT) {
        const int row = idx >> 8, c0 = (idx & 255) * 8, s = row & (SEQ - 1);
        float y[8];
#pragma unroll
        for (int e = 0; e < 8; ++e) y[e] = 0.f;
#pragma unroll
        for (int k = 0; k < 3; ++k) {
            const int sk = s - 2 + k; const float mk = (sk >= 0) ? 1.f : 0.f;
            const bf16* pr = proj + (size_t)(sk >= 0 ? row - 2 + k : row) * NPP;
            const v4u xc = *(const v4u*)(pr + OFF_CX + c0), cc = *(const v4u*)(pr + OFF_CC + c0);
            const f32x4 w0 = *(const f32x4*)(conv_w + k * CW + c0) * mk, w1 = *(const f32x4*)(conv_w + k * CW + c0 + 4) * mk;
            y[0] += w0.x * (bfl(xc.x) * bfl(cc.x)); y[1] += w0.y * (bfh(xc.x) * bfh(cc.x)); y[2] += w0.z * (bfl(xc.y) * bfl(cc.y)); y[3] += w0.w * (bfh(xc.y) * bfh(cc.y));
            y[4] += w1.x * (bfl(xc.z) * bfl(cc.z)); y[5] += w1.y * (bfh(xc.z) * bfh(cc.z)); y[6] += w1.z * (bfl(xc.w) * bfl(cc.w)); y[7] += w1.w * (bfh(xc.w) * bfh(cc.w));
        }
        const v4u cb = *(const v4u*)(proj + (size_t)row * NPP + OFF_CB + c0);
        v4u o; o.x = pk2(y[0] * bfl(cb.x), y[1] * bfh(cb.x)); o.y = pk2(y[2] * bfl(cb.y), y[3] * bfh(cb.y)); o.z = pk2(y[4] * bfl(cb.z), y[5] * bfh(cb.z)); o.w = pk2(y[6] * bfl(cb.w), y[7] * bfh(cb.w));
        *(v4u*)(outA + (size_t)row * CW + c0) = o;
    }
}

constexpr int XS = 136, LS = 68;
constexpr int CH_LDS = 3 * 64 * XS * 2 + 64 * LS * 4 + 4 * 64 * 4;
static_assert(2 * CH_LDS <= MISC_OFF, "two chunks per workgroup");
__device__ __forceinline__ void dn_chunk_pair(const bf16* proj, const float* AB, const unsigned long long* ssq, const float* qkv_w, const float* a_log, const float* dt_bias, unsigned char* ws, LAS unsigned char* lds, int pair, int tid) {
    const int lane = tid & 63, wave = __builtin_amdgcn_readfirstlane(tid >> 6), half = wave >> 2, wv = wave & 3, th = tid & 255;
    const int cid = pair * 2 + half, bh = cid >> 5, n = cid & 31, b = bh >> 4, h = bh & 15;
    LAS unsigned char* hb = lds + half * CH_LDS;
    LAS bf16* Qb = (LAS bf16*)hb; LAS bf16* Kb = Qb + 64 * XS; LAS bf16* Vb = Kb + 64 * XS; LAS float* Lt = (LAS float*)(Vb + 64 * XS);
    LAS float* GC = Lt + 64 * LS; LAS float* BETA = GC + 64; LAS float* EGC = BETA + 64; LAS float* ETAIL = EGC + 64;
    const size_t rowb = (size_t)b * SEQ;
    bf16* WC = (bf16*)(ws + WS_WC) + (size_t)cid * 8192; float* UB = (float*)(ws + WS_UB) + (size_t)cid * 8192; bf16* QD = (bf16*)(ws + WS_QD) + (size_t)cid * 8192;
    bf16* KTT = (bf16*)(ws + WS_KTT) + (size_t)cid * 8192; bf16* AQK = (bf16*)(ws + WS_AQK) + (size_t)cid * 4096; float* GL = (float*)(ws + WS_GL);
    float egc_l, etail_l;
    {
        const size_t row = rowb + n * CH + lane;
        float al = 0.f, bl = 0.f;
#pragma unroll
        for (int q = 0; q < 4; ++q) { al += AB[(size_t)q * M * 32 + row * 32 + 16 + h]; bl += AB[(size_t)q * M * 32 + row * 32 + h]; }
        const float rs = 1.0f / sqrtf((float)ssq[row] * SSQ_INVK + EPS); al *= rs; bl *= rs;
        const float xx = al + dt_bias[h];
        const float sp = fmaxf(xx, 0.f) + log1pf(expf(-fabsf(xx)));
        float g = -expf(a_log[h]) * sp;
#pragma unroll
        for (int d = 1; d < 64; d <<= 1) { const float t = __shfl_up(g, d); if (lane >= d) g += t; }
        const float glast = __shfl(g, 63);
        egc_l = expf(g); etail_l = expf(glast - g);
        if (wv == 0) { GC[lane] = g; BETA[lane] = 1.0f / (1.0f + expf(-bl)); EGC[lane] = egc_l; ETAIL[lane] = etail_l; if (lane == 63) GL[cid] = expf(glast); }
    }
    {
        const int c0 = (th & 15) * 8, i0 = (th >> 4) * 4;
#pragma unroll
        for (int mat = 0; mat < 3; ++mat) {
            const int wcol = mat * DNW + h * HD + c0;
            f32x4 w[4][2];
#pragma unroll
            for (int j = 0; j < 4; ++j) { w[j][0] = *(const f32x4*)(qkv_w + j * (3 * DNW) + wcol); w[j][1] = *(const f32x4*)(qkv_w + j * (3 * DNW) + wcol + 4); }
            v4u raw[7];
#pragma unroll
            for (int t = 0; t < 7; ++t) { const int st = n * CH + i0 - 3 + t; raw[t] = *(const v4u*)(proj + (rowb + (st >= 0 ? st : 0)) * NPP + OFF_Q + wcol); if (st < 0) raw[t] = (v4u){0u, 0u, 0u, 0u}; }
            LAS bf16* X = (mat == 0) ? Qb : (mat == 1) ? Kb : Vb;
#pragma unroll
            for (int j4 = 0; j4 < 4; ++j4) {
                const int i = i0 + j4;
                f32x4 a0 = {0.f, 0.f, 0.f, 0.f}, a1 = {0.f, 0.f, 0.f, 0.f};
#pragma unroll
                for (int j = 0; j < 4; ++j) { const v4u r = raw[j4 + j];
                    a0.x += w[j][0].x * bfl(r.x); a0.y += w[j][0].y * bfh(r.x); a0.z += w[j][0].z * bfl(r.y); a0.w += w[j][0].w * bfh(r.y);
                    a1.x += w[j][1].x * bfl(r.z); a1.y += w[j][1].y * bfh(r.z); a1.z += w[j][1].z * bfl(r.w); a1.w += w[j][1].w * bfh(r.w); }
#pragma unroll
                for (int e = 0; e < 4; ++e) { a0[e] = a0[e] * sigm(a0[e]); a1[e] = a1[e] * sigm(a1[e]); }
                if (mat < 2) {
                    float ss = (a0.x * a0.x + a0.y * a0.y) + (a0.z * a0.z + a0.w * a0.w) + (a1.x * a1.x + a1.y * a1.y) + (a1.z * a1.z + a1.w * a1.w);
                    ss += __shfl_xor(ss, 1); ss += __shfl_xor(ss, 2); ss += __shfl_xor(ss, 4); ss += __shfl_xor(ss, 8);
                    float sc = 1.0f / sqrtf(ss + EPS); if (mat == 0) sc *= 0.08838834764831845f;
                    a0 = a0 * sc; a1 = a1 * sc;
                }
                v4u o; o.x = pk2(a0.x, a0.y); o.y = pk2(a0.z, a0.w); o.z = pk2(a1.x, a1.y); o.w = pk2(a1.z, a1.w);
                *(LAS v4u*)(X + i * XS + c0) = o;
                if (mat == 0) { const float eg = __shfl(egc_l, i); a0 = a0 * eg; a1 = a1 * eg;
                    v4u q; q.x = pk2(a0.x, a0.y); q.y = pk2(a0.z, a0.w); q.z = pk2(a1.x, a1.y); q.w = pk2(a1.z, a1.w); *(v4u*)(QD + i * 128 + c0) = q; }
            }
        }
    }
    __syncthreads();
    {
        { const float et = etail_l; const int i = lane;
#pragma unroll 8
          for (int p = 0; p < 32; ++p) { const int d = wv + 4 * p; KTT[d * 64 + i] = (bf16)f2bf(bf1(Kb[i * XS + d]) * et); } }
        const int r = lane & 15, kq = lane >> 4;
        for (int job = wv; job < 26; job += 4) {
            int prod, it, jt;
            if (job < 10) { prod = 0; it = (job >= 6) ? 3 : (job >= 3) ? 2 : (job >= 1) ? 1 : 0; jt = job - (it * (it + 1)) / 2; }
            else { prod = 1; it = (job - 10) >> 2; jt = (job - 10) & 3; }
            f32x4 acc = {0.f, 0.f, 0.f, 0.f};
            if (jt <= it) {
                const LAS bf16* Ab = (prod ? Qb : Kb) + (16 * it + r) * XS + 8 * kq; const LAS bf16* Bb = Kb + (16 * jt + r) * XS + 8 * kq;
#pragma unroll
                for (int ks = 0; ks < 4; ++ks) acc = __builtin_amdgcn_mfma_f32_16x16x32_bf16(*(const LAS bf16x8*)(Ab + 32 * ks), *(const LAS bf16x8*)(Bb + 32 * ks), acc, 0, 0, 0);
            }
            const int jx = 16 * jt + r; const float gcj = GC[jx];
            f32x4 o;
#pragma unroll
            for (int reg = 0; reg < 4; ++reg) { const int ix = 16 * it + 4 * kq + reg; const float dec = expf(GC[ix] - gcj);
                if (prod == 0) o[reg] = (ix > jx) ? BETA[ix] * acc[reg] * dec : 0.f;
                else o[reg] = (ix >= jx) ? acc[reg] * dec : 0.f; }
            if (prod == 0) *(LAS f32x4*)(Lt + jx * LS + 16 * it + 4 * kq) = o;
            else {
#pragma unroll
                for (int reg = 0; reg < 4; ++reg) AQK[(16 * it + 4 * kq + reg) * 64 + jx] = (bf16)f2bf(o[reg]); }
        }
    }
    __syncthreads();
    {
        const int col = th;
        int zv = 0; asm volatile("" : "+v"(zv));
        const LAS float* LtV = Lt + zv; const LAS float* BV = BETA + zv; const LAS float* EV = EGC + zv;
        const LAS bf16* src = (col < 128) ? (Vb + col) : (Kb + (col - 128));
        float x[64];
#pragma unroll
        for (int i = 0; i < 64; ++i) { float sc = BV[i]; if (col >= 128) sc *= EV[i]; x[i] = bf1(src[i * XS]) * sc; }
#pragma unroll
        for (int j = 0; j < 63; ++j) {
            const float xj = x[j];
#pragma unroll
            for (int ii = (j + 1) >> 2; ii < 16; ++ii) { const f32x4 l4 = *(const LAS f32x4*)(LtV + j * LS + 4 * ii);
#pragma unroll
                for (int e = 0; e < 4; ++e) { if (4 * ii + e > j) x[4 * ii + e] -= l4[e] * xj; } }
        }
        if (col < 128) {
#pragma unroll
            for (int i = 0; i < 64; ++i) UB[i * 128 + col] = x[i];
        } else {
#pragma unroll
            for (int i = 0; i < 64; ++i) WC[i * 128 + col - 128] = (bf16)f2bf(-x[i]);
        }
    }
    __syncthreads();
}

constexpr int SSB = 136, USB = 72;
#define LDS_BARRIER() do { asm volatile("s_waitcnt lgkmcnt(0)" ::: "memory"); __builtin_amdgcn_s_barrier(); asm volatile("" ::: "memory"); } while (0)
__device__ __forceinline__ unsigned long long pk4(const f32x4 v) { return (unsigned long long)pk2(v.x, v.y) | ((unsigned long long)pk2(v.z, v.w) << 32); }
struct ScanOps { bf16x8 wcf[4], qdf[4], aqf[2], ktf[2]; f32x4 ubv; };
struct SideJob { const float* Wg; const float* Wu; const float* Wd; bf16* Tgu; bf16* Td; const float* gain; LAS float* scr; int q0; };
__device__ __forceinline__ void side_item(const SideJob& J, int q, const float*& W, int& N, bf16*& WT, int& ldk, const float*& gain, TwItem& t) {
    constexpr int IG = (D / 64) * (FF / 32);
    if (q < IG) { W = J.Wg; N = FF; WT = J.Tgu; ldk = D; gain = J.gain; t = tw_item(q, FF / 32, 1, 0); }
    else if (q < 2 * IG) { W = J.Wu; N = FF; WT = J.Tgu; ldk = D; gain = J.gain; t = tw_item(q - IG, FF / 32, 2, 0); }
    else { W = J.Wd; N = D; WT = J.Td; ldk = FF; gain = nullptr; t = tw_item(q - 2 * IG, D / 32, 0, 0); }
}
constexpr int SIDE_ITEMS = 2048 * NCH;
struct ScanPtrs { const bf16* WCb; const bf16* QDb; const bf16* KTb; const bf16* AQb; const float* UBb; const float* GLb; int offW, offA, offK, offU; };
__device__ __forceinline__ void scan_load_a(ScanOps& o, const ScanPtrs& p, int n) {
#pragma unroll
    for (int ks = 0; ks < 4; ++ks) { o.wcf[ks] = *(const bf16x8*)(p.WCb + (size_t)n * 8192 + p.offW + 32 * ks); o.qdf[ks] = *(const bf16x8*)(p.QDb + (size_t)n * 8192 + p.offW + 32 * ks); }
#pragma unroll
    for (int reg = 0; reg < 4; ++reg) o.ubv[reg] = p.UBb[(size_t)n * 8192 + p.offU + reg * 128];
}
__device__ __forceinline__ void scan_load_b(ScanOps& o, const ScanPtrs& p, int n) {
#pragma unroll
    for (int ks = 0; ks < 2; ++ks) { o.aqf[ks] = *(const bf16x8*)(p.AQb + (size_t)n * 4096 + p.offA + 32 * ks); o.ktf[ks] = *(const bf16x8*)(p.KTb + (size_t)n * 8192 + p.offK + 32 * ks); }
}
__device__ __forceinline__ void scan_step(const ScanOps& cur, ScanOps& nxt, const ScanPtrs& p, LAS bf16* St, LAS bf16* Ut, f32x4& s0, f32x4& s1, float* orow, float gl, int nn, int r, int kq, int rt, int ct, int wave,
                                          const SideJob& J, const float (&sc_cur)[32], float (&sc_nxt)[32], int qcur, int qnxt, int lane) {
    f32x4 accU = cur.ubv, accO = {0.f, 0.f, 0.f, 0.f};
    const LAS bf16* srow = St + (16 * ct + r) * SSB + 8 * kq;
#pragma unroll
    for (int ks = 0; ks < 4; ++ks) { const bf16x8 sf = *(const LAS bf16x8*)(srow + 32 * ks);
        accU = __builtin_amdgcn_mfma_f32_16x16x32_bf16(cur.wcf[ks], sf, accU, 0, 0, 0); accO = __builtin_amdgcn_mfma_f32_16x16x32_bf16(cur.qdf[ks], sf, accO, 0, 0, 0); }
    *(LAS unsigned long long*)(Ut + (16 * ct + r) * USB + 16 * rt + 4 * kq) = pk4(accU);
    scan_load_a(nxt, p, nn);
    { const float* W; int N; bf16* WT; int ldk; const float* gain; TwItem t; if (qnxt >= 0) { side_item(J, qnxt, W, N, WT, ldk, gain, t); tw_load(sc_nxt, W, N, t, lane); } }
    LDS_BARRIER();
    const LAS bf16* urow = Ut + (16 * ct + r) * USB + 8 * kq;
#pragma unroll
    for (int ks = 0; ks < 2; ++ks) { const bf16x8 uf = *(const LAS bf16x8*)(urow + 32 * ks); accO = __builtin_amdgcn_mfma_f32_16x16x32_bf16(cur.aqf[ks], uf, accO, 0, 0, 0); }
#pragma unroll
    for (int reg = 0; reg < 4; ++reg) orow[(size_t)reg * DNW] = accO[reg];
    s0 = s0 * gl; s1 = s1 * gl;
    const LAS bf16* u0 = Ut + r * USB + 8 * kq; const LAS bf16* u1 = Ut + (16 + r) * USB + 8 * kq;
#pragma unroll
    for (int ks = 0; ks < 2; ++ks) { const bf16x8 a8 = *(const LAS bf16x8*)(u0 + 32 * ks), b8 = *(const LAS bf16x8*)(u1 + 32 * ks);
        s0 = __builtin_amdgcn_mfma_f32_16x16x32_bf16(cur.ktf[ks], a8, s0, 0, 0, 0); s1 = __builtin_amdgcn_mfma_f32_16x16x32_bf16(cur.ktf[ks], b8, s1, 0, 0, 0); }
    scan_load_b(nxt, p, nn);
    { const float* W; int N; bf16* WT; int ldk; const float* gain; TwItem t; if (qcur >= 0) { side_item(J, qcur, W, N, WT, ldk, gain, t); tw_store(sc_cur, WT, ldk, gain, t, J.scr, lane); } }
    *(LAS unsigned long long*)(St + r * SSB + 16 * wave + 4 * kq) = pk4(s0); *(LAS unsigned long long*)(St + (16 + r) * SSB + 16 * wave + 4 * kq) = pk4(s1);
    LDS_BARRIER();
}
__device__ __forceinline__ void dn_scan_unit(unsigned char* ws, LAS unsigned char* lds, float* O, int unit, int tid, SideJob J) {
    const int lane = tid & 63, wave = __builtin_amdgcn_readfirstlane(tid >> 6), r = lane & 15, kq = lane >> 4;
    const int bh = unit >> 2, vs = unit & 3, b = bh >> 4, h = bh & 15;
    const int rt = wave >> 1, ct = wave & 1;
    LAS bf16* St = (LAS bf16*)lds; LAS bf16* Ut = St + 32 * SSB;
    for (int i = tid; i < 32 * SSB / 2; i += NTHREADS) ((LAS unsigned*)St)[i] = 0u;
    f32x4 s0 = {0.f, 0.f, 0.f, 0.f}, s1 = {0.f, 0.f, 0.f, 0.f};
    ScanPtrs p;
    p.offW = (16 * rt + r) * 128 + 8 * kq; p.offA = (16 * rt + r) * 64 + 8 * kq; p.offK = (16 * wave + r) * 64 + 8 * kq; p.offU = (16 * rt + 4 * kq) * 128 + vs * 32 + 16 * ct + r;
    p.WCb = (const bf16*)(ws + WS_WC) + (size_t)bh * NCH * 8192; p.UBb = (const float*)(ws + WS_UB) + (size_t)bh * NCH * 8192; p.QDb = (const bf16*)(ws + WS_QD) + (size_t)bh * NCH * 8192;
    p.KTb = (const bf16*)(ws + WS_KTT) + (size_t)bh * NCH * 8192; p.AQb = (const bf16*)(ws + WS_AQK) + (size_t)bh * NCH * 4096; p.GLb = (const float*)(ws + WS_GL) + (size_t)bh * NCH;
    ScanOps A, B;
    scan_load_a(A, p, 0); scan_load_b(A, p, 0);
    float scA[32], scB[32];
    J.scr = (LAS float*)(lds + 16384 + wave * 8704);
    { const float* W; int N; bf16* WT; int ldk; const float* gain; TwItem t; side_item(J, J.q0, W, N, WT, ldk, gain, t); tw_load(scA, W, N, t, lane); }
    const int glall = __float_as_int(p.GLb[lane & 31]);
    LDS_BARRIER();
    float* orow = O + ((size_t)b * SEQ + 16 * rt + 4 * kq) * DNW + h * HD + vs * 32 + 16 * ct + r;
#pragma unroll
    for (int n = 0; n < NCH; n += 2) {
        scan_step(A, B, p, St, Ut, s0, s1, orow + (size_t)n * CH * DNW, __int_as_float(__builtin_amdgcn_readlane(glall, n)), n + 1, r, kq, rt, ct, wave, J, scA, scB, J.q0 + n, J.q0 + n + 1, lane);
        scan_step(B, A, p, St, Ut, s0, s1, orow + (size_t)(n + 1) * CH * DNW, __int_as_float(__builtin_amdgcn_readlane(glall, n + 1)), (n + 2 < NCH) ? n + 2 : n + 1, r, kq, rt, ct, wave, J, scB, scA, J.q0 + n + 1, (n + 2 < NCH) ? J.q0 + n + 2 : -1, lane);
    }
    __syncthreads();
}

__device__ __forceinline__ void ab_logits(const bf16* XN, const bf16* Wab, float* ABP, int job, int lane) {
    const int r = lane & 15, kq = lane >> 4, tile = job >> 2, q = job & 3;
    const bf16* ap = XN + (size_t)(16 * tile + r) * D + q * (D / 4) + 8 * kq; const bf16* b0p = Wab + (size_t)r * D + q * (D / 4) + 8 * kq; const bf16* b1p = b0p + (size_t)16 * D;
    f32x4 acc0 = {0.f, 0.f, 0.f, 0.f}, acc1 = {0.f, 0.f, 0.f, 0.f};
#pragma unroll 16
    for (int ks = 0; ks < D / 128; ++ks) { const bf16x8 a = *(const bf16x8*)(ap + 32 * ks), b0 = *(const bf16x8*)(b0p + 32 * ks), b1 = *(const bf16x8*)(b1p + 32 * ks);
        acc0 = __builtin_amdgcn_mfma_f32_16x16x32_bf16(a, b0, acc0, 0, 0, 0); acc1 = __builtin_amdgcn_mfma_f32_16x16x32_bf16(a, b1, acc1, 0, 0, 0); }
    float* o = ABP + (size_t)q * M * 32 + (size_t)(16 * tile + 4 * kq) * 32 + r;
#pragma unroll
    for (int reg = 0; reg < 4; ++reg) { o[reg * 32] = acc0[reg]; o[reg * 32 + 16] = acc1[reg]; }
}

__device__ __forceinline__ void dn_gated_norm(const float* O, const bf16* proj, const float* wn, bf16* ON, int gtid, int NT) {
    for (int idx = gtid; idx < M * NH * 16; idx += NT) {
        const int pair = idx >> 4, sub = idx & 15, row = pair >> 4, h = pair & 15, c = h * HD + sub * 8;
        const f32x4 o0 = *(const f32x4*)(O + (size_t)row * DNW + c), o1 = *(const f32x4*)(O + (size_t)row * DNW + c + 4);
        float ss = (o0.x * o0.x + o0.y * o0.y) + (o0.z * o0.z + o0.w * o0.w) + (o1.x * o1.x + o1.y * o1.y) + (o1.z * o1.z + o1.w * o1.w);
        ss += __shfl_xor(ss, 1); ss += __shfl_xor(ss, 2); ss += __shfl_xor(ss, 4); ss += __shfl_xor(ss, 8);
        const float rstd = 1.0f / sqrtf(ss * (1.0f / HD) + EPS);
        const v4u z = *(const v4u*)(proj + (size_t)row * NPP + OFF_Z + c);
        const f32x4 w0 = *(const f32x4*)(wn + sub * 8), w1 = *(const f32x4*)(wn + sub * 8 + 4);
        const float z0 = bfl(z.x), z1 = bfh(z.x), z2 = bfl(z.y), z3 = bfh(z.y), z4 = bfl(z.z), z5 = bfh(z.z), z6 = bfl(z.w), z7 = bfh(z.w);
        v4u o; o.x = pk2(o0.x * rstd * w0.x * (z0 * sigm(z0)), o0.y * rstd * w0.y * (z1 * sigm(z1))); o.y = pk2(o0.z * rstd * w0.z * (z2 * sigm(z2)), o0.w * rstd * w0.w * (z3 * sigm(z3)));
        o.z = pk2(o1.x * rstd * w1.x * (z4 * sigm(z4)), o1.y * rstd * w1.y * (z5 * sigm(z5))); o.w = pk2(o1.z * rstd * w1.z * (z6 * sigm(z6)), o1.w * rstd * w1.w * (z7 * sigm(z7)));
        *(v4u*)(ON + (size_t)row * DNW + c) = o;
    }
}

__device__ __forceinline__ void xattn_unit(const float* QP, const unsigned long long* ssq, const bf16* KB, const bf16* VT, bf16* XO, LAS unsigned char* lds, int unit, int tid) {
    const int lane = tid & 63, wave = __builtin_amdgcn_readfirstlane(tid >> 6), r = lane & 15, kq = lane >> 4;
    const int b = unit >> 6, hd = (unit >> 4) & 3, qt = unit & 15;
    LAS unsigned char* Ksm = lds; LAS unsigned char* Vtm = lds + 256 * 272;
    {
        const int seg = tid & 15, rr = tid >> 4;
#pragma unroll
        for (int p = 0; p < 8; ++p) { const int key = rr + 32 * p; const v4u v = *(const v4u*)(KB + (size_t)(b * MEMT + key) * XW + hd * HD + seg * 8); *(LAS v4u*)(Ksm + key * 272 + seg * 16) = v; }
        const int seg2 = tid & 31, r2 = tid >> 5;
#pragma unroll
        for (int p = 0; p < 8; ++p) { const int d = r2 + 16 * p; const v4u v = *(const v4u*)(VT + ((size_t)(b * 4 + hd) * HD + d) * MEMT + seg2 * 8); *(LAS v4u*)(Vtm + d * 528 + seg2 * 16) = v; }
    }
    const size_t qrow = (size_t)b * SEQ + qt * 128 + wave * 16 + r;
    bf16x8 qf[4];
    const float qs = 0.08838834764831845f * 1.4426950408889634f / sqrtf((float)ssq[qrow] * SSQ_INVK + EPS);
#pragma unroll
    for (int ks = 0; ks < 4; ++ks) { const float* qp = QP + qrow * XW + hd * HD + 32 * ks + 8 * kq; f32x4 a = {0.f, 0.f, 0.f, 0.f}, c = {0.f, 0.f, 0.f, 0.f};
#pragma unroll
        for (int g = 0; g < 4; ++g) { a += *(const f32x4*)(qp + (size_t)g * M * XW); c += *(const f32x4*)(qp + (size_t)g * M * XW + 4); }
        a = a * qs; c = c * qs;
        v4u w; w.x = pk2(a.x, a.y); w.y = pk2(a.z, a.w); w.z = pk2(c.x, c.y); w.w = pk2(c.z, c.w); qf[ks] = __builtin_bit_cast(bf16x8, w); }
    __syncthreads();
    f32x4 sc[16];
#pragma unroll
    for (int t = 0; t < 16; ++t) { sc[t] = (f32x4){0.f, 0.f, 0.f, 0.f};
#pragma unroll
        for (int ks = 0; ks < 4; ++ks) { const bf16x8 kf = *(const LAS bf16x8*)(Ksm + (16 * t + r) * 272 + (32 * ks + 8 * kq) * 2);
            sc[t] = __builtin_amdgcn_mfma_f32_16x16x32_bf16(kf, qf[ks], sc[t], 0, 0, 0); } }
    float mx = -3.0e38f;
#pragma unroll
    for (int t = 0; t < 16; ++t) mx = fmaxf(mx, fmaxf(fmaxf(sc[t].x, sc[t].y), fmaxf(sc[t].z, sc[t].w)));
    mx = fmaxf(mx, __shfl_xor(mx, 16)); mx = fmaxf(mx, __shfl_xor(mx, 32));
    float sum = 0.f;
#pragma unroll
    for (int t = 0; t < 16; ++t) {
#pragma unroll
        for (int e = 0; e < 4; ++e) { sc[t][e] = __builtin_amdgcn_exp2f(sc[t][e] - mx); sum += sc[t][e]; } }
    sum += __shfl_xor(sum, 16); sum += __shfl_xor(sum, 32);
    const float inv = 1.0f / sum;
    bf16x8 pf[8];
#pragma unroll
    for (int s = 0; s < 8; ++s) { v4u w; w.x = pk2(sc[2 * s].x, sc[2 * s].y); w.y = pk2(sc[2 * s].z, sc[2 * s].w); w.z = pk2(sc[2 * s + 1].x, sc[2 * s + 1].y); w.w = pk2(sc[2 * s + 1].z, sc[2 * s + 1].w);
        pf[s] = __builtin_bit_cast(bf16x8, w); }
#pragma unroll
    for (int dt = 0; dt < 8; ++dt) { f32x4 o = {0.f, 0.f, 0.f, 0.f};
#pragma unroll
        for (int s = 0; s < 8; ++s) { const LAS unsigned char* vp = Vtm + (16 * dt + r) * 528 + (32 * s + 4 * kq) * 2;
            const unsigned long long lo = *(const LAS unsigned long long*)vp, hi = *(const LAS unsigned long long*)(vp + 32);
            v4u w; w.x = (unsigned)lo; w.y = (unsigned)(lo >> 32); w.z = (unsigned)hi; w.w = (unsigned)(hi >> 32);
            o = __builtin_amdgcn_mfma_f32_16x16x32_bf16(__builtin_bit_cast(bf16x8, w), pf[s], o, 0, 0, 0); }
        o = o * inv;
        *(unsigned long long*)(XO + qrow * XW + hd * HD + 16 * dt + 4 * kq) = (unsigned long long)pk2(o.x, o.y) | ((unsigned long long)pk2(o.z, o.w) << 32); }
    __syncthreads();
}

struct Args { const float* in[27]; float* out; unsigned char* ws; int ph_lo, ph_hi; };
enum { I_X = 0, I_MEM, I_F1N, I_F1G, I_F1U, I_F1D, I_MIXN, I_WIN, I_CONVW, I_QKVW, I_ALOG, I_DTB, I_DNN, I_WOC, I_WOD, I_WO, I_XAN, I_MEMN, I_XWQ, I_XWK, I_XWV, I_XWO, I_F2N, I_F2G, I_F2U, I_F2D, I_FINN };

typedef const __attribute__((address_space(4))) Args* KArgs;
__device__ __forceinline__ KArgs kargs() { KArgs p = (KArgs)__builtin_amdgcn_kernarg_segment_ptr(); asm volatile("" : "+s"(p)); return p; }
#define PH_BEGIN KArgs A = kargs(); unsigned char* const ws = A->ws; (void)ws;
#define W1GU ((bf16*)(ws + WS_W1GU))
#define W1D ((bf16*)(ws + WS_W1D))
#define W2GU ((bf16*)(ws + WS_W2GU))
#define W2D ((bf16*)(ws + WS_W2D))
#define WIN ((bf16*)(ws + WS_WIN))
#define WA ((bf16*)(ws + WS_WA))
#define WB ((bf16*)(ws + WS_WB))
#define WO ((bf16*)(ws + WS_WO))
#define WQ ((bf16*)(ws + WS_WQ))
#define WKV ((bf16*)(ws + WS_WKV))
#define WXO ((bf16*)(ws + WS_WXO))
#define XN ((bf16*)(ws + WS_XN))
#define ACT ((bf16*)(ws + WS_R))
#define PROJ ((bf16*)(ws + WS_R))
#define MN ((bf16*)(ws + WS_MN))
#define KB ((bf16*)(ws + WS_KB))
#define VT ((bf16*)(ws + WS_VT))
#define OB ((float*)(ws + WS_O))
#define CONVA ((bf16*)(ws + WS_CONVA))
#define ON ((bf16*)(ws + WS_ON))
#define QP ((float*)(ws + WS_QP))
#define AB ((float*)(ws + WS_AB))
#define HB ((bf16*)(ws + WS_XNB))
#define SSQ(i) ((unsigned long long*)(ws + WS_SSQ) + (i) * M)
#define XO ((bf16*)(ws + WS_XO))
#define H (A->out)
#define INP(i) (A->in[i])
__global__ void __launch_bounds__(NTHREADS, 2) fwd_kernel(Args args) {
    extern __shared__ __attribute__((aligned(16))) unsigned char lds_raw[];
    LAS unsigned char* lds = (LAS unsigned char*)lds_raw;
    volatile LAS unsigned* MISC = (volatile LAS unsigned*)(lds + MISC_OFF);
    const int tid = threadIdx.x, lane = tid & 63, wave = __builtin_amdgcn_readfirstlane(tid >> 6);
    const int G = gridDim.x, bx = blockIdx.x;
    const int vcu = (G % 8 == 0) ? (bx % 8) * (G / 8) + bx / 8 : bx;
    const int gw = vcu * NWAVES + wave, NGW = G * NWAVES, gtid = vcu * NTHREADS + tid, NT = G * NTHREADS;
    gu32* ctl = (gu32*)(args.ws + WS_CTL);
    for (int u = tid; u < (LDS_BYTES - MISC_OFF) / 4; u += NTHREADS) ((LAS unsigned*)(lds + MISC_OFF))[u] = 0u;
    __syncthreads();
    XcdBarrier bar; bar.bar = (unsigned*)(ctl + CW_BAR); bar.x = 0; bar.st = nullptr;
    const int lo = args.ph_lo, hi = args.ph_hi;
    if (hi - lo > 1) bar = xcd_barrier_post((unsigned*)(ctl + CW_BAR), MISC + 8);
#define IN(k) (lo <= (k) && (k) < hi)
#define SEAM(k) do { if (IN(k) && IN((k) + 1)) xcd_barrier(bar); } while (0)
    if (IN(0)) for (int rep_ = 0; rep_ < (PROBE_PHASE == 0 ? PROBE_REPS : 1); ++rep_) { PH_BEGIN
        LAS float* scr = (LAS float*)(lds + wave * 16384);
        transpose_weight(INP(I_F1D), FF, D, W1D, FF, 0, 0, nullptr, scr, gw, NGW, lane);
        transpose_weight(INP(I_WIN), D, NPROJ, WIN, D, 3, 0, INP(I_MIXN), scr, gw, NGW, lane);
        transpose_weight(INP(I_XWQ), D, XW, WQ, D, 0, 0, INP(I_XAN), scr, gw, NGW, lane);
        transpose_weight(INP(I_XWK), D, XW, WKV, D, 0, 0, nullptr, scr, gw, NGW, lane);
        transpose_weight(INP(I_XWV), D, XW, WKV, D, 0, XW, nullptr, scr, gw, NGW, lane);
        transpose_weight(INP(I_XWO), XW, D, WXO, XW, 0, 0, nullptr, scr, gw, NGW, lane);
        { constexpr int IG = (D / 64) * (FF / 32); for (int it = SIDE_ITEMS - 2 * IG + gw; it < IG; it += NGW) { float rr[32]; const TwItem t = tw_item(it, D / 32, 0, 0); tw_load(rr, INP(I_F2D), D, t, lane); tw_store(rr, W2D, FF, nullptr, t, scr, lane); } }
        transpose_weight(INP(I_F1G), D, FF, W1GU, D, 1, 0, nullptr, scr, gw, NGW, lane);
        transpose_weight(INP(I_F1U), D, FF, W1GU, D, 2, 0, nullptr, scr, gw, NGW, lane);
        rms_rows<false>(INP(I_X), INP(I_F1N), XN, M, gw, NGW, lane);
        rms_rows<false>(INP(I_MEM), INP(I_MEMN), MN, BATCH * MEMT, gw, NGW, lane);
    }
    SEAM(0);
    if (IN(1)) for (int rep_ = 0; rep_ < (PROBE_PHASE == 1 ? PROBE_REPS : 1); ++rep_) { PH_BEGIN
        pg8::Gemm g{XN, W1GU, M, 2 * FF, D, D, D}; pg8::OrderFfnKv S; S.init(M, 2 * FF, G, bx); S.A1 = MN; S.B1 = WKV;
        pg8::EpiSwiGLUKV E{{ACT, FF, nullptr, 0.f, 0.f}, {KB, VT}};
        pg8::gemm_phase<pg8::EpiSwiGLUKV, pg8::OrderFfnKv, true, true>(lds, g, S, E);
        const int rounds = (S.nwg + 16 + G - 1) / G, first_idle = S.nwg + 16 - (rounds - 1) * G;
        if (first_idle < G) { if (bx >= first_idle) { const int gw2 = (bx - first_idle) * NWAVES + wave, NGW2 = (G - first_idle) * NWAVES; LAS float* scr = (LAS float*)(lds + wave * 16384);
            transpose_weight(INP(I_WOC), CW, D, WA, CW, 0, 0, nullptr, scr, gw2, NGW2, lane);
            transpose_weight(INP(I_WOD), DNW, D, WB, DNW, 0, 0, nullptr, scr, gw2, NGW2, lane);
            transpose_weight(INP(I_WO), D, D, WO, D, 0, 0, nullptr, scr, gw2, NGW2, lane); } }
        else { LAS float* scr = (LAS float*)(lds + wave * 16384);
            transpose_weight(INP(I_WOC), CW, D, WA, CW, 0, 0, nullptr, scr, gw, NGW, lane);
            transpose_weight(INP(I_WOD), DNW, D, WB, DNW, 0, 0, nullptr, scr, gw, NGW, lane);
            transpose_weight(INP(I_WO), D, D, WO, D, 0, 0, nullptr, scr, gw, NGW, lane); }
    }
    SEAM(1);
    if (IN(2)) { PH_BEGIN
        pg8::Gemm g{ACT, W1D, M, D, FF, FF, FF}; pg8::StaticOrder S; S.init(M, D, G, bx);
        pg8::EpiResidBf<true> E{INP(I_X), HB, D, 0.5f, SSQ(0)};
        pg8::gemm_phase<pg8::EpiResidBf<true>, pg8::StaticOrder, true, true>(lds, g, S, E);
    }
    SEAM(2);
    if (IN(3)) for (int rep_ = 0; rep_ < (PROBE_PHASE == 3 ? PROBE_REPS : 1); ++rep_) { PH_BEGIN
        pg8::Gemm g{HB, WIN, M, NPP, D, D, D}; pg8::StaticOrder S; S.init(M, NPP, G, bx);
        pg8::EpiStoreBf16 E{PROJ, NPP, SSQ(0), SSQ_INVK, EPS};
        pg8::gemm_phase<pg8::EpiStoreBf16, pg8::StaticOrder, true, true>(lds, g, S, E);
        for (int job = gw; job < (M / 16) * 4; job += NGW) ab_logits(HB, WIN + (size_t)NPP * D, AB, job, lane);
    }
    SEAM(3);
    if (IN(4)) for (int rep_ = 0; rep_ < (PROBE_PHASE == 4 ? PROBE_REPS : 1); ++rep_) { PH_BEGIN
        conv_branch_a(PROJ, INP(I_CONVW), CONVA, gtid, NT);
        for (int pair = vcu; pair < BATCH * NH * NCH / 2; pair += G) dn_chunk_pair(PROJ, AB, SSQ(0), INP(I_QKVW), INP(I_ALOG), INP(I_DTB), ws, lds, pair, tid);
    }
    SEAM(4);
    if (IN(5)) for (int rep_ = 0; rep_ < (PROBE_PHASE == 5 ? PROBE_REPS : 1); ++rep_) { PH_BEGIN for (int unit = vcu; unit < BATCH * NH * 4; unit += G) { SideJob J{INP(I_F2G), INP(I_F2U), INP(I_F2D), W2GU, W2D, INP(I_F2N), nullptr, (unit * NWAVES + wave) * NCH}; dn_scan_unit(ws, lds, OB, unit, tid, J); } }
    SEAM(5);
    if (IN(6)) for (int rep_ = 0; rep_ < (PROBE_PHASE == 6 ? PROBE_REPS : 1); ++rep_) { PH_BEGIN dn_gated_norm(OB, PROJ, INP(I_DNN), ON, gtid, NT); }
    SEAM(6);
    if (IN(7)) for (int rep_ = 0; rep_ < (PROBE_PHASE == 7 ? PROBE_REPS : 1); ++rep_) { PH_BEGIN
        pg8::Gemm g{CONVA, WA, M, D, CW, CW, CW}; pg8::OrderTwoPass S; S.init(M, D, G, bx); S.A1 = ON; S.B1 = WB;
        pg8::EpiGateFused E{XN, D, PROJ + OFF_GA, PROJ + OFF_GB, NPP};
        pg8::gemm_phase<pg8::EpiGateFused, pg8::OrderTwoPass, true, true>(lds, g, S, E);
    }
    SEAM(7);
    if (IN(8)) { PH_BEGIN
        pg8::Gemm g{XN, WO, M, D, D, D, D}; pg8::StaticOrder S; S.init(M, D, G, bx);
        pg8::EpiResidBf<false> E{HB, HB, D, 1.0f, SSQ(1)};
        pg8::gemm_phase<pg8::EpiResidBf<false>, pg8::StaticOrder, true, true>(lds, g, S, E);
    }
    SEAM(8);
    if (IN(9)) for (int rep_ = 0; rep_ < (PROBE_PHASE == 9 ? PROBE_REPS : 1); ++rep_) { PH_BEGIN
        pg8::Gemm g{HB, WQ, M, XW, D / 4, D, D}; pg8::OrderSplitK4 S{G, bx, (D / 4) * 2};
        pg8::EpiPartF32 E{QP, XW, (size_t)M * XW};
        pg8::gemm_phase<pg8::EpiPartF32, pg8::OrderSplitK4, true, true>(lds, g, S, E);
    }
    SEAM(9);
    if (IN(10)) for (int rep_ = 0; rep_ < (PROBE_PHASE == 10 ? PROBE_REPS : 1); ++rep_) { PH_BEGIN for (int unit = vcu; unit < BATCH * 4 * (SEQ / 128); unit += G) xattn_unit(QP, SSQ(1), KB, VT, XO, lds, unit, tid); }
    SEAM(10);
    if (IN(11)) { PH_BEGIN
        pg8::Gemm g{XO, WXO, M, D, XW, XW, XW}; pg8::StaticOrder S; S.init(M, D, G, bx);
        pg8::EpiResidBf<false> E{HB, HB, D, 1.0f, SSQ(2)};
        pg8::gemm_phase<pg8::EpiResidBf<false>, pg8::StaticOrder, true, true>(lds, g, S, E);
    }
    SEAM(11);
    if (IN(12)) for (int rep_ = 0; rep_ < (PROBE_PHASE == 12 ? PROBE_REPS : 1); ++rep_) { PH_BEGIN
        pg8::Gemm g{HB, W2GU, M, 2 * FF, D, D, D}; pg8::StaticOrder S; S.init(M, 2 * FF, G, bx);
        pg8::EpiSwiGLU E{ACT, FF, SSQ(2), SSQ_INVK, EPS};
        pg8::gemm_phase<pg8::EpiSwiGLU, pg8::StaticOrder, true, true>(lds, g, S, E);
    }
    SEAM(12);
    if (IN(13)) { PH_BEGIN
        pg8::Gemm g{ACT, W2D, M, D, FF, FF, FF}; pg8::StaticOrder S; S.init(M, D, G, bx);
        pg8::EpiResidBf<false> E{HB, HB, D, 0.5f, SSQ(3)};
        pg8::gemm_phase<pg8::EpiResidBf<false>, pg8::StaticOrder, true, true>(lds, g, S, E);
    }
    SEAM(13);
    if (IN(14)) { PH_BEGIN final_norm(HB, SSQ(3), INP(I_FINN), H, gw, NGW, lane); }
#undef IN
#undef SEAM
}

extern "C" void kernel_launch(void* const* d_in, const int* in_sizes, int n_in, void* d_out, int out_size, void* d_ws, size_t ws_size, hipStream_t stream) {
    static int grid = 0;
    if (grid == 0) {
        if (n_in != 27 || out_size != M * D || ws_size < WS_END) { fprintf(stderr, "kernel_launch: unexpected problem (n_in %d, out %d, ws %zu < %zu)\n", n_in, out_size, ws_size, (size_t)WS_END); grid = -1; return; }
        int dev = 0, cus = 0, per_cu = 0;
        if (hipGetDevice(&dev) != hipSuccess || hipDeviceGetAttribute(&cus, hipDeviceAttributeMultiprocessorCount, dev) != hipSuccess) { grid = -1; return; }
        if (hipFuncSetAttribute((const void*)fwd_kernel, hipFuncAttributeMaxDynamicSharedMemorySize, LDS_BYTES) != hipSuccess) { fprintf(stderr, "kernel_launch: hipFuncSetAttribute failed\n"); grid = -1; return; }
        if (hipOccupancyMaxActiveBlocksPerMultiprocessor(&per_cu, (const void*)fwd_kernel, NTHREADS, LDS_BYTES) != hipSuccess || per_cu < 1) { fprintf(stderr, "kernel_launch: occupancy query reports %d blocks per CU\n", per_cu); (void)hipGetLastError(); grid = -1; return; }
        grid = cus;
    }
    if (grid < 0) return;
    (void)hipMemsetAsync((char*)d_ws + WS_CTL, 0, CTL_ZERO_BYTES, stream);
    Args a{};
    for (int i = 0; i < 27; ++i) a.in[i] = (const float*)d_in[i];
    a.out = (float*)d_out; a.ws = (unsigned char*)d_ws;
#if MK_N_LAUNCHES == 1
    a.ph_lo = 0; a.ph_hi = NPH;
    hipLaunchKernelGGL(fwd_kernel, dim3(grid), dim3(NTHREADS), LDS_BYTES, stream, a);
#else
    for (int p = 0; p < NPH; ++p) { a.ph_lo = p; a.ph_hi = p + 1; hipLaunchKernelGGL(fwd_kernel, dim3(grid), dim3(NTHREADS), LDS_BYTES, stream, a); }
#endif
}
```

```cpp
#include <hip/hip_runtime.h>
#include <cstdio>
#include <cstdint>
#ifndef MK_N_LAUNCHES
#define MK_N_LAUNCHES 1
#endif
namespace pg8 {
#define PG8_LAS __attribute__((address_space(3)))
typedef unsigned short bf16_t;
typedef short bf16x8 __attribute__((ext_vector_type(8)));
typedef float f32x4 __attribute__((ext_vector_type(4)));
typedef unsigned u32x4 __attribute__((ext_vector_type(4)));
constexpr int BM = 256, BK = 64, HALF = 128, HTB = HALF * BK * 2  , STAGE_BYTES = 8 * HTB, NXCD = 8, WGM = 8;

__host__ __device__ __forceinline__ int lds_byte(int r, int c) { const int st = (r >> 4) * 2 + (c >> 5), rr = r & 15, cc = c & 31, ob = rr * 64 + cc * 2; return st * 1024 + (ob ^ (((ob >> 9) & 1) << 5)); }
__host__ __device__ __forceinline__ void stage_rc(int b, int& R, int& C) { const int st = b / 1024, sb = b % 1024, swz = sb ^ (((sb >> 9) & 1) << 5); R = (st >> 1) * 16 + swz / 64; C = (st & 1) * 32 + (swz % 64) / 2; }
__host__ __device__ __forceinline__ int perm32(int rho) { const int n = rho >> 4, i = rho & 15; return 8 * (i >> 2) + 4 * n + (i & 3); }

struct Unit { int pm, pn, g; };
struct Gemm { const bf16_t* A; const bf16_t* Bt; int M, N, K, lda, ldb; };

struct StaticOrder {
    int nM, nN, nwg, G, c;
    __host__ __device__ void init(int M, int N, int G_, int c_) { nM = M / BM; nN = N / BM; nwg = nM * nN; G = G_; c = c_; }
    __host__ __device__ bool next(int i, Unit& u) const {
        const long L = (long)i * G + c; if (L >= nwg) return false;
        int wgid = (int)L; { const int q = nwg / NXCD, r = nwg % NXCD, xcd = wgid % NXCD, off = wgid / NXCD; wgid = (xcd < r ? xcd * (q + 1) : r * (q + 1) + (xcd - r) * q) + off; }
        const int nig = WGM * nN, gid = wgid / nig, fm = gid * WGM, gsz = (nM - fm) < WGM ? (nM - fm) : WGM;
        u.pm = fm + ((wgid % nig) % gsz); u.pn = (wgid % nig) / gsz; u.g = 0; return true;
    }
    __device__ __forceinline__ const char* pa(const Gemm& g, const Unit& u, size_t tstepA) const { return (const char*)g.A + (size_t)u.pm * tstepA; }
    __device__ __forceinline__ const char* pb(const Gemm& g, const Unit& u, size_t tstepB) const { return (const char*)g.Bt + (size_t)u.pn * tstepB; }
    __device__ __forceinline__ bool keep(const Unit&) const { return false; }
    __device__ __forceinline__ void a_ready(const Unit&) const {}
    __device__ __forceinline__ void done(const Unit&) const {}
};

__device__ __forceinline__ unsigned cvt_pk_bf16(float lo, float hi) { unsigned r; asm volatile("v_cvt_pk_bf16_f32 %0, %1, %2" : "=v"(r) : "v"(lo), "v"(hi)); return r; }
__device__ __forceinline__ float bf_lo(unsigned w) { return __uint_as_float(w << 16); }
__device__ __forceinline__ float bf_hi(unsigned w) { return __uint_as_float(w & 0xffff0000u); }
__device__ __forceinline__ float fast_sigmoid(float x) { return __builtin_amdgcn_rcpf(1.0f + __builtin_amdgcn_exp2f(-1.4426950408889634f * x)); }
__device__ __forceinline__ float fast_silu(float x) { return x * fast_sigmoid(x); }

template <bool RS> struct EpiSwiGLUT {
    static constexpr bool PERM = true, AFTER_DRAIN = false, PRE = RS;
    bf16_t* O; int ldc; const unsigned long long* ssq; float inv_k, eps;
    __device__ __forceinline__ float pre_load(const Unit& u, int tid) const { return (tid < BM) ? (float)ssq[u.pm * BM + tid] : 0.f; }
    __device__ __forceinline__ void pre_store(PG8_LAS float* slot, int tid, float v) const { if (tid < BM) slot[tid] = 1.0f / sqrtf(v * inv_k + eps); }
    __device__ __forceinline__ void operator()(const f32x4 (&acc)[2][2][4][2], const Unit& u, int wr, int wc, int fr, int fq, const PG8_LAS float* rsl = nullptr) const {
        const int row0 = u.pm * BM + wr * 64 + fr, col0 = u.pn * HALF + wc * 32 + 8 * fq;
#pragma unroll
        for (int ai = 0; ai < 2; ++ai)
#pragma unroll
            for (int m = 0; m < 4; ++m) { bf16_t* rowp = O + (size_t)(row0 + ai * HALF + m * 16) * ldc + col0;
                const float rs = RS ? rsl[wr * 64 + fr + ai * HALF + m * 16] : 1.0f;
                const f32x4 g0 = acc[ai][0][m][0] * rs, g1 = acc[ai][0][m][1] * rs, u0 = acc[ai][1][m][0] * rs, u1 = acc[ai][1][m][1] * rs;
                f32x4 v0, v1;
#pragma unroll
                for (int j = 0; j < 4; ++j) { v0[j] = fast_silu(g0[j]) * u0[j]; v1[j] = fast_silu(g1[j]) * u1[j]; }
                u32x4 w; w.x = cvt_pk_bf16(v0[0], v0[1]); w.y = cvt_pk_bf16(v0[2], v0[3]); w.z = cvt_pk_bf16(v1[0], v1[1]); w.w = cvt_pk_bf16(v1[2], v1[3]);
                *(u32x4*)rowp = w; }
    }
};
typedef EpiSwiGLUT<false> EpiSwiGLU;
typedef EpiSwiGLUT<true> EpiSwiGLUrs;
template <bool XF32> struct EpiResidBf {
    static constexpr bool PERM = true, AFTER_DRAIN = false, PRE = false;
    const void* base; bf16_t* out; int ldc; float alpha; unsigned long long* ssq;
    __device__ __forceinline__ void operator()(const f32x4 (&acc)[2][2][4][2], const Unit& u, int wr, int wc, int fr, int fq) const {
        const int row0 = u.pm * BM + wr * 64 + fr, col0 = u.pn * BM + wc * 32 + 8 * fq;
#pragma unroll
        for (int ai = 0; ai < 2; ++ai) {
            f32x4 b[4][2][2];
#pragma unroll
            for (int m = 0; m < 4; ++m) { const size_t off = (size_t)(row0 + ai * HALF + m * 16) * ldc + col0;
#pragma unroll
                for (int bj = 0; bj < 2; ++bj) {
                    if (XF32) { b[m][bj][0] = *(const f32x4*)((const float*)base + off + bj * HALF); b[m][bj][1] = *(const f32x4*)((const float*)base + off + bj * HALF + 4); }
                    else { const u32x4 w = *(const u32x4*)((const bf16_t*)base + off + bj * HALF);
                        b[m][bj][0] = (f32x4){bf_lo(w.x), bf_hi(w.x), bf_lo(w.y), bf_hi(w.y)}; b[m][bj][1] = (f32x4){bf_lo(w.z), bf_hi(w.z), bf_lo(w.w), bf_hi(w.w)}; } } }
#pragma unroll
            for (int m = 0; m < 4; ++m) { const size_t off = (size_t)(row0 + ai * HALF + m * 16) * ldc + col0; float ss = 0.f;
#pragma unroll
                for (int bj = 0; bj < 2; ++bj) { const f32x4 o0 = b[m][bj][0] + acc[ai][bj][m][0] * alpha, o1 = b[m][bj][1] + acc[ai][bj][m][1] * alpha;
                    ss += ((o0[0] * o0[0] + o0[1] * o0[1]) + (o0[2] * o0[2] + o0[3] * o0[3])) + ((o1[0] * o1[0] + o1[1] * o1[1]) + (o1[2] * o1[2] + o1[3] * o1[3]));
                    u32x4 w; w.x = cvt_pk_bf16(o0[0], o0[1]); w.y = cvt_pk_bf16(o0[2], o0[3]); w.z = cvt_pk_bf16(o1[0], o1[1]); w.w = cvt_pk_bf16(o1[2], o1[3]);
                    *(u32x4*)(out + off + bj * HALF) = w; }
                ss += __shfl_xor(ss, 16); ss += __shfl_xor(ss, 32);
                if (fq == 0) __hip_atomic_fetch_add(ssq + row0 + ai * HALF + m * 16, (unsigned long long)(ss * 1048576.0f + 0.5f), __ATOMIC_RELAXED, __HIP_MEMORY_SCOPE_AGENT); }
        }
    }
};
struct EpiStoreBf16 {
    static constexpr bool PERM = true, AFTER_DRAIN = false, PRE = true;
    bf16_t* O; int ldc; const unsigned long long* ssq; float inv_k, eps;
    __device__ __forceinline__ float pre_load(const Unit& u, int tid) const { return (tid < BM) ? (float)ssq[u.pm * BM + tid] : 0.f; }
    __device__ __forceinline__ void pre_store(PG8_LAS float* slot, int tid, float v) const { if (tid < BM) slot[tid] = 1.0f / sqrtf(v * inv_k + eps); }
    __device__ __forceinline__ void operator()(const f32x4 (&acc)[2][2][4][2], const Unit& u, int wr, int wc, int fr, int fq, const PG8_LAS float* rsl) const {
        const int row0 = u.pm * BM + wr * 64 + fr, col0 = u.pn * BM + wc * 32 + 8 * fq;
#pragma unroll
        for (int ai = 0; ai < 2; ++ai)
#pragma unroll
            for (int m = 0; m < 4; ++m) { bf16_t* rowp = O + (size_t)(row0 + ai * HALF + m * 16) * ldc + col0;
                const float scale = rsl[wr * 64 + fr + ai * HALF + m * 16];
#pragma unroll
                for (int bj = 0; bj < 2; ++bj) { const f32x4 v0 = acc[ai][bj][m][0] * scale, v1 = acc[ai][bj][m][1] * scale;
                    u32x4 w; w.x = cvt_pk_bf16(v0[0], v0[1]); w.y = cvt_pk_bf16(v0[2], v0[3]); w.z = cvt_pk_bf16(v1[0], v1[1]); w.w = cvt_pk_bf16(v1[2], v1[3]);
                    *(u32x4*)(rowp + bj * HALF) = w; } }
    }
};
struct EpiKV {
    static constexpr bool PERM = true, AFTER_DRAIN = false, PRE = false;
    bf16_t* KB; bf16_t* VT;
    __device__ __forceinline__ void operator()(const f32x4 (&acc)[2][2][4][2], const Unit& u, int wr, int wc, int fr, int fq) const {
        const int rl0 = wr * 64 + fr;
        if (u.pn < 2) {
            const int col0 = u.pn * BM + wc * 32 + 8 * fq;
#pragma unroll
            for (int ai = 0; ai < 2; ++ai)
#pragma unroll
                for (int m = 0; m < 4; ++m) { bf16_t* rowp = KB + (size_t)(u.pm * BM + rl0 + ai * HALF + m * 16) * 512 + col0;
#pragma unroll
                    for (int bj = 0; bj < 2; ++bj) { const f32x4 v0 = acc[ai][bj][m][0], v1 = acc[ai][bj][m][1];
                        u32x4 w; w.x = cvt_pk_bf16(v0[0], v0[1]); w.y = cvt_pk_bf16(v0[2], v0[3]); w.z = cvt_pk_bf16(v1[0], v1[1]); w.w = cvt_pk_bf16(v1[2], v1[3]);
                        *(u32x4*)(rowp + bj * HALF) = w; } }
        } else {
            const int colv0 = (u.pn - 2) * BM + wc * 32 + 8 * fq;
#pragma unroll
            for (int ai = 0; ai < 2; ++ai)
#pragma unroll
                for (int m = 0; m < 4; ++m) { const int key = rl0 + ai * HALF + m * 16;
#pragma unroll
                    for (int bj = 0; bj < 2; ++bj)
#pragma unroll
                        for (int n = 0; n < 2; ++n)
#pragma unroll
                            for (int e = 0; e < 4; ++e) { const int cv = colv0 + bj * HALF + 4 * n + e;
                                VT[((size_t)u.pm * 512 + cv) * 256 + key] = (bf16_t)(cvt_pk_bf16(acc[ai][bj][m][n][e], 0.f) & 0xffffu); } }
        }
    }
};
struct EpiGateA {
    static constexpr bool PERM = true, AFTER_DRAIN = false, PRE = false;
    float* T; int ldc; const bf16_t* G; int ldg;
    __device__ __forceinline__ void operator()(const f32x4 (&acc)[2][2][4][2], const Unit& u, int wr, int wc, int fr, int fq) const {
        const int row0 = u.pm * BM + wr * 64 + fr, col0 = u.pn * BM + wc * 32 + 8 * fq;
#pragma unroll
        for (int ai = 0; ai < 2; ++ai)
#pragma unroll
            for (int m = 0; m < 4; ++m) { const size_t row = (size_t)(row0 + ai * HALF + m * 16);
#pragma unroll
                for (int bj = 0; bj < 2; ++bj) { const int c = col0 + bj * HALF; const u32x4 gw = *(const u32x4*)(G + row * ldg + c);
                    f32x4 v0 = acc[ai][bj][m][0], v1 = acc[ai][bj][m][1];
                    v0[0] *= fast_sigmoid(bf_lo(gw.x)); v0[1] *= fast_sigmoid(bf_hi(gw.x)); v0[2] *= fast_sigmoid(bf_lo(gw.y)); v0[3] *= fast_sigmoid(bf_hi(gw.y));
                    v1[0] *= fast_sigmoid(bf_lo(gw.z)); v1[1] *= fast_sigmoid(bf_hi(gw.z)); v1[2] *= fast_sigmoid(bf_lo(gw.w)); v1[3] *= fast_sigmoid(bf_hi(gw.w));
                    *(f32x4*)(T + row * ldc + c) = v0; *(f32x4*)(T + row * ldc + c + 4) = v1; } }
    }
};
struct EpiGateB {
    static constexpr bool PERM = true, AFTER_DRAIN = false, PRE = false;
    const float* T; bf16_t* O; int ldc; const bf16_t* G; int ldg;
    __device__ __forceinline__ void operator()(const f32x4 (&acc)[2][2][4][2], const Unit& u, int wr, int wc, int fr, int fq) const {
        const int row0 = u.pm * BM + wr * 64 + fr, col0 = u.pn * BM + wc * 32 + 8 * fq;
#pragma unroll
        for (int ai = 0; ai < 2; ++ai)
#pragma unroll
            for (int m = 0; m < 4; ++m) { const size_t row = (size_t)(row0 + ai * HALF + m * 16);
#pragma unroll
                for (int bj = 0; bj < 2; ++bj) { const int c = col0 + bj * HALF; const u32x4 gw = *(const u32x4*)(G + row * ldg + c);
                    const f32x4 t0 = *(const f32x4*)(T + row * ldc + c), t1 = *(const f32x4*)(T + row * ldc + c + 4);
                    f32x4 v0 = acc[ai][bj][m][0], v1 = acc[ai][bj][m][1];
                    v0[0] = t0[0] + v0[0] * fast_sigmoid(bf_lo(gw.x)); v0[1] = t0[1] + v0[1] * fast_sigmoid(bf_hi(gw.x)); v0[2] = t0[2] + v0[2] * fast_sigmoid(bf_lo(gw.y)); v0[3] = t0[3] + v0[3] * fast_sigmoid(bf_hi(gw.y));
                    v1[0] = t1[0] + v1[0] * fast_sigmoid(bf_lo(gw.z)); v1[1] = t1[1] + v1[1] * fast_sigmoid(bf_hi(gw.z)); v1[2] = t1[2] + v1[2] * fast_sigmoid(bf_lo(gw.w)); v1[3] = t1[3] + v1[3] * fast_sigmoid(bf_hi(gw.w));
                    u32x4 w; w.x = cvt_pk_bf16(v0[0], v0[1]); w.y = cvt_pk_bf16(v0[2], v0[3]); w.z = cvt_pk_bf16(v1[0], v1[1]); w.w = cvt_pk_bf16(v1[2], v1[3]);
                    *(u32x4*)(O + row * ldc + c) = w; } }
    }
};

struct OrderFfnKv : StaticOrder {
    const bf16_t* A1; const bf16_t* B1;
    __device__ __forceinline__ bool next(int i, Unit& u) const {
        if (StaticOrder::next(i, u)) return true;
        const long L = (long)i * G + c - nwg; if (L < 0 || L >= 16) return false;
        u.g = 1; u.pm = (int)(L >> 2); u.pn = (int)(L & 3); return true; }
    __device__ __forceinline__ const char* pa(const Gemm& g, const Unit& u, size_t tstepA) const { return (const char*)(u.g ? A1 : g.A) + (size_t)u.pm * tstepA; }
    __device__ __forceinline__ const char* pb(const Gemm& g, const Unit& u, size_t tstepB) const { return (const char*)(u.g ? B1 : g.Bt) + (size_t)u.pn * tstepB; }
};
struct EpiSwiGLUKV {
    static constexpr bool PERM = true, AFTER_DRAIN = false, PRE = false;
    EpiSwiGLU e0; EpiKV e1;
    __device__ __forceinline__ void operator()(const f32x4 (&acc)[2][2][4][2], const Unit& u, int wr, int wc, int fr, int fq) const { if (u.g == 0) e0(acc, u, wr, wc, fr, fq); else e1(acc, u, wr, wc, fr, fq); }
};
struct OrderSplitK4 {
    int G, c, ks_bytes;
    __device__ __forceinline__ bool next(int i, Unit& u) const { const long L = (long)i * G + c; if (L >= 256) return false; u.pm = (int)(L >> 3); u.pn = (int)((L >> 2) & 1); u.g = (int)(L & 3); return true; }
    __device__ __forceinline__ const char* pa(const Gemm& g, const Unit& u, size_t tstepA) const { return (const char*)g.A + (size_t)u.pm * tstepA + (size_t)u.g * ks_bytes; }
    __device__ __forceinline__ const char* pb(const Gemm& g, const Unit& u, size_t tstepB) const { return (const char*)g.Bt + (size_t)u.pn * tstepB + (size_t)u.g * ks_bytes; }
    __device__ __forceinline__ bool keep(const Unit&) const { return false; }
    __device__ __forceinline__ void a_ready(const Unit&) const {}
    __device__ __forceinline__ void done(const Unit&) const {}
};
struct EpiPartF32 {
    static constexpr bool PERM = false, AFTER_DRAIN = false, PRE = false;
    float* P; int ldc; size_t gstride;
    __device__ __forceinline__ void operator()(const f32x4 (&acc)[2][2][4][2], const Unit& u, int wr, int wc, int fr, int fq) const {
        const int row0 = u.pm * BM + wr * 64 + fr, col0 = u.pn * BM + wc * 32 + 4 * fq; float* out = P + (size_t)u.g * gstride;
#pragma unroll
        for (int ai = 0; ai < 2; ++ai)
#pragma unroll
            for (int m = 0; m < 4; ++m) { const size_t off = (size_t)(row0 + ai * HALF + m * 16) * ldc + col0;
#pragma unroll
                for (int bj = 0; bj < 2; ++bj)
#pragma unroll
                    for (int n = 0; n < 2; ++n) *(f32x4*)(out + off + bj * HALF + n * 16) = acc[ai][bj][m][n]; }
    }
};
struct OrderTwoPass : StaticOrder {
    const bf16_t* A1; const bf16_t* B1;
    __device__ __forceinline__ bool next(int i, Unit& u) const { if (!StaticOrder::next(i >> 1, u)) return false; u.g = i & 1; return true; }
    __device__ __forceinline__ const char* pa(const Gemm& g, const Unit& u, size_t tstepA) const { return (const char*)(u.g ? A1 : g.A) + (size_t)u.pm * tstepA; }
    __device__ __forceinline__ const char* pb(const Gemm& g, const Unit& u, size_t tstepB) const { return (const char*)(u.g ? B1 : g.Bt) + (size_t)u.pn * tstepB; }
    __device__ __forceinline__ bool keep(const Unit& u) const { return u.g == 0; }
};
struct EpiGateFused {
    static constexpr bool PERM = true, AFTER_DRAIN = false, PRE = false;
    bf16_t* O; int ldc; const bf16_t* GA; const bf16_t* GB; int ldg;
    __device__ __forceinline__ void operator()(f32x4 (&acc)[2][2][4][2], const Unit& u, int wr, int wc, int fr, int fq) const {
        const int row0 = u.pm * BM + wr * 64 + fr, col0 = u.pn * BM + wc * 32 + 8 * fq;
#pragma unroll
        for (int ai = 0; ai < 2; ++ai) {
            u32x4 gbv[4][2], gav[4][2];
#pragma unroll
            for (int m = 0; m < 4; ++m) { const size_t row = (size_t)(row0 + ai * HALF + m * 16);
#pragma unroll
                for (int bj = 0; bj < 2; ++bj) { gbv[m][bj] = *(const u32x4*)(GB + row * ldg + col0 + bj * HALF); if (u.g == 0) gav[m][bj] = *(const u32x4*)(GA + row * ldg + col0 + bj * HALF); } }
#pragma unroll
            for (int m = 0; m < 4; ++m) { const size_t row = (size_t)(row0 + ai * HALF + m * 16);
#pragma unroll
                for (int bj = 0; bj < 2; ++bj) { const int c = col0 + bj * HALF; const u32x4 gb = gbv[m][bj];
                    float eb[8] = {bf_lo(gb.x), bf_hi(gb.x), bf_lo(gb.y), bf_hi(gb.y), bf_lo(gb.z), bf_hi(gb.z), bf_lo(gb.w), bf_hi(gb.w)};
#pragma unroll
                    for (int e = 0; e < 8; ++e) eb[e] = 1.0f + __builtin_amdgcn_exp2f(-1.4426950408889634f * eb[e]);
                    if (u.g == 0) { const u32x4 ga = gav[m][bj];
                        float ea[8] = {bf_lo(ga.x), bf_hi(ga.x), bf_lo(ga.y), bf_hi(ga.y), bf_lo(ga.z), bf_hi(ga.z), bf_lo(ga.w), bf_hi(ga.w)};
#pragma unroll
                        for (int e = 0; e < 8; ++e) { const float rt = eb[e] * __builtin_amdgcn_rcpf(1.0f + __builtin_amdgcn_exp2f(-1.4426950408889634f * ea[e]));
                            acc[ai][bj][m][e >> 2][e & 3] *= rt; }
                    } else { f32x4 v0 = acc[ai][bj][m][0], v1 = acc[ai][bj][m][1];
#pragma unroll
                        for (int e = 0; e < 4; ++e) { v0[e] *= __builtin_amdgcn_rcpf(eb[e]); v1[e] *= __builtin_amdgcn_rcpf(eb[4 + e]); }
                        u32x4 w; w.x = cvt_pk_bf16(v0[0], v0[1]); w.y = cvt_pk_bf16(v0[2], v0[3]); w.z = cvt_pk_bf16(v1[0], v1[1]); w.w = cvt_pk_bf16(v1[2], v1[3]);
                        *(u32x4*)(O + row * ldc + c) = w; } } }
        }
    }
};


template <class Epi, class Sched, bool ALIGN_EPI = false, bool SP2 = false>
__device__ __forceinline__ void gemm_phase(PG8_LAS unsigned char* lds, const Gemm g, const Sched& S, const Epi& E) {
    const int tid = threadIdx.x, wid = __builtin_amdgcn_readfirstlane(tid >> 6), lane = tid & 63, wr = wid >> 2, wc = wid & 3, fr = lane & 15, fq = lane >> 4;
    const int K = g.K, nt = K / BK;
    unsigned voffA[2], voffB[2];
#pragma unroll
    for (int i = 0; i < 2; ++i) { int R, C; stage_rc(tid * 16 + i * 8192, R, C); const int Rb = Epi::PERM ? ((R & ~31) + perm32(R & 31)) : R;
        voffA[i] = (unsigned)(R * g.lda + C) * 2u; voffB[i] = (unsigned)(Rb * g.ldb + C) * 2u; }
    const size_t kstep = (size_t)(BK * 2);
    const size_t hstepA = (size_t)HALF * g.lda * 2, hstepB = (size_t)HALF * g.ldb * 2;
    const size_t tstepA = 2 * hstepA, tstepB = 2 * hstepB;
    const unsigned ldsw = (unsigned)wid * 1024u;
    const int aoff = lds_byte(wr * 64 + fr, fq * 8), boff = lds_byte(wc * 32 + fr, fq * 8);
#define PG8_SA(b, h) (((b) * 2 + (h)) * HTB)
#define PG8_SB(b, h) ((4 + (b) * 2 + (h)) * HTB)
#define PG8_STAGE(bufoff, gbase, voff) do { _Pragma("unroll") for (int _i = 0; _i < 2; ++_i) \
        __builtin_amdgcn_global_load_lds((const unsigned*)((const char*)(gbase) + (voff)[_i]), (PG8_LAS unsigned*)(lds + (bufoff) + ldsw + _i * 8192), 16, 0, 0); } while (0)
#define PG8_LDA(dst, b, h) do { _Pragma("unroll") for (int m = 0; m < 4; ++m) _Pragma("unroll") for (int k = 0; k < 2; ++k) dst[m][k] = *(const PG8_LAS bf16x8*)(lds + PG8_SA(b, h) + aoff + m * 2048 + k * 1024); } while (0)
#define PG8_LDB(dst, b, h) do { _Pragma("unroll") for (int n = 0; n < 2; ++n) _Pragma("unroll") for (int k = 0; k < 2; ++k) dst[n][k] = *(const PG8_LAS bf16x8*)(lds + PG8_SB(b, h) + boff + n * 2048 + k * 1024); } while (0)
#define PG8_MMA(ai, bj, At, Bt) do { __builtin_amdgcn_s_setprio(1); _Pragma("unroll") for (int m = 0; m < 4; ++m) _Pragma("unroll") for (int n = 0; n < 2; ++n) _Pragma("unroll") for (int k = 0; k < 2; ++k) \
        acc[ai][bj][m][n] = __builtin_amdgcn_mfma_f32_16x16x32_bf16(Bt[n][k], At[m][k], acc[ai][bj][m][n], 0, 0, 0); __builtin_amdgcn_s_setprio(0); } while (0)
#define PG8_WAIT_V(n) asm volatile("s_waitcnt vmcnt(" #n ")" ::: "memory")
#define PG8_WAIT_L(n) asm volatile("s_waitcnt lgkmcnt(" #n ")" ::: "memory")
#define PG8_BAR __builtin_amdgcn_s_barrier()
#define PG8_SCHED __builtin_amdgcn_sched_barrier(0)
    Unit cur, nxt; int ui = 0;
    if (!S.next(0, cur)) return;
    f32x4 acc[2][2][4][2];
#pragma unroll
    for (int a = 0; a < 2; ++a)
#pragma unroll
        for (int b = 0; b < 2; ++b)
#pragma unroll
            for (int m = 0; m < 4; ++m)
#pragma unroll
                for (int n = 0; n < 2; ++n) acc[a][b][m][n] = (f32x4){0.f, 0.f, 0.f, 0.f};
    bf16x8 At[4][2], B0[2][2], B1[2][2];
    const char* cA = S.pa(g, cur, tstepA); const char* cB = S.pb(g, cur, tstepB);
    PG8_LAS float* const rsl = (PG8_LAS float*)(lds + STAGE_BYTES); float pv = 0.f; int slot = 0;
    if constexpr (Epi::PRE) pv = E.pre_load(cur, tid);
    S.a_ready(cur);
    if constexpr (SP2) {
        PG8_STAGE(PG8_SB(0, 0), cB, voffB); PG8_STAGE(PG8_SB(0, 1), cB + hstepB, voffB); PG8_STAGE(PG8_SA(0, 0), cA, voffA); PG8_STAGE(PG8_SA(0, 1), cA + hstepA, voffA);
        if (wr == 1) PG8_BAR;
        PG8_WAIT_V(2); if constexpr (Epi::PRE) E.pre_store(rsl, tid, pv); PG8_BAR;
        PG8_STAGE(PG8_SB(1, 0), cB + kstep, voffB); PG8_STAGE(PG8_SA(1, 0), cA + kstep, voffA); PG8_STAGE(PG8_SB(1, 1), cB + hstepB + kstep, voffB);
        PG8_WAIT_V(6); PG8_BAR;
    } else {
        PG8_STAGE(PG8_SB(0, 0), cB, voffB); PG8_STAGE(PG8_SA(0, 0), cA, voffA); PG8_STAGE(PG8_SB(0, 1), cB + hstepB, voffB); PG8_STAGE(PG8_SA(0, 1), cA + hstepA, voffA);
        if (wr == 1) PG8_BAR;
        PG8_WAIT_V(4); if constexpr (Epi::PRE) E.pre_store(rsl, tid, pv); PG8_BAR;
        PG8_STAGE(PG8_SB(1, 0), cB + kstep, voffB); PG8_STAGE(PG8_SA(1, 0), cA + kstep, voffA); PG8_STAGE(PG8_SB(1, 1), cB + hstepB + kstep, voffB);
        PG8_WAIT_V(6); PG8_BAR;
    }
    for (;;) {
        const bool has_next = S.next(ui + 1, nxt);
        const char* nA = has_next ? S.pa(g, nxt, tstepA) : cA; const char* nB = has_next ? S.pb(g, nxt, tstepB) : cB;
        for (int t = 0; t < nt; t += 2) {
            const bool last = (t == nt - 2);
            const char* a1 = cA + (size_t)(t + 1) * kstep;
            const char* a2 = last ? nA : cA + (size_t)(t + 2) * kstep; const char* b2 = last ? nB : cB + (size_t)(t + 2) * kstep;
            const char* a3 = a2 + kstep; const char* b3 = b2 + kstep;
            if (last && has_next) S.a_ready(nxt);
            if constexpr (SP2) {
            PG8_LDB(B0, 0, 0); PG8_LDB(B1, 0, 1); PG8_SCHED; PG8_LDA(At, 0, 0); PG8_STAGE(PG8_SA(1, 1), a1 + hstepA, voffA);
            PG8_WAIT_V(8); PG8_WAIT_L(0); PG8_BAR; PG8_MMA(0, 0, At, B0); PG8_MMA(0, 1, At, B1); PG8_BAR; PG8_SCHED;
            PG8_LDA(At, 0, 1); PG8_STAGE(PG8_SB(0, 0), b2, voffB); PG8_STAGE(PG8_SB(0, 1), b2 + hstepB, voffB); PG8_STAGE(PG8_SA(0, 0), a2, voffA);
            PG8_WAIT_V(8); PG8_WAIT_L(0); PG8_BAR; PG8_MMA(1, 0, At, B0); PG8_MMA(1, 1, At, B1); PG8_BAR; PG8_SCHED;
            PG8_LDB(B0, 1, 0); PG8_LDB(B1, 1, 1); PG8_SCHED; PG8_LDA(At, 1, 0); PG8_STAGE(PG8_SA(0, 1), a2 + hstepA, voffA);
            PG8_WAIT_V(8); PG8_WAIT_L(0); PG8_BAR; PG8_MMA(0, 0, At, B0); PG8_MMA(0, 1, At, B1); PG8_BAR; PG8_SCHED;
            PG8_LDA(At, 1, 1); PG8_STAGE(PG8_SB(1, 0), b3, voffB); PG8_STAGE(PG8_SB(1, 1), b3 + hstepB, voffB); PG8_STAGE(PG8_SA(1, 0), a3, voffA);
            PG8_WAIT_V(8); PG8_WAIT_L(0); PG8_BAR; PG8_MMA(1, 0, At, B0); PG8_MMA(1, 1, At, B1); PG8_BAR; PG8_SCHED;
            } else {
            PG8_LDB(B0, 0, 0); PG8_SCHED; PG8_LDA(At, 0, 0); PG8_STAGE(PG8_SA(1, 1), a1 + hstepA, voffA);
            PG8_WAIT_L(8); PG8_BAR; PG8_WAIT_L(0); PG8_MMA(0, 0, At, B0); PG8_BAR; PG8_SCHED;
            PG8_LDB(B1, 0, 1); PG8_STAGE(PG8_SB(0, 0), b2, voffB);
            PG8_BAR; PG8_WAIT_L(0); PG8_MMA(0, 1, At, B1); PG8_BAR;
            PG8_LDA(At, 0, 1); PG8_STAGE(PG8_SA(0, 0), a2, voffA);
            PG8_BAR; PG8_WAIT_L(0); PG8_MMA(1, 0, At, B0); PG8_BAR; PG8_SCHED;
            PG8_STAGE(PG8_SB(0, 1), b2 + hstepB, voffB);
            PG8_WAIT_V(6); PG8_BAR; PG8_MMA(1, 1, At, B1); PG8_BAR;
            PG8_LDB(B0, 1, 0); PG8_SCHED; PG8_LDA(At, 1, 0); PG8_STAGE(PG8_SA(0, 1), a2 + hstepA, voffA);
            PG8_WAIT_L(8); PG8_BAR; PG8_WAIT_L(0); PG8_MMA(0, 0, At, B0); PG8_BAR; PG8_SCHED;
            PG8_LDB(B1, 1, 1); PG8_STAGE(PG8_SB(1, 0), b3, voffB);
            PG8_BAR; PG8_WAIT_L(0); PG8_MMA(0, 1, At, B1); PG8_BAR;
            PG8_LDA(At, 1, 1); PG8_STAGE(PG8_SA(1, 0), a3, voffA);
            PG8_BAR; PG8_WAIT_L(0); PG8_MMA(1, 0, At, B0); PG8_BAR; PG8_SCHED;
            PG8_STAGE(PG8_SB(1, 1), b3 + hstepB, voffB);
            PG8_WAIT_V(6); PG8_BAR; PG8_MMA(1, 1, At, B1); PG8_BAR;
            }
        }
        if constexpr (ALIGN_EPI) { if (wr == 0) PG8_BAR; }
        if constexpr (!Epi::AFTER_DRAIN) {
            if constexpr (Epi::PRE) { float pn_ = 0.f; if (has_next) pn_ = E.pre_load(nxt, tid); E(acc, cur, wr, wc, fr, fq, rsl + slot * 256); if (has_next) E.pre_store(rsl + (slot ^ 1) * 256, tid, pn_); slot ^= 1; }
            else E(acc, cur, wr, wc, fr, fq);
            S.done(cur); }
        if (!has_next) break;
        if (!S.keep(cur))
#pragma unroll
        for (int a = 0; a < 2; ++a)
#pragma unroll
            for (int b = 0; b < 2; ++b)
#pragma unroll
                for (int m = 0; m < 4; ++m)
#pragma unroll
                    for (int n = 0; n < 2; ++n) acc[a][b][m][n] = (f32x4){0.f, 0.f, 0.f, 0.f};
        cur = nxt; cA = nA; cB = nB; ++ui;
        if constexpr (ALIGN_EPI) { if (wr == 1) PG8_BAR; }
    }
    PG8_WAIT_V(0);
    if constexpr (!ALIGN_EPI) { if (wr == 0) PG8_BAR; }
    PG8_BAR;
    if constexpr (Epi::AFTER_DRAIN) { E.fused(acc, cur, wr, wc, fr, fq, lds, wid, lane); S.done(cur); }
#undef PG8_SA
#undef PG8_SB
#undef PG8_STAGE
#undef PG8_LDA
#undef PG8_LDB
#undef PG8_MMA
#undef PG8_WAIT_V
#undef PG8_WAIT_L
#undef PG8_BAR
#undef PG8_SCHED
}
}
#define GAS __attribute__((address_space(1)))
#define LAS __attribute__((address_space(3)))
typedef unsigned short bf16;
typedef unsigned v4u __attribute__((ext_vector_type(4)));
typedef float f32x4 __attribute__((ext_vector_type(4)));
typedef short bf16x8 __attribute__((ext_vector_type(8)));
typedef GAS unsigned gu32;
typedef GAS unsigned long long gu64;
#define RLX_AGENT __ATOMIC_RELAXED, __HIP_MEMORY_SCOPE_AGENT
#define LDS_WAIT() asm volatile("s_waitcnt lgkmcnt(0)" ::: "memory")
#define VM_WAIT() asm volatile("s_waitcnt vmcnt(0)" ::: "memory")
__device__ __forceinline__ unsigned long long rt() { return __builtin_amdgcn_s_memrealtime(); }
__device__ __forceinline__ unsigned f2bf(float f) { unsigned u = __builtin_bit_cast(unsigned, f); return (u + 0x7fffu + ((u >> 16) & 1u)) >> 16; }
__device__ __forceinline__ unsigned pk2(float lo, float hi) { return f2bf(lo) | (f2bf(hi) << 16); }

#define XB_TMO      128
#define XB_XCNT(j)  (256  + 64 * (j))
#define XB_XSUB(j)  (1280 + 64 * (j))
#define XB_XGEN(j)  (2304 + 64 * (j))
#define XB_TOP      3328
#define XB_TOPGEN   3392
#define XCD_BAR_WORDS 3456
#define XB_SPIN_CAP (1u << 18)

__device__ __forceinline__ unsigned xb_ld(unsigned* p)              { return __hip_atomic_load(p, __ATOMIC_RELAXED, __HIP_MEMORY_SCOPE_AGENT); }
__device__ __forceinline__ unsigned xb_add(unsigned* p, unsigned v) { return __hip_atomic_fetch_add(p, v, __ATOMIC_RELAXED, __HIP_MEMORY_SCOPE_AGENT); }
__device__ __forceinline__ unsigned xb_xcc_id() { return (unsigned)__builtin_amdgcn_s_getreg((3 << 11) | 20) & 0xFu; }
#define XB_SPIN(cond, bar) do { unsigned _sp = 0; while (cond) { __builtin_amdgcn_s_sleep(1); \
    if ((++_sp & 255u) == 0u) { if (xb_ld(&(bar)[XB_TMO])) break; if (_sp > XB_SPIN_CAP) { atomicAdd(&(bar)[XB_TMO], 1u); break; } } } } while (0)

struct XcdBarrier {
    unsigned* bar; unsigned x;
    volatile LAS unsigned* st;
};

__device__ __forceinline__ XcdBarrier xcd_barrier_post(unsigned* bar, volatile LAS unsigned* st) {
    XcdBarrier b; b.bar = bar; b.x = xb_xcc_id(); b.st = st;
    if (threadIdx.x == 0) (void)xb_add(&bar[XB_XCNT(b.x)], 1u);
    return b;
}
__device__ __forceinline__ void xcd_barrier_complete(unsigned* bar, unsigned x, unsigned& nloc, unsigned& nx) {
    const unsigned G = gridDim.x * gridDim.y * gridDim.z;
    unsigned sum, cnt, mine, sp = 0u;
    for (;;) {
        sum = 0u; cnt = 0u; mine = 0u;
#pragma unroll
        for (unsigned j = 0; j < 16; ++j) { const unsigned c = xb_ld(&bar[XB_XCNT(j)]); sum += c; cnt += (c > 0u) ? 1u : 0u; mine = (j == x) ? c : mine; }
        if (sum == G) break;
        __builtin_amdgcn_s_sleep(1);
        if ((++sp & 255u) == 0u) { if (xb_ld(&bar[XB_TMO])) break; if (sp > XB_SPIN_CAP) { atomicAdd(&bar[XB_TMO], 1u); break; } }
    }
    nloc = mine > 0u ? mine : 1u; nx = cnt > 0u ? cnt : 1u;
}

__device__ __forceinline__ void xcd_barrier(const XcdBarrier& b) {
    asm volatile("s_waitcnt vmcnt(0)" ::: "memory");
    __syncthreads();
    if (threadIdx.x == 0) {
        unsigned* bar = b.bar;
        __builtin_amdgcn_s_waitcnt(0);
        unsigned nloc = b.st[0], nx = b.st[1];
        if (nloc == 0u) { xcd_barrier_complete(bar, b.x, nloc, nx); b.st[0] = nloc; b.st[1] = nx; }
        const unsigned old = xb_add(&bar[XB_XSUB(b.x)], 1u);
        const unsigned gen = old / nloc;
        if (old + 1u == (gen + 1u) * nloc) {
            __builtin_amdgcn_fence(__ATOMIC_RELEASE, "agent");
            asm volatile("s_waitcnt vmcnt(0)" ::: "memory");
            const unsigned og = xb_add(&bar[XB_TOP], 1u);
            const unsigned tg = og / nx;
            if (og + 1u == (tg + 1u) * nx) xb_add(&bar[XB_TOPGEN], 1u);
            else XB_SPIN(xb_ld(&bar[XB_TOPGEN]) == tg, bar);
            __builtin_amdgcn_fence(__ATOMIC_ACQUIRE, "agent");
            xb_add(&bar[XB_XGEN(b.x)], 1u);
            asm volatile("s_waitcnt vmcnt(0)" ::: "memory");
        } else {
            XB_SPIN(xb_ld(&bar[XB_XGEN(b.x)]) == gen, bar);
            __builtin_amdgcn_fence(__ATOMIC_ACQUIRE, "agent");
            asm volatile("s_waitcnt vmcnt(0)" ::: "memory");
        }
    }
    __syncthreads();
}

constexpr int NWAVES = 8, NTHREADS = NWAVES * 64;
constexpr int BATCH = 4, SEQ = 2048, D = 4096, FF = 11008, M = BATCH * SEQ;
constexpr int CW = 2048, DNW = 2048, NH = 16, HD = 128, CH = 64, NCH = SEQ / CH;
constexpr int NPROJ = 22560, NPP = 22528;
constexpr int OFF_CX = 0, OFF_CC = 2048, OFF_CB = 4096, OFF_Q = 6144, OFF_Z = 12288, OFF_GA = 14336, OFF_GB = 18432;
constexpr int MEMT = 256, XW = 512;
constexpr float EPS = 1e-6f;
constexpr float SSQ_INVK = 1.0f / (4096.0f * 1048576.0f);
#ifndef PROBE_PHASE
#define PROBE_REPS 3
#define PROBE_SUB 0
#define PROBE_PHASE -1
#endif
constexpr int NPH = 15;

constexpr size_t MiB = 1u << 20;
constexpr size_t WS_CTL = 0, CTL_ZERO_BYTES = 1 * MiB;
constexpr size_t WS_W1GU = 1 * MiB, WS_W1D = 173 * MiB, WS_W2GU = 259 * MiB, WS_W2D = 431 * MiB, WS_WIN = 517 * MiB;
constexpr size_t WS_WA = 695 * MiB, WS_WB = 711 * MiB, WS_WO = 727 * MiB, WS_WQ = 759 * MiB, WS_WKV = 763 * MiB, WS_WXO = 771 * MiB;
constexpr size_t WS_XN = 775 * MiB;
constexpr size_t WS_R = 839 * MiB;
constexpr size_t WS_DN = 1195 * MiB;
constexpr size_t WS_WC = WS_DN, WS_UB = WS_DN + 64 * MiB, WS_QD = WS_DN + 128 * MiB, WS_KTT = WS_DN + 192 * MiB, WS_AQK = WS_DN + 256 * MiB, WS_GL = WS_DN + 288 * MiB;
constexpr size_t WS_TMP = WS_DN;
constexpr size_t WS_MN = 1484 * MiB, WS_KB = 1492 * MiB, WS_VT = 1493 * MiB, WS_AB = 1494 * MiB, WS_XNB = 1498 * MiB, WS_END = 1562 * MiB;
constexpr size_t WS_O = WS_W1GU, WS_CONVA = WS_W1GU + 64 * MiB, WS_ON = WS_W1GU + 96 * MiB, WS_XO = WS_W1GU + 136 * MiB;
constexpr size_t WS_QP = WS_O;
constexpr int CW_TMO = 0, CW_BAR = 4096;
constexpr size_t WS_SSQ = 65536;
constexpr int RING_BYTES = 131072;
constexpr int ATT_LDS = 256 * 272 + 128 * 528;
constexpr int MISC_OFF = 147456;
constexpr int LDS_BYTES = 151552;
static_assert(ATT_LDS <= MISC_OFF && MISC_OFF + 128 <= LDS_BYTES, "LDS map");

__device__ __forceinline__ float bfl(unsigned w) { return __uint_as_float(w << 16); }
__device__ __forceinline__ float bfh(unsigned w) { return __uint_as_float(w & 0xffff0000u); }
__device__ __forceinline__ float bf1(bf16 v) { return __uint_as_float(((unsigned)v) << 16); }
__device__ __forceinline__ float sigm(float x) { return __builtin_amdgcn_rcpf(1.0f + __builtin_amdgcn_exp2f(-1.4426950408889634f * x)); }
__device__ __forceinline__ float wave_sum(float v) {
#pragma unroll
    for (int o = 1; o < 64; o <<= 1) v += __shfl_xor(v, o);
    return v;
}

struct TwItem { int k0, n0, drow0; };
__device__ __forceinline__ TwItem tw_item(int item, int nblk, int mode, int roff) {
    TwItem t; const int kb = item / nblk, nb = item - kb * nblk; t.k0 = 64 * kb; t.n0 = 32 * nb;
    t.drow0 = (mode == 0) ? (roff + t.n0) : (mode == 3) ? ((t.n0 < 14336) ? t.n0 : (t.n0 < 14368) ? (NPP + t.n0 - 14336) : (t.n0 - 32))
                                          : (256 * (t.n0 >> 7) + 128 * (mode - 1) + (t.n0 & 127));
    return t;
}
__device__ __forceinline__ void tw_load(float (&r)[32], const float* W, int N, const TwItem& t, int lane) {
    const float* p = W + (size_t)(t.k0 + (lane >> 5)) * N + t.n0 + (lane & 31);
#pragma unroll
    for (int i = 0; i < 32; ++i) r[i] = __builtin_nontemporal_load(p + (size_t)(2 * i) * N);
}
__device__ __forceinline__ void tw_store(const float (&r)[32], bf16* WT, int ldk, const float* gain, const TwItem& t, LAS float* scr, int lane) {
#pragma unroll
    for (int i = 0; i < 32; ++i) scr[(2 * i + (lane >> 5)) * 33 + (lane & 31)] = r[i];
    LDS_WAIT(); asm volatile("" ::: "memory");
    const int c = lane & 7;
    f32x4 g0 = {1.f, 1.f, 1.f, 1.f}, g1 = {1.f, 1.f, 1.f, 1.f};
    if (gain) { g0 = *(const f32x4*)(gain + t.k0 + 8 * c); g1 = *(const f32x4*)(gain + t.k0 + 8 * c + 4); }
#pragma unroll
    for (int j = 0; j < 4; ++j) { const int n = (lane >> 3) + 8 * j; const LAS float* s = scr + (8 * c) * 33 + n;
        v4u o; o.x = pk2(s[0 * 33] * g0.x, s[1 * 33] * g0.y); o.y = pk2(s[2 * 33] * g0.z, s[3 * 33] * g0.w); o.z = pk2(s[4 * 33] * g1.x, s[5 * 33] * g1.y); o.w = pk2(s[6 * 33] * g1.z, s[7 * 33] * g1.w);
        *(v4u*)(WT + (size_t)(t.drow0 + n) * ldk + t.k0 + 8 * c) = o; }
    LDS_WAIT(); asm volatile("" ::: "memory");
}
__device__ __forceinline__ void transpose_weight(const float* W, int K, int N, bf16* WT, int ldk, int mode, int roff, const float* gain, LAS float* scr, int gw, int NGW, int lane) {
    const int nblk = N / 32, nitems = (K / 64) * nblk;
    int item = gw; if (item >= nitems) return;
    float ra[32], rb[32];
    TwItem ta = tw_item(item, nblk, mode, roff), tb = ta;
    tw_load(ra, W, N, ta, lane);
    for (;;) {
        bool hn = item + NGW < nitems;
        if (hn) { tb = tw_item(item + NGW, nblk, mode, roff); tw_load(rb, W, N, tb, lane); }
        tw_store(ra, WT, ldk, gain, ta, scr, lane);
        if (!hn) break;
        item += NGW; hn = item + NGW < nitems;
        if (hn) { ta = tw_item(item + NGW, nblk, mode, roff); tw_load(ra, W, N, ta, lane); }
        tw_store(rb, WT, ldk, gain, tb, scr, lane);
        if (!hn) break;
        item += NGW;
    }
}
template <bool OUT_F32>
__device__ __forceinline__ void rms_rows(const float* X, const float* w, void* out, int nrows, int gw, int NGW, int lane) {
    for (int m = gw; m < nrows; m += NGW) {
        const f32x4* xr = (const f32x4*)(X + (size_t)m * D) + lane;
        f32x4 v[16]; float s = 0.f;
#pragma unroll
        for (int j = 0; j < 16; ++j) { v[j] = xr[64 * j]; s += (v[j].x * v[j].x + v[j].y * v[j].y) + (v[j].z * v[j].z + v[j].w * v[j].w); }
        const float rstd = 1.0f / sqrtf(wave_sum(s) * (1.0f / D) + EPS);
        const f32x4* wr = (const f32x4*)w + lane;
        if (OUT_F32) { f32x4* o = (f32x4*)((float*)out + (size_t)m * D) + lane;
#pragma unroll
            for (int j = 0; j < 16; ++j) { const f32x4 g = wr[64 * j]; o[64 * j] = v[j] * rstd * g; }
        } else { unsigned long long* o8 = (unsigned long long*)((bf16*)out + (size_t)m * D) + lane;
#pragma unroll
            for (int j = 0; j < 16; ++j) { const f32x4 g = wr[64 * j]; const f32x4 y = v[j] * rstd * g;
                o8[64 * j] = (unsigned long long)pk2(y.x, y.y) | ((unsigned long long)pk2(y.z, y.w) << 32); } }
    }
}

__device__ __forceinline__ void final_norm(const bf16* HBp, const unsigned long long* ssq, const float* w, float* out, int gw, int NGW, int lane) {
    for (int m = gw; m < M; m += NGW) {
        const float rstd = 1.0f / sqrtf((float)ssq[m] * SSQ_INVK + EPS);
        const v4u* hr = (const v4u*)(HBp + (size_t)m * D) + lane; f32x4* o = (f32x4*)(out + (size_t)m * D) + 2 * lane; const f32x4* wr = (const f32x4*)w + 2 * lane;
#pragma unroll
        for (int j = 0; j < 8; ++j) { const v4u h = hr[64 * j]; const f32x4 g0 = wr[128 * j], g1 = wr[128 * j + 1];
            o[128 * j] = (f32x4){bfl(h.x), bfh(h.x), bfl(h.y), bfh(h.y)} * rstd * g0; o[128 * j + 1] = (f32x4){bfl(h.z), bfh(h.z), bfl(h.w), bfh(h.w)} * rstd * g1; }
    }
}

__device__ __forceinline__ void conv_branch_a(const bf16* proj, const float* conv_w, bf16* outA, int idx0, int idx1, int stride) {
    for (int idx = idx0; idx < idx1; idx += stride) {
        const int row = idx >> 8, c0 = (idx & 255) * 8, s = row & (SEQ - 1);
        float y[8];
#pragma unroll
        for (int e = 0; e < 8; ++e) y[e] = 0.f;
#pragma unroll
        for (int k = 0; k < 3; ++k) {
            const int sk = s - 2 + k; const float mk = (sk >= 0) ? 1.f : 0.f;
            const bf16* pr = proj + (size_t)(sk >= 0 ? row - 2 + k : row) * NPP;
            const v4u xc = *(const v4u*)(pr + OFF_CX + c0), cc = *(const v4u*)(pr + OFF_CC + c0);
            const f32x4 w0 = *(const f32x4*)(conv_w + k * CW + c0) * mk, w1 = *(const f32x4*)(conv_w + k * CW + c0 + 4) * mk;
            y[0] += w0.x * (bfl(xc.x) * bfl(cc.x)); y[1] += w0.y * (bfh(xc.x) * bfh(cc.x)); y[2] += w0.z * (bfl(xc.y) * bfl(cc.y)); y[3] += w0.w * (bfh(xc.y) * bfh(cc.y));
            y[4] += w1.x * (bfl(xc.z) * bfl(cc.z)); y[5] += w1.y * (bfh(xc.z) * bfh(cc.z)); y[6] += w1.z * (bfl(xc.w) * bfl(cc.w)); y[7] += w1.w * (bfh(xc.w) * bfh(cc.w));
        }
        const v4u cb = *(const v4u*)(proj + (size_t)row * NPP + OFF_CB + c0);
        v4u o; o.x = pk2(y[0] * bfl(cb.x), y[1] * bfh(cb.x)); o.y = pk2(y[2] * bfl(cb.y), y[3] * bfh(cb.y)); o.z = pk2(y[4] * bfl(cb.z), y[5] * bfh(cb.z)); o.w = pk2(y[6] * bfl(cb.w), y[7] * bfh(cb.w));
        *(v4u*)(outA + (size_t)row * CW + c0) = o;
    }
}

constexpr int XS = 136, LS = 68;
constexpr int CH_LDS = 3 * 64 * XS * 2 + 64 * LS * 4 + 4 * 64 * 4;
static_assert(2 * CH_LDS <= MISC_OFF, "two chunks per workgroup");
__device__ __forceinline__ void dn_chunk_pair(const bf16* proj, const float* AB, const unsigned long long* ssq, const float* qkv_w, const float* a_log, const float* dt_bias, unsigned char* ws, LAS unsigned char* lds, int pair, int tid, const float* conv_w, bf16* convA) {
    const int lane = tid & 63, wave = __builtin_amdgcn_readfirstlane(tid >> 6), half = wave >> 2, wv = wave & 3, th = tid & 255;
    const int cid = pair * 2 + half, bh = cid >> 5, n = cid & 31, b = bh >> 4, h = bh & 15;
    LAS unsigned char* hb = lds + half * CH_LDS;
    LAS bf16* Qb = (LAS bf16*)hb; LAS bf16* Kb = Qb + 64 * XS; LAS bf16* Vb = Kb + 64 * XS; LAS float* Lt = (LAS float*)(Vb + 64 * XS);
    LAS float* GC = Lt + 64 * LS; LAS float* BETA = GC + 64; LAS float* EGC = BETA + 64; LAS float* ETAIL = EGC + 64;
    const size_t rowb = (size_t)b * SEQ;
    bf16* WC = (bf16*)(ws + WS_WC) + (size_t)cid * 8192; float* UB = (float*)(ws + WS_UB) + (size_t)cid * 8192; bf16* QD = (bf16*)(ws + WS_QD) + (size_t)cid * 8192;
    bf16* KTT = (bf16*)(ws + WS_KTT) + (size_t)cid * 8192; bf16* AQK = (bf16*)(ws + WS_AQK) + (size_t)cid * 4096; float* GL = (float*)(ws + WS_GL);
    float egc_l, etail_l;
    {
        const size_t row = rowb + n * CH + lane;
        float al = 0.f, bl = 0.f;
#pragma unroll
        for (int q = 0; q < 4; ++q) { al += AB[(size_t)q * M * 32 + row * 32 + 16 + h]; bl += AB[(size_t)q * M * 32 + row * 32 + h]; }
        const float rs = 1.0f / sqrtf((float)ssq[row] * SSQ_INVK + EPS); al *= rs; bl *= rs;
        const float xx = al + dt_bias[h];
        const float sp = fmaxf(xx, 0.f) + log1pf(expf(-fabsf(xx)));
        float g = -expf(a_log[h]) * sp;
#pragma unroll
        for (int d = 1; d < 64; d <<= 1) { const float t = __shfl_up(g, d); if (lane >= d) g += t; }
        const float glast = __shfl(g, 63);
        egc_l = expf(g); etail_l = expf(glast - g);
        if (wv == 0) { GC[lane] = g; BETA[lane] = 1.0f / (1.0f + expf(-bl)); EGC[lane] = egc_l; ETAIL[lane] = etail_l; if (lane == 63) GL[cid] = expf(glast); }
    }
    {
        const int c0 = (th & 15) * 8, i0 = (th >> 4) * 4;
#pragma unroll
        for (int mat = 0; mat < 3; ++mat) {
            const int wcol = mat * DNW + h * HD + c0;
            f32x4 w[4][2];
#pragma unroll
            for (int j = 0; j < 4; ++j) { w[j][0] = *(const f32x4*)(qkv_w + j * (3 * DNW) + wcol); w[j][1] = *(const f32x4*)(qkv_w + j * (3 * DNW) + wcol + 4); }
            v4u raw[7];
#pragma unroll
            for (int t = 0; t < 7; ++t) { const int st = n * CH + i0 - 3 + t; raw[t] = *(const v4u*)(proj + (rowb + (st >= 0 ? st : 0)) * NPP + OFF_Q + wcol); if (st < 0) raw[t] = (v4u){0u, 0u, 0u, 0u}; }
            LAS bf16* X = (mat == 0) ? Qb : (mat == 1) ? Kb : Vb;
#pragma unroll
            for (int j4 = 0; j4 < 4; ++j4) {
                const int i = i0 + j4;
                f32x4 a0 = {0.f, 0.f, 0.f, 0.f}, a1 = {0.f, 0.f, 0.f, 0.f};
#pragma unroll
                for (int j = 0; j < 4; ++j) { const v4u r = raw[j4 + j];
                    a0.x += w[j][0].x * bfl(r.x); a0.y += w[j][0].y * bfh(r.x); a0.z += w[j][0].z * bfl(r.y); a0.w += w[j][0].w * bfh(r.y);
                    a1.x += w[j][1].x * bfl(r.z); a1.y += w[j][1].y * bfh(r.z); a1.z += w[j][1].z * bfl(r.w); a1.w += w[j][1].w * bfh(r.w); }
#pragma unroll
                for (int e = 0; e < 4; ++e) { a0[e] = a0[e] * sigm(a0[e]); a1[e] = a1[e] * sigm(a1[e]); }
                if (mat < 2) {
                    float ss = (a0.x * a0.x + a0.y * a0.y) + (a0.z * a0.z + a0.w * a0.w) + (a1.x * a1.x + a1.y * a1.y) + (a1.z * a1.z + a1.w * a1.w);
                    ss += __shfl_xor(ss, 1); ss += __shfl_xor(ss, 2); ss += __shfl_xor(ss, 4); ss += __shfl_xor(ss, 8);
                    float sc = 1.0f / sqrtf(ss + EPS); if (mat == 0) sc *= 0.08838834764831845f;
                    a0 = a0 * sc; a1 = a1 * sc;
                }
                v4u o; o.x = pk2(a0.x, a0.y); o.y = pk2(a0.z, a0.w); o.z = pk2(a1.x, a1.y); o.w = pk2(a1.z, a1.w);
                *(LAS v4u*)(X + i * XS + c0) = o;
                if (mat == 0) { const float eg = __shfl(egc_l, i); a0 = a0 * eg; a1 = a1 * eg;
                    v4u q; q.x = pk2(a0.x, a0.y); q.y = pk2(a0.z, a0.w); q.z = pk2(a1.x, a1.y); q.w = pk2(a1.z, a1.w); *(v4u*)(QD + i * 128 + c0) = q; }
            }
        }
    }
    __syncthreads();
    {
        const int r = lane & 15, kq = lane >> 4;
        for (int job = wv; job < 26; job += 4) {
            int prod, it, jt;
            if (job < 10) { prod = 0; it = (job >= 6) ? 3 : (job >= 3) ? 2 : (job >= 1) ? 1 : 0; jt = job - (it * (it + 1)) / 2; }
            else { prod = 1; it = (job - 10) >> 2; jt = (job - 10) & 3; }
            f32x4 acc = {0.f, 0.f, 0.f, 0.f};
            if (jt <= it) {
                const LAS bf16* Ab = (prod ? Qb : Kb) + (16 * it + r) * XS + 8 * kq; const LAS bf16* Bb = Kb + (16 * jt + r) * XS + 8 * kq;
#pragma unroll
                for (int ks = 0; ks < 4; ++ks) acc = __builtin_amdgcn_mfma_f32_16x16x32_bf16(*(const LAS bf16x8*)(Ab + 32 * ks), *(const LAS bf16x8*)(Bb + 32 * ks), acc, 0, 0, 0);
            }
            const int jx = 16 * jt + r; const float gcj = GC[jx];
            f32x4 o;
#pragma unroll
            for (int reg = 0; reg < 4; ++reg) { const int ix = 16 * it + 4 * kq + reg; const float dec = expf(GC[ix] - gcj);
                if (prod == 0) o[reg] = (ix > jx) ? BETA[ix] * acc[reg] * dec : 0.f;
                else o[reg] = (ix >= jx) ? acc[reg] * dec : 0.f; }
            if (prod == 0) *(LAS f32x4*)(Lt + jx * LS + 16 * it + 4 * kq) = o;
            else {
#pragma unroll
                for (int reg = 0; reg < 4; ++reg) AQK[(16 * it + 4 * kq + reg) * 64 + jx] = (bf16)f2bf(o[reg]); }
        }
    }
    __syncthreads();
    constexpr int TS = 68;
    LAS bf16* Tv = Qb; LAS bf16* Tk = Qb + 64 * TS;
    if (wv == half) {
        int zv = 0; asm volatile("" : "+v"(zv));
        const LAS float* LtV = Lt + zv;
        float x[64];
#pragma unroll
        for (int i = 0; i < 64; ++i) x[i] = (i == lane) ? 1.0f : 0.0f;
        f32x4 lr[16];
#define DN_FMAQ(J, Q) { _Pragma("unroll") for (int ii = 4 * (Q); ii < 4 * (Q) + 4; ++ii) { if (ii >= (((J) + 1) >> 2)) { _Pragma("unroll") for (int e = 0; e < 4; ++e) { if (4 * ii + e > (J)) x[4 * ii + e] -= lr[ii][e] * xj; } } } }
#define DN_LDQ(J, Q) { _Pragma("unroll") for (int ii = 4 * (Q); ii < 4 * (Q) + 4; ++ii) { if ((J) < 63 && ii >= (((J) + 1) >> 2)) lr[ii] = *(const LAS f32x4*)(LtV + (J) * LS + 4 * ii); } __builtin_amdgcn_sched_barrier(0); }
#define DN_ROW(J) { const float xj = x[J]; DN_FMAQ(J, 0) DN_LDQ((J) + 1, 0) DN_FMAQ(J, 1) DN_LDQ((J) + 1, 1) DN_FMAQ(J, 2) DN_LDQ((J) + 1, 2) DN_FMAQ(J, 3) DN_LDQ((J) + 1, 3) }
        DN_LDQ(0, 0) DN_LDQ(0, 1) DN_LDQ(0, 2) DN_LDQ(0, 3)
        DN_ROW(0)
        DN_ROW(1)
        DN_ROW(2)
        DN_ROW(3)
        DN_ROW(4)
        DN_ROW(5)
        DN_ROW(6)
        DN_ROW(7)
        DN_ROW(8)
        DN_ROW(9)
        DN_ROW(10)
        DN_ROW(11)
        DN_ROW(12)
        DN_ROW(13)
        DN_ROW(14)
        DN_ROW(15)
        DN_ROW(16)
        DN_ROW(17)
        DN_ROW(18)
        DN_ROW(19)
        DN_ROW(20)
        DN_ROW(21)
        DN_ROW(22)
        DN_ROW(23)
        DN_ROW(24)
        DN_ROW(25)
        DN_ROW(26)
        DN_ROW(27)
        DN_ROW(28)
        DN_ROW(29)
        DN_ROW(30)
        DN_ROW(31)
        DN_ROW(32)
        DN_ROW(33)
        DN_ROW(34)
        DN_ROW(35)
        DN_ROW(36)
        DN_ROW(37)
        DN_ROW(38)
        DN_ROW(39)
        DN_ROW(40)
        DN_ROW(41)
        DN_ROW(42)
        DN_ROW(43)
        DN_ROW(44)
        DN_ROW(45)
        DN_ROW(46)
        DN_ROW(47)
        DN_ROW(48)
        DN_ROW(49)
        DN_ROW(50)
        DN_ROW(51)
        DN_ROW(52)
        DN_ROW(53)
        DN_ROW(54)
        DN_ROW(55)
        DN_ROW(56)
        DN_ROW(57)
        DN_ROW(58)
        DN_ROW(59)
        DN_ROW(60)
        DN_ROW(61)
        DN_ROW(62)
#undef DN_FMAQ
#undef DN_LDQ
#undef DN_ROW
        const float bv = BETA[lane], bk = bv * EGC[lane];
#pragma unroll
        for (int i = 0; i < 64; ++i) { Tv[i * TS + lane] = (bf16)f2bf(x[i] * bv); Tk[i * TS + lane] = (bf16)f2bf(x[i] * bk); }
    } else {
        const int w3 = (wv > half) ? wv - 1 : wv; const float et = etail_l; const int i = lane;
#pragma unroll 4
        for (int d = w3; d < 128; d += 3) KTT[d * 64 + i] = (bf16)f2bf(bf1(Kb[i * XS + d]) * et);
        conv_branch_a(proj, conv_w, convA, pair * 2048 + (half * 3 + w3) * 64 + lane, (pair + 1) * 2048, 384);
    }
    __syncthreads();
    {
        typedef short v4i16_t __attribute__((ext_vector_type(4)));
        const int r = lane & 15, kq = lane >> 4, q4 = r >> 2, p4 = r & 3;
        bf16x8 av[2], ak[2];
#pragma unroll
        for (int ks = 0; ks < 2; ++ks) { const LAS unsigned long long* pv = (const LAS unsigned long long*)(Tv + (16 * wv + r) * TS + 32 * ks + 8 * kq); const LAS unsigned long long* pk = (const LAS unsigned long long*)(Tk + (16 * wv + r) * TS + 32 * ks + 8 * kq);
            const unsigned long long v0 = pv[0], v1 = pv[1], k0 = pk[0], k1 = pk[1];
            v4u wv4; wv4.x = (unsigned)v0; wv4.y = (unsigned)(v0 >> 32); wv4.z = (unsigned)v1; wv4.w = (unsigned)(v1 >> 32); av[ks] = __builtin_bit_cast(bf16x8, wv4);
            v4u wk4; wk4.x = (unsigned)k0; wk4.y = (unsigned)(k0 >> 32); wk4.z = (unsigned)k1; wk4.w = (unsigned)(k1 >> 32); ak[ks] = __builtin_bit_cast(bf16x8, wk4); }
#pragma unroll
        for (int part = 0; part < 2; ++part) {
            const LAS bf16* Bsrc = part ? Kb : Vb;
#pragma unroll
            for (int ct = 0; ct < 8; ++ct) {
                f32x4 acc = {0.f, 0.f, 0.f, 0.f};
#pragma unroll
                for (int ks = 0; ks < 2; ++ks) {
                    const LAS bf16* bp = Bsrc + (32 * ks + 8 * kq + q4) * XS + 16 * ct + 4 * p4;
                    const v4i16_t t0 = __builtin_amdgcn_ds_read_tr16_b64_v4i16((LAS v4i16_t*)bp), t1 = __builtin_amdgcn_ds_read_tr16_b64_v4i16((LAS v4i16_t*)(bp + 4 * XS));
                    bf16x8 bfrag; bfrag[0] = t0[0]; bfrag[1] = t0[1]; bfrag[2] = t0[2]; bfrag[3] = t0[3]; bfrag[4] = t1[0]; bfrag[5] = t1[1]; bfrag[6] = t1[2]; bfrag[7] = t1[3];
                    acc = __builtin_amdgcn_mfma_f32_16x16x32_bf16(bfrag, part ? ak[ks] : av[ks], acc, 0, 0, 0);
                }
                const int o = (16 * wv + r) * 128 + 16 * ct + 4 * kq;
                if (part == 0) *(f32x4*)(UB + o) = acc;
                else *(unsigned long long*)(WC + o) = (unsigned long long)pk2(-acc.x, -acc.y) | ((unsigned long long)pk2(-acc.z, -acc.w) << 32);
            }
        }
    }
    __syncthreads();
}

constexpr int SSB = 136, USB = 72;
#define LDS_BARRIER() do { asm volatile("s_waitcnt lgkmcnt(0)" ::: "memory"); __builtin_amdgcn_s_barrier(); asm volatile("" ::: "memory"); } while (0)
__device__ __forceinline__ unsigned long long pk4(const f32x4 v) { return (unsigned long long)pk2(v.x, v.y) | ((unsigned long long)pk2(v.z, v.w) << 32); }
struct ScanOps { bf16x8 wcf[4], qdf[4], aqf[2], ktf[2]; f32x4 ubv; };
struct SideJob { const float* Wg; const float* Wu; const float* Wd; bf16* Tgu; bf16* Td; const float* gain; LAS float* scr; int q0; };
__device__ __forceinline__ void side_item(const SideJob& J, int q, const float*& W, int& N, bf16*& WT, int& ldk, const float*& gain, TwItem& t) {
    constexpr int IG = (D / 64) * (FF / 32);
    if (q < IG) { W = J.Wg; N = FF; WT = J.Tgu; ldk = D; gain = J.gain; t = tw_item(q, FF / 32, 1, 0); }
    else if (q < 2 * IG) { W = J.Wu; N = FF; WT = J.Tgu; ldk = D; gain = J.gain; t = tw_item(q - IG, FF / 32, 2, 0); }
    else { W = J.Wd; N = D; WT = J.Td; ldk = FF; gain = nullptr; t = tw_item(q - 2 * IG, D / 32, 0, 0); }
}
constexpr int SIDE_ITEMS = 2048 * NCH;
struct ScanPtrs { const bf16* WCb; const bf16* QDb; const bf16* KTb; const bf16* AQb; const float* UBb; const float* GLb; int offW, offA, offK, offU; };
__device__ __forceinline__ void scan_load_a(ScanOps& o, const ScanPtrs& p, int n) {
#pragma unroll
    for (int ks = 0; ks < 4; ++ks) { o.wcf[ks] = *(const bf16x8*)(p.WCb + (size_t)n * 8192 + p.offW + 32 * ks); o.qdf[ks] = *(const bf16x8*)(p.QDb + (size_t)n * 8192 + p.offW + 32 * ks); }
#pragma unroll
    for (int reg = 0; reg < 4; ++reg) o.ubv[reg] = p.UBb[(size_t)n * 8192 + p.offU + reg * 128];
}
__device__ __forceinline__ void scan_load_b(ScanOps& o, const ScanPtrs& p, int n) {
#pragma unroll
    for (int ks = 0; ks < 2; ++ks) { o.aqf[ks] = *(const bf16x8*)(p.AQb + (size_t)n * 4096 + p.offA + 32 * ks); o.ktf[ks] = *(const bf16x8*)(p.KTb + (size_t)n * 8192 + p.offK + 32 * ks); }
}
__device__ __forceinline__ void scan_step(const ScanOps& cur, ScanOps& nxt, const ScanPtrs& p, LAS bf16* St, LAS bf16* Ut, f32x4& s0, f32x4& s1, float* orow, float gl, int nn, int r, int kq, int rt, int ct, int wave,
                                          const SideJob& J, const float (&sc_cur)[32], float (&sc_nxt)[32], int qcur, int qnxt, int lane) {
    f32x4 accU = cur.ubv, accO = {0.f, 0.f, 0.f, 0.f};
    const LAS bf16* srow = St + (16 * ct + r) * SSB + 8 * kq;
#pragma unroll
    for (int ks = 0; ks < 4; ++ks) { const bf16x8 sf = *(const LAS bf16x8*)(srow + 32 * ks);
        accU = __builtin_amdgcn_mfma_f32_16x16x32_bf16(cur.wcf[ks], sf, accU, 0, 0, 0); accO = __builtin_amdgcn_mfma_f32_16x16x32_bf16(cur.qdf[ks], sf, accO, 0, 0, 0); }
    *(LAS unsigned long long*)(Ut + (16 * ct + r) * USB + 16 * rt + 4 * kq) = pk4(accU);
    scan_load_a(nxt, p, nn);
    { const float* W; int N; bf16* WT; int ldk; const float* gain; TwItem t; if (qnxt >= 0) { side_item(J, qnxt, W, N, WT, ldk, gain, t); tw_load(sc_nxt, W, N, t, lane); } }
    LDS_BARRIER();
    const LAS bf16* urow = Ut + (16 * ct + r) * USB + 8 * kq;
#pragma unroll
    for (int ks = 0; ks < 2; ++ks) { const bf16x8 uf = *(const LAS bf16x8*)(urow + 32 * ks); accO = __builtin_amdgcn_mfma_f32_16x16x32_bf16(cur.aqf[ks], uf, accO, 0, 0, 0); }
#pragma unroll
    for (int reg = 0; reg < 4; ++reg) orow[(size_t)reg * DNW] = accO[reg];
    s0 = s0 * gl; s1 = s1 * gl;
    const LAS bf16* u0 = Ut + r * USB + 8 * kq; const LAS bf16* u1 = Ut + (16 + r) * USB + 8 * kq;
#pragma unroll
    for (int ks = 0; ks < 2; ++ks) { const bf16x8 a8 = *(const LAS bf16x8*)(u0 + 32 * ks), b8 = *(const LAS bf16x8*)(u1 + 32 * ks);
        s0 = __builtin_amdgcn_mfma_f32_16x16x32_bf16(cur.ktf[ks], a8, s0, 0, 0, 0); s1 = __builtin_amdgcn_mfma_f32_16x16x32_bf16(cur.ktf[ks], b8, s1, 0, 0, 0); }
    scan_load_b(nxt, p, nn);
    { const float* W; int N; bf16* WT; int ldk; const float* gain; TwItem t; if (qcur >= 0) { side_item(J, qcur, W, N, WT, ldk, gain, t); tw_store(sc_cur, WT, ldk, gain, t, J.scr, lane); } }
    *(LAS unsigned long long*)(St + r * SSB + 16 * wave + 4 * kq) = pk4(s0); *(LAS unsigned long long*)(St + (16 + r) * SSB + 16 * wave + 4 * kq) = pk4(s1);
    LDS_BARRIER();
}
__device__ __forceinline__ void dn_scan_unit(unsigned char* ws, LAS unsigned char* lds, float* O, int unit, int tid, SideJob J) {
    const int lane = tid & 63, wave = __builtin_amdgcn_readfirstlane(tid >> 6), r = lane & 15, kq = lane >> 4;
    const int bh = unit >> 2, vs = unit & 3, b = bh >> 4, h = bh & 15;
    const int rt = wave >> 1, ct = wave & 1;
    LAS bf16* St = (LAS bf16*)lds; LAS bf16* Ut = St + 32 * SSB;
    { int tz = tid; asm volatile("" : "+v"(tz));
      for (int i = tz; i < 32 * SSB / 2; i += NTHREADS) ((LAS unsigned*)St)[i] = 0u; }
    f32x4 s0 = {0.f, 0.f, 0.f, 0.f}, s1 = {0.f, 0.f, 0.f, 0.f};
    ScanPtrs p;
    p.offW = (16 * rt + r) * 128 + 8 * kq; p.offA = (16 * rt + r) * 64 + 8 * kq; p.offK = (16 * wave + r) * 64 + 8 * kq; p.offU = (16 * rt + 4 * kq) * 128 + vs * 32 + 16 * ct + r;
    p.WCb = (const bf16*)(ws + WS_WC) + (size_t)bh * NCH * 8192; p.UBb = (const float*)(ws + WS_UB) + (size_t)bh * NCH * 8192; p.QDb = (const bf16*)(ws + WS_QD) + (size_t)bh * NCH * 8192;
    p.KTb = (const bf16*)(ws + WS_KTT) + (size_t)bh * NCH * 8192; p.AQb = (const bf16*)(ws + WS_AQK) + (size_t)bh * NCH * 4096; p.GLb = (const float*)(ws + WS_GL) + (size_t)bh * NCH;
    ScanOps A, B;
    scan_load_a(A, p, 0); scan_load_b(A, p, 0);
    float scA[32], scB[32];
    J.scr = (LAS float*)(lds + 16384 + wave * 8704);
    { const float* W; int N; bf16* WT; int ldk; const float* gain; TwItem t; side_item(J, J.q0, W, N, WT, ldk, gain, t); tw_load(scA, W, N, t, lane); }
    const int glall = __float_as_int(p.GLb[lane & 31]);
    LDS_BARRIER();
    float* orow = O + ((size_t)b * SEQ + 16 * rt + 4 * kq) * DNW + h * HD + vs * 32 + 16 * ct + r;
#pragma unroll
    for (int n = 0; n < NCH; n += 2) {
        scan_step(A, B, p, St, Ut, s0, s1, orow + (size_t)n * CH * DNW, __int_as_float(__builtin_amdgcn_readlane(glall, n)), n + 1, r, kq, rt, ct, wave, J, scA, scB, J.q0 + n, J.q0 + n + 1, lane);
        scan_step(B, A, p, St, Ut, s0, s1, orow + (size_t)(n + 1) * CH * DNW, __int_as_float(__builtin_amdgcn_readlane(glall, n + 1)), (n + 2 < NCH) ? n + 2 : n + 1, r, kq, rt, ct, wave, J, scB, scA, J.q0 + n + 1, (n + 2 < NCH) ? J.q0 + n + 2 : -1, lane);
    }
    __syncthreads();
}

__device__ __forceinline__ void ab_logits(const bf16* XN, const bf16* Wab, float* ABP, int job, int lane) {
    const int r = lane & 15, kq = lane >> 4, tile = job >> 2, q = job & 3;
    const bf16* ap = XN + (size_t)(16 * tile + r) * D + q * (D / 4) + 8 * kq; const bf16* b0p = Wab + (size_t)r * D + q * (D / 4) + 8 * kq; const bf16* b1p = b0p + (size_t)16 * D;
    f32x4 acc0 = {0.f, 0.f, 0.f, 0.f}, acc1 = {0.f, 0.f, 0.f, 0.f};
#pragma unroll 16
    for (int ks = 0; ks < D / 128; ++ks) { const bf16x8 a = *(const bf16x8*)(ap + 32 * ks), b0 = *(const bf16x8*)(b0p + 32 * ks), b1 = *(const bf16x8*)(b1p + 32 * ks);
        acc0 = __builtin_amdgcn_mfma_f32_16x16x32_bf16(a, b0, acc0, 0, 0, 0); acc1 = __builtin_amdgcn_mfma_f32_16x16x32_bf16(a, b1, acc1, 0, 0, 0); }
    float* o = ABP + (size_t)q * M * 32 + (size_t)(16 * tile + 4 * kq) * 32 + r;
#pragma unroll
    for (int reg = 0; reg < 4; ++reg) { o[reg * 32] = acc0[reg]; o[reg * 32 + 16] = acc1[reg]; }
}

__device__ __forceinline__ void dn_gated_norm(const float* O, const bf16* proj, const float* wn, bf16* ON, int gtid, int NT) {
    for (int idx = gtid; idx < M * NH * 16; idx += NT) {
        const int pair = idx >> 4, sub = idx & 15, row = pair >> 4, h = pair & 15, c = h * HD + sub * 8;
        const f32x4 o0 = *(const f32x4*)(O + (size_t)row * DNW + c), o1 = *(const f32x4*)(O + (size_t)row * DNW + c + 4);
        float ss = (o0.x * o0.x + o0.y * o0.y) + (o0.z * o0.z + o0.w * o0.w) + (o1.x * o1.x + o1.y * o1.y) + (o1.z * o1.z + o1.w * o1.w);
        ss += __shfl_xor(ss, 1); ss += __shfl_xor(ss, 2); ss += __shfl_xor(ss, 4); ss += __shfl_xor(ss, 8);
        const float rstd = 1.0f / sqrtf(ss * (1.0f / HD) + EPS);
        const v4u z = *(const v4u*)(proj + (size_t)row * NPP + OFF_Z + c);
        const f32x4 w0 = *(const f32x4*)(wn + sub * 8), w1 = *(const f32x4*)(wn + sub * 8 + 4);
        const float z0 = bfl(z.x), z1 = bfh(z.x), z2 = bfl(z.y), z3 = bfh(z.y), z4 = bfl(z.z), z5 = bfh(z.z), z6 = bfl(z.w), z7 = bfh(z.w);
        v4u o; o.x = pk2(o0.x * rstd * w0.x * (z0 * sigm(z0)), o0.y * rstd * w0.y * (z1 * sigm(z1))); o.y = pk2(o0.z * rstd * w0.z * (z2 * sigm(z2)), o0.w * rstd * w0.w * (z3 * sigm(z3)));
        o.z = pk2(o1.x * rstd * w1.x * (z4 * sigm(z4)), o1.y * rstd * w1.y * (z5 * sigm(z5))); o.w = pk2(o1.z * rstd * w1.z * (z6 * sigm(z6)), o1.w * rstd * w1.w * (z7 * sigm(z7)));
        *(v4u*)(ON + (size_t)row * DNW + c) = o;
    }
}

__device__ __forceinline__ void xattn_unit(const float* QP, const unsigned long long* ssq, const bf16* KB, const bf16* VT, bf16* XO, LAS unsigned char* lds, int unit, int tid) {
    const int lane = tid & 63, wave = __builtin_amdgcn_readfirstlane(tid >> 6), r = lane & 15, kq = lane >> 4;
    const int b = unit >> 6, hd = (unit >> 4) & 3, qt = unit & 15;
    LAS unsigned char* Ksm = lds; LAS unsigned char* Vtm = lds + 256 * 272;
    {
        const int seg = tid & 15, rr = tid >> 4;
#pragma unroll
        for (int p = 0; p < 8; ++p) { const int key = rr + 32 * p; const v4u v = *(const v4u*)(KB + (size_t)(b * MEMT + key) * XW + hd * HD + seg * 8); *(LAS v4u*)(Ksm + key * 272 + seg * 16) = v; }
        const int seg2 = tid & 31, r2 = tid >> 5;
#pragma unroll
        for (int p = 0; p < 8; ++p) { const int d = r2 + 16 * p; const v4u v = *(const v4u*)(VT + ((size_t)(b * 4 + hd) * HD + d) * MEMT + seg2 * 8); *(LAS v4u*)(Vtm + d * 528 + seg2 * 16) = v; }
    }
    const size_t qrow = (size_t)b * SEQ + qt * 128 + wave * 16 + r;
    bf16x8 qf[4];
    const float qs = 0.08838834764831845f * 1.4426950408889634f / sqrtf((float)ssq[qrow] * SSQ_INVK + EPS);
#pragma unroll
    for (int ks = 0; ks < 4; ++ks) { const float* qp = QP + qrow * XW + hd * HD + 32 * ks + 8 * kq; f32x4 a = {0.f, 0.f, 0.f, 0.f}, c = {0.f, 0.f, 0.f, 0.f};
#pragma unroll
        for (int g = 0; g < 4; ++g) { a += *(const f32x4*)(qp + (size_t)g * M * XW); c += *(const f32x4*)(qp + (size_t)g * M * XW + 4); }
        a = a * qs; c = c * qs;
        v4u w; w.x = pk2(a.x, a.y); w.y = pk2(a.z, a.w); w.z = pk2(c.x, c.y); w.w = pk2(c.z, c.w); qf[ks] = __builtin_bit_cast(bf16x8, w); }
    __syncthreads();
    f32x4 sc[16];
#pragma unroll
    for (int t = 0; t < 16; ++t) { sc[t] = (f32x4){0.f, 0.f, 0.f, 0.f};
#pragma unroll
        for (int ks = 0; ks < 4; ++ks) { const bf16x8 kf = *(const LAS bf16x8*)(Ksm + (16 * t + r) * 272 + (32 * ks + 8 * kq) * 2);
            sc[t] = __builtin_amdgcn_mfma_f32_16x16x32_bf16(kf, qf[ks], sc[t], 0, 0, 0); } }
    float mx = -3.0e38f;
#pragma unroll
    for (int t = 0; t < 16; ++t) mx = fmaxf(mx, fmaxf(fmaxf(sc[t].x, sc[t].y), fmaxf(sc[t].z, sc[t].w)));
    mx = fmaxf(mx, __shfl_xor(mx, 16)); mx = fmaxf(mx, __shfl_xor(mx, 32));
    float sum = 0.f;
#pragma unroll
    for (int t = 0; t < 16; ++t) {
#pragma unroll
        for (int e = 0; e < 4; ++e) { sc[t][e] = __builtin_amdgcn_exp2f(sc[t][e] - mx); sum += sc[t][e]; } }
    sum += __shfl_xor(sum, 16); sum += __shfl_xor(sum, 32);
    const float inv = 1.0f / sum;
    bf16x8 pf[8];
#pragma unroll
    for (int s = 0; s < 8; ++s) { v4u w; w.x = pk2(sc[2 * s].x, sc[2 * s].y); w.y = pk2(sc[2 * s].z, sc[2 * s].w); w.z = pk2(sc[2 * s + 1].x, sc[2 * s + 1].y); w.w = pk2(sc[2 * s + 1].z, sc[2 * s + 1].w);
        pf[s] = __builtin_bit_cast(bf16x8, w); }
#pragma unroll
    for (int dt = 0; dt < 8; ++dt) { f32x4 o = {0.f, 0.f, 0.f, 0.f};
#pragma unroll
        for (int s = 0; s < 8; ++s) { const LAS unsigned char* vp = Vtm + (16 * dt + r) * 528 + (32 * s + 4 * kq) * 2;
            const unsigned long long lo = *(const LAS unsigned long long*)vp, hi = *(const LAS unsigned long long*)(vp + 32);
            v4u w; w.x = (unsigned)lo; w.y = (unsigned)(lo >> 32); w.z = (unsigned)hi; w.w = (unsigned)(hi >> 32);
            o = __builtin_amdgcn_mfma_f32_16x16x32_bf16(__builtin_bit_cast(bf16x8, w), pf[s], o, 0, 0, 0); }
        o = o * inv;
        *(unsigned long long*)(XO + qrow * XW + hd * HD + 16 * dt + 4 * kq) = (unsigned long long)pk2(o.x, o.y) | ((unsigned long long)pk2(o.z, o.w) << 32); }
    __syncthreads();
}

struct Args { const float* in[27]; float* out; unsigned char* ws; int ph_lo, ph_hi; };
enum { I_X = 0, I_MEM, I_F1N, I_F1G, I_F1U, I_F1D, I_MIXN, I_WIN, I_CONVW, I_QKVW, I_ALOG, I_DTB, I_DNN, I_WOC, I_WOD, I_WO, I_XAN, I_MEMN, I_XWQ, I_XWK, I_XWV, I_XWO, I_F2N, I_F2G, I_F2U, I_F2D, I_FINN };

typedef const __attribute__((address_space(4))) Args* KArgs;
__device__ __forceinline__ KArgs kargs() { KArgs p = (KArgs)__builtin_amdgcn_kernarg_segment_ptr(); asm volatile("" : "+s"(p)); return p; }
#define PH_BEGIN KArgs A = kargs(); unsigned char* const ws = A->ws; (void)ws;
#define W1GU ((bf16*)(ws + WS_W1GU))
#define W1D ((bf16*)(ws + WS_W1D))
#define W2GU ((bf16*)(ws + WS_W2GU))
#define W2D ((bf16*)(ws + WS_W2D))
#define WIN ((bf16*)(ws + WS_WIN))
#define WA ((bf16*)(ws + WS_WA))
#define WB ((bf16*)(ws + WS_WB))
#define WO ((bf16*)(ws + WS_WO))
#define WQ ((bf16*)(ws + WS_WQ))
#define WKV ((bf16*)(ws + WS_WKV))
#define WXO ((bf16*)(ws + WS_WXO))
#define XN ((bf16*)(ws + WS_XN))
#define ACT ((bf16*)(ws + WS_R))
#define PROJ ((bf16*)(ws + WS_R))
#define MN ((bf16*)(ws + WS_MN))
#define KB ((bf16*)(ws + WS_KB))
#define VT ((bf16*)(ws + WS_VT))
#define OB ((float*)(ws + WS_O))
#define CONVA ((bf16*)(ws + WS_CONVA))
#define ON ((bf16*)(ws + WS_ON))
#define QP ((float*)(ws + WS_QP))
#define AB ((float*)(ws + WS_AB))
#define HB ((bf16*)(ws + WS_XNB))
#define SSQ(i) ((unsigned long long*)(ws + WS_SSQ) + (i) * M)
#define XO ((bf16*)(ws + WS_XO))
#define H (A->out)
#define INP(i) (A->in[i])
__global__ void __launch_bounds__(NTHREADS, 2) fwd_kernel(Args args) {
    extern __shared__ __attribute__((aligned(16))) unsigned char lds_raw[];
    LAS unsigned char* lds = (LAS unsigned char*)lds_raw;
    volatile LAS unsigned* MISC = (volatile LAS unsigned*)(lds + MISC_OFF);
    const int tid = threadIdx.x, lane = tid & 63, wave = __builtin_amdgcn_readfirstlane(tid >> 6);
    const int G = gridDim.x, bx = blockIdx.x;
    const int vcu = (G % 8 == 0) ? (bx % 8) * (G / 8) + bx / 8 : bx;
    const int gw = vcu * NWAVES + wave, NGW = G * NWAVES, gtid = vcu * NTHREADS + tid, NT = G * NTHREADS;
    gu32* ctl = (gu32*)(args.ws + WS_CTL);
    for (int u = tid; u < (LDS_BYTES - MISC_OFF) / 4; u += NTHREADS) ((LAS unsigned*)(lds + MISC_OFF))[u] = 0u;
    __syncthreads();
    XcdBarrier bar; bar.bar = (unsigned*)(ctl + CW_BAR); bar.x = 0; bar.st = nullptr;
    const int lo = args.ph_lo, hi = args.ph_hi;
    if (hi - lo > 1) bar = xcd_barrier_post((unsigned*)(ctl + CW_BAR), MISC + 8);
#define IN(k) (lo <= (k) && (k) < hi)
#define SEAM(k) do { if (IN(k) && IN((k) + 1)) xcd_barrier(bar); } while (0)
    if (IN(0)) for (int rep_ = 0; rep_ < (PROBE_PHASE == 0 ? PROBE_REPS : 1); ++rep_) { PH_BEGIN
        LAS float* scr = (LAS float*)(lds + wave * 16384);
        transpose_weight(INP(I_F1D), FF, D, W1D, FF, 0, 0, nullptr, scr, gw, NGW, lane);
        transpose_weight(INP(I_WIN), D, NPROJ, WIN, D, 3, 0, INP(I_MIXN), scr, gw, NGW, lane);
        transpose_weight(INP(I_XWQ), D, XW, WQ, D, 0, 0, INP(I_XAN), scr, gw, NGW, lane);
        transpose_weight(INP(I_XWK), D, XW, WKV, D, 0, 0, nullptr, scr, gw, NGW, lane);
        transpose_weight(INP(I_XWV), D, XW, WKV, D, 0, XW, nullptr, scr, gw, NGW, lane);
        transpose_weight(INP(I_XWO), XW, D, WXO, XW, 0, 0, nullptr, scr, gw, NGW, lane);
        { constexpr int IG = (D / 64) * (FF / 32); for (int it = SIDE_ITEMS - 2 * IG + gw; it < IG; it += NGW) { float rr[32]; const TwItem t = tw_item(it, D / 32, 0, 0); tw_load(rr, INP(I_F2D), D, t, lane); tw_store(rr, W2D, FF, nullptr, t, scr, lane); } }
        transpose_weight(INP(I_F1G), D, FF, W1GU, D, 1, 0, nullptr, scr, gw, NGW, lane);
        transpose_weight(INP(I_F1U), D, FF, W1GU, D, 2, 0, nullptr, scr, gw, NGW, lane);
        rms_rows<false>(INP(I_X), INP(I_F1N), XN, M, gw, NGW, lane);
        rms_rows<false>(INP(I_MEM), INP(I_MEMN), MN, BATCH * MEMT, gw, NGW, lane);
    }
    SEAM(0);
    if (IN(1)) for (int rep_ = 0; rep_ < (PROBE_PHASE == 1 ? PROBE_REPS : 1); ++rep_) { PH_BEGIN
        pg8::Gemm g{XN, W1GU, M, 2 * FF, D, D, D}; pg8::OrderFfnKv S; S.init(M, 2 * FF, G, bx); S.A1 = MN; S.B1 = WKV;
        pg8::EpiSwiGLUKV E{{ACT, FF, nullptr, 0.f, 0.f}, {KB, VT}};
        pg8::gemm_phase<pg8::EpiSwiGLUKV, pg8::OrderFfnKv, true, true>(lds, g, S, E);
        const int rounds = (S.nwg + 16 + G - 1) / G, first_idle = S.nwg + 16 - (rounds - 1) * G;
        if (first_idle < G) { if (bx >= first_idle) { const int gw2 = (bx - first_idle) * NWAVES + wave, NGW2 = (G - first_idle) * NWAVES; LAS float* scr = (LAS float*)(lds + wave * 16384);
            transpose_weight(INP(I_WOC), CW, D, WA, CW, 0, 0, nullptr, scr, gw2, NGW2, lane);
            transpose_weight(INP(I_WOD), DNW, D, WB, DNW, 0, 0, nullptr, scr, gw2, NGW2, lane);
            transpose_weight(INP(I_WO), D, D, WO, D, 0, 0, nullptr, scr, gw2, NGW2, lane); } }
        else { LAS float* scr = (LAS float*)(lds + wave * 16384);
            transpose_weight(INP(I_WOC), CW, D, WA, CW, 0, 0, nullptr, scr, gw, NGW, lane);
            transpose_weight(INP(I_WOD), DNW, D, WB, DNW, 0, 0, nullptr, scr, gw, NGW, lane);
            transpose_weight(INP(I_WO), D, D, WO, D, 0, 0, nullptr, scr, gw, NGW, lane); }
    }
    SEAM(1);
    if (IN(2)) { PH_BEGIN
        pg8::Gemm g{ACT, W1D, M, D, FF, FF, FF}; pg8::StaticOrder S; S.init(M, D, G, bx);
        pg8::EpiResidBf<true> E{INP(I_X), HB, D, 0.5f, SSQ(0)};
        pg8::gemm_phase<pg8::EpiResidBf<true>, pg8::StaticOrder, true, true>(lds, g, S, E);
    }
    SEAM(2);
    if (IN(3)) for (int rep_ = 0; rep_ < (PROBE_PHASE == 3 ? PROBE_REPS : 1); ++rep_) { PH_BEGIN
        pg8::Gemm g{HB, WIN, M, NPP, D, D, D}; pg8::StaticOrder S; S.init(M, NPP, G, bx);
        pg8::EpiStoreBf16 E{PROJ, NPP, SSQ(0), SSQ_INVK, EPS};
        pg8::gemm_phase<pg8::EpiStoreBf16, pg8::StaticOrder, true, true>(lds, g, S, E);
        for (int job = gw; job < (M / 16) * 4; job += NGW) ab_logits(HB, WIN + (size_t)NPP * D, AB, job, lane);
    }
    SEAM(3);
    if (IN(4)) for (int rep_ = 0; rep_ < (PROBE_PHASE == 4 ? PROBE_REPS : 1); ++rep_) { PH_BEGIN
        for (int pair = vcu; pair < BATCH * NH * NCH / 2; pair += G) dn_chunk_pair(PROJ, AB, SSQ(0), INP(I_QKVW), INP(I_ALOG), INP(I_DTB), ws, lds, pair, tid, INP(I_CONVW), CONVA);
    }
    SEAM(4);
    if (IN(5)) for (int rep_ = 0; rep_ < (PROBE_PHASE == 5 ? PROBE_REPS : 1); ++rep_) { PH_BEGIN for (int unit = vcu; unit < BATCH * NH * 4; unit += G) { SideJob J{INP(I_F2G), INP(I_F2U), INP(I_F2D), W2GU, W2D, INP(I_F2N), nullptr, (unit * NWAVES + wave) * NCH}; dn_scan_unit(ws, lds, OB, unit, tid, J); } }
    SEAM(5);
    if (IN(6)) for (int rep_ = 0; rep_ < (PROBE_PHASE == 6 ? PROBE_REPS : 1); ++rep_) { PH_BEGIN dn_gated_norm(OB, PROJ, INP(I_DNN), ON, gtid, NT); }
    SEAM(6);
    if (IN(7)) for (int rep_ = 0; rep_ < (PROBE_PHASE == 7 ? PROBE_REPS : 1); ++rep_) { PH_BEGIN
        pg8::Gemm g{CONVA, WA, M, D, CW, CW, CW}; pg8::OrderTwoPass S; S.init(M, D, G, bx); S.A1 = ON; S.B1 = WB;
        pg8::EpiGateFused E{XN, D, PROJ + OFF_GA, PROJ + OFF_GB, NPP};
        pg8::gemm_phase<pg8::EpiGateFused, pg8::OrderTwoPass, true, true>(lds, g, S, E);
    }
    SEAM(7);
    if (IN(8)) { PH_BEGIN
        pg8::Gemm g{XN, WO, M, D, D, D, D}; pg8::StaticOrder S; S.init(M, D, G, bx);
        pg8::EpiResidBf<false> E{HB, HB, D, 1.0f, SSQ(1)};
        pg8::gemm_phase<pg8::EpiResidBf<false>, pg8::StaticOrder, true, true>(lds, g, S, E);
    }
    SEAM(8);
    if (IN(9)) for (int rep_ = 0; rep_ < (PROBE_PHASE == 9 ? PROBE_REPS : 1); ++rep_) { PH_BEGIN
        pg8::Gemm g{HB, WQ, M, XW, D / 4, D, D}; pg8::OrderSplitK4 S{G, bx, (D / 4) * 2};
        pg8::EpiPartF32 E{QP, XW, (size_t)M * XW};
        pg8::gemm_phase<pg8::EpiPartF32, pg8::OrderSplitK4, true, true>(lds, g, S, E);
    }
    SEAM(9);
    if (IN(10)) for (int rep_ = 0; rep_ < (PROBE_PHASE == 10 ? PROBE_REPS : 1); ++rep_) { PH_BEGIN for (int unit = vcu; unit < BATCH * 4 * (SEQ / 128); unit += G) xattn_unit(QP, SSQ(1), KB, VT, XO, lds, unit, tid); }
    SEAM(10);
    if (IN(11)) { PH_BEGIN
        pg8::Gemm g{XO, WXO, M, D, XW, XW, XW}; pg8::StaticOrder S; S.init(M, D, G, bx);
        pg8::EpiResidBf<false> E{HB, HB, D, 1.0f, SSQ(2)};
        pg8::gemm_phase<pg8::EpiResidBf<false>, pg8::StaticOrder, true, true>(lds, g, S, E);
    }
    SEAM(11);
    if (IN(12)) for (int rep_ = 0; rep_ < (PROBE_PHASE == 12 ? PROBE_REPS : 1); ++rep_) { PH_BEGIN
        pg8::Gemm g{HB, W2GU, M, 2 * FF, D, D, D}; pg8::StaticOrder S; S.init(M, 2 * FF, G, bx);
        pg8::EpiSwiGLUrs E{ACT, FF, SSQ(2), SSQ_INVK, EPS};
        pg8::gemm_phase<pg8::EpiSwiGLUrs, pg8::StaticOrder, true, true>(lds, g, S, E);
    }
    SEAM(12);
    if (IN(13)) { PH_BEGIN
        pg8::Gemm g{ACT, W2D, M, D, FF, FF, FF}; pg8::StaticOrder S; S.init(M, D, G, bx);
        pg8::EpiResidBf<false> E{HB, HB, D, 0.5f, SSQ(3)};
        pg8::gemm_phase<pg8::EpiResidBf<false>, pg8::StaticOrder, true, true>(lds, g, S, E);
    }
    SEAM(13);
    if (IN(14)) { PH_BEGIN final_norm(HB, SSQ(3), INP(I_FINN), H, gw, NGW, lane); }
#undef IN
#undef SEAM
}

extern "C" void kernel_launch(void* const* d_in, const int* in_sizes, int n_in, void* d_out, int out_size, void* d_ws, size_t ws_size, hipStream_t stream) {
    static int grid = 0;
    if (grid == 0) {
        if (n_in != 27 || out_size != M * D || ws_size < WS_END) { fprintf(stderr, "kernel_launch: unexpected problem (n_in %d, out %d, ws %zu < %zu)\n", n_in, out_size, ws_size, (size_t)WS_END); grid = -1; return; }
        int dev = 0, cus = 0, per_cu = 0;
        if (hipGetDevice(&dev) != hipSuccess || hipDeviceGetAttribute(&cus, hipDeviceAttributeMultiprocessorCount, dev) != hipSuccess) { grid = -1; return; }
        if (hipFuncSetAttribute((const void*)fwd_kernel, hipFuncAttributeMaxDynamicSharedMemorySize, LDS_BYTES) != hipSuccess) { fprintf(stderr, "kernel_launch: hipFuncSetAttribute failed\n"); grid = -1; return; }
        if (hipOccupancyMaxActiveBlocksPerMultiprocessor(&per_cu, (const void*)fwd_kernel, NTHREADS, LDS_BYTES) != hipSuccess || per_cu < 1) { fprintf(stderr, "kernel_launch: occupancy query reports %d blocks per CU\n", per_cu); (void)hipGetLastError(); grid = -1; return; }
        grid = cus;
    }
    if (grid < 0) return;
    (void)hipMemsetAsync((char*)d_ws + WS_CTL, 0, CTL_ZERO_BYTES, stream);
    Args a{};
    for (int i = 0; i < 27; ++i) a.in[i] = (const float*)d_in[i];
    a.out = (float*)d_out; a.ws = (unsigned char*)d_ws;
#if MK_N_LAUNCHES == 1
    a.ph_lo = 0; a.ph_hi = NPH;
    hipLaunchKernelGGL(fwd_kernel, dim3(grid), dim3(NTHREADS), LDS_BYTES, stream, a);
#else
    for (int p = 0; p < NPH; ++p) { a.ph_lo = p; a.ph_hi = p + 1; hipLaunchKernelGGL(fwd_kernel, dim3(grid), dim3(NTHREADS), LDS_BYTES, stream, a); }
#endif
}
```

```cpp
#include <hip/hip_runtime.h>
#include <cstdio>
#include <cstdint>
#ifndef MK_N_LAUNCHES
#define MK_N_LAUNCHES 1
#endif
namespace pg8 {
#define PG8_LAS __attribute__((address_space(3)))
typedef unsigned short bf16_t;
typedef short bf16x8 __attribute__((ext_vector_type(8)));
typedef float f32x4 __attribute__((ext_vector_type(4)));
typedef unsigned u32x4 __attribute__((ext_vector_type(4)));
constexpr int BM = 256, BK = 64, HALF = 128, HTB = HALF * BK * 2  , STAGE_BYTES = 8 * HTB, NXCD = 8, WGM = 8;

__host__ __device__ __forceinline__ int lds_byte(int r, int c) { const int st = (r >> 4) * 2 + (c >> 5), rr = r & 15, cc = c & 31, ob = rr * 64 + cc * 2; return st * 1024 + (ob ^ (((ob >> 9) & 1) << 5)); }
__host__ __device__ __forceinline__ void stage_rc(int b, int& R, int& C) { const int st = b / 1024, sb = b % 1024, swz = sb ^ (((sb >> 9) & 1) << 5); R = (st >> 1) * 16 + swz / 64; C = (st & 1) * 32 + (swz % 64) / 2; }
__host__ __device__ __forceinline__ int perm32(int rho) { const int n = rho >> 4, i = rho & 15; return 8 * (i >> 2) + 4 * n + (i & 3); }

struct Unit { int pm, pn, g; };
struct Gemm { const bf16_t* A; const bf16_t* Bt; int M, N, K, lda, ldb; };

struct StaticOrder {
    int nM, nN, nwg, G, c;
    __host__ __device__ void init(int M, int N, int G_, int c_) { nM = M / BM; nN = N / BM; nwg = nM * nN; G = G_; c = c_; }
    __host__ __device__ bool next(int i, Unit& u) const {
        const long L = (long)i * G + c; if (L >= nwg) return false;
        int wgid = (int)L; { const int q = nwg / NXCD, r = nwg % NXCD, xcd = wgid % NXCD, off = wgid / NXCD; wgid = (xcd < r ? xcd * (q + 1) : r * (q + 1) + (xcd - r) * q) + off; }
        const int nig = WGM * nN, gid = wgid / nig, fm = gid * WGM, gsz = (nM - fm) < WGM ? (nM - fm) : WGM;
        u.pm = fm + ((wgid % nig) % gsz); u.pn = (wgid % nig) / gsz; u.g = 0; return true;
    }
    __device__ __forceinline__ const char* pa(const Gemm& g, const Unit& u, size_t tstepA) const { return (const char*)g.A + (size_t)u.pm * tstepA; }
    __device__ __forceinline__ const char* pb(const Gemm& g, const Unit& u, size_t tstepB) const { return (const char*)g.Bt + (size_t)u.pn * tstepB; }
    __device__ __forceinline__ bool keep(const Unit&) const { return false; }
    __device__ __forceinline__ void a_ready(const Unit&) const {}
    __device__ __forceinline__ void done(const Unit&) const {}
};

__device__ __forceinline__ unsigned cvt_pk_bf16(float lo, float hi) { unsigned r; asm volatile("v_cvt_pk_bf16_f32 %0, %1, %2" : "=v"(r) : "v"(lo), "v"(hi)); return r; }
__device__ __forceinline__ float bf_lo(unsigned w) { return __uint_as_float(w << 16); }
__device__ __forceinline__ float bf_hi(unsigned w) { return __uint_as_float(w & 0xffff0000u); }
__device__ __forceinline__ float fast_sigmoid(float x) { return __builtin_amdgcn_rcpf(1.0f + __builtin_amdgcn_exp2f(-1.4426950408889634f * x)); }
__device__ __forceinline__ float fast_silu(float x) { return x * fast_sigmoid(x); }

template <bool RS> struct EpiSwiGLUT {
    static constexpr bool PERM = true, AFTER_DRAIN = false, PRE = RS;
    bf16_t* O; int ldc; const unsigned long long* ssq; float inv_k, eps;
    __device__ __forceinline__ float pre_load(const Unit& u, int tid) const { return (tid < BM) ? (float)ssq[u.pm * BM + tid] : 0.f; }
    __device__ __forceinline__ void pre_store(PG8_LAS float* slot, int tid, float v) const { if (tid < BM) slot[tid] = 1.0f / sqrtf(v * inv_k + eps); }
    __device__ __forceinline__ void operator()(const f32x4 (&acc)[2][2][4][2], const Unit& u, int wr, int wc, int fr, int fq, const PG8_LAS float* rsl = nullptr) const {
        const int row0 = u.pm * BM + wr * 64 + fr, col0 = u.pn * HALF + wc * 32 + 8 * fq;
#pragma unroll
        for (int ai = 0; ai < 2; ++ai)
#pragma unroll
            for (int m = 0; m < 4; ++m) { bf16_t* rowp = O + (size_t)(row0 + ai * HALF + m * 16) * ldc + col0;
                const float rs = RS ? rsl[wr * 64 + fr + ai * HALF + m * 16] : 1.0f;
                const f32x4 g0 = acc[ai][0][m][0] * rs, g1 = acc[ai][0][m][1] * rs, u0 = acc[ai][1][m][0] * rs, u1 = acc[ai][1][m][1] * rs;
                f32x4 v0, v1;
#pragma unroll
                for (int j = 0; j < 4; ++j) { v0[j] = fast_silu(g0[j]) * u0[j]; v1[j] = fast_silu(g1[j]) * u1[j]; }
                u32x4 w; w.x = cvt_pk_bf16(v0[0], v0[1]); w.y = cvt_pk_bf16(v0[2], v0[3]); w.z = cvt_pk_bf16(v1[0], v1[1]); w.w = cvt_pk_bf16(v1[2], v1[3]);
                *(u32x4*)rowp = w; }
    }
};
typedef EpiSwiGLUT<false> EpiSwiGLU;
typedef EpiSwiGLUT<true> EpiSwiGLUrs;
template <bool XF32> struct EpiResidBf {
    static constexpr bool PERM = true, AFTER_DRAIN = false, PRE = false;
    const void* base; bf16_t* out; int ldc; float alpha; unsigned long long* ssq;
    __device__ __forceinline__ void operator()(const f32x4 (&acc)[2][2][4][2], const Unit& u, int wr, int wc, int fr, int fq) const {
        const int row0 = u.pm * BM + wr * 64 + fr, col0 = u.pn * BM + wc * 32 + 8 * fq;
#pragma unroll
        for (int ai = 0; ai < 2; ++ai) {
            f32x4 b[4][2][2];
#pragma unroll
            for (int m = 0; m < 4; ++m) { const size_t off = (size_t)(row0 + ai * HALF + m * 16) * ldc + col0;
#pragma unroll
                for (int bj = 0; bj < 2; ++bj) {
                    if (XF32) { b[m][bj][0] = *(const f32x4*)((const float*)base + off + bj * HALF); b[m][bj][1] = *(const f32x4*)((const float*)base + off + bj * HALF + 4); }
                    else { const u32x4 w = *(const u32x4*)((const bf16_t*)base + off + bj * HALF);
                        b[m][bj][0] = (f32x4){bf_lo(w.x), bf_hi(w.x), bf_lo(w.y), bf_hi(w.y)}; b[m][bj][1] = (f32x4){bf_lo(w.z), bf_hi(w.z), bf_lo(w.w), bf_hi(w.w)}; } } }
#pragma unroll
            for (int m = 0; m < 4; ++m) { const size_t off = (size_t)(row0 + ai * HALF + m * 16) * ldc + col0; float ss = 0.f;
#pragma unroll
                for (int bj = 0; bj < 2; ++bj) { const f32x4 o0 = b[m][bj][0] + acc[ai][bj][m][0] * alpha, o1 = b[m][bj][1] + acc[ai][bj][m][1] * alpha;
                    ss += ((o0[0] * o0[0] + o0[1] * o0[1]) + (o0[2] * o0[2] + o0[3] * o0[3])) + ((o1[0] * o1[0] + o1[1] * o1[1]) + (o1[2] * o1[2] + o1[3] * o1[3]));
                    u32x4 w; w.x = cvt_pk_bf16(o0[0], o0[1]); w.y = cvt_pk_bf16(o0[2], o0[3]); w.z = cvt_pk_bf16(o1[0], o1[1]); w.w = cvt_pk_bf16(o1[2], o1[3]);
                    *(u32x4*)(out + off + bj * HALF) = w; }
                ss += __shfl_xor(ss, 16); ss += __shfl_xor(ss, 32);
                if (fq == 0) __hip_atomic_fetch_add(ssq + row0 + ai * HALF + m * 16, (unsigned long long)(ss * 1048576.0f + 0.5f), __ATOMIC_RELAXED, __HIP_MEMORY_SCOPE_AGENT); }
        }
    }
};
struct EpiStoreBf16 {
    static constexpr bool PERM = true, AFTER_DRAIN = false, PRE = true;
    bf16_t* O; int ldc; const unsigned long long* ssq; float inv_k, eps;
    __device__ __forceinline__ float pre_load(const Unit& u, int tid) const { return (tid < BM) ? (float)ssq[u.pm * BM + tid] : 0.f; }
    __device__ __forceinline__ void pre_store(PG8_LAS float* slot, int tid, float v) const { if (tid < BM) slot[tid] = 1.0f / sqrtf(v * inv_k + eps); }
    __device__ __forceinline__ void operator()(const f32x4 (&acc)[2][2][4][2], const Unit& u, int wr, int wc, int fr, int fq, const PG8_LAS float* rsl) const {
        const int row0 = u.pm * BM + wr * 64 + fr, col0 = u.pn * BM + wc * 32 + 8 * fq;
#pragma unroll
        for (int ai = 0; ai < 2; ++ai)
#pragma unroll
            for (int m = 0; m < 4; ++m) { bf16_t* rowp = O + (size_t)(row0 + ai * HALF + m * 16) * ldc + col0;
                const float scale = rsl[wr * 64 + fr + ai * HALF + m * 16];
#pragma unroll
                for (int bj = 0; bj < 2; ++bj) { const f32x4 v0 = acc[ai][bj][m][0] * scale, v1 = acc[ai][bj][m][1] * scale;
                    u32x4 w; w.x = cvt_pk_bf16(v0[0], v0[1]); w.y = cvt_pk_bf16(v0[2], v0[3]); w.z = cvt_pk_bf16(v1[0], v1[1]); w.w = cvt_pk_bf16(v1[2], v1[3]);
                    *(u32x4*)(rowp + bj * HALF) = w; } }
    }
};
struct EpiKV {
    static constexpr bool PERM = true, AFTER_DRAIN = false, PRE = false;
    bf16_t* KB; bf16_t* VT;
    __device__ __forceinline__ void operator()(const f32x4 (&acc)[2][2][4][2], const Unit& u, int wr, int wc, int fr, int fq) const {
        const int rl0 = wr * 64 + fr;
        if (u.pn < 2) {
            const int col0 = u.pn * BM + wc * 32 + 8 * fq;
#pragma unroll
            for (int ai = 0; ai < 2; ++ai)
#pragma unroll
                for (int m = 0; m < 4; ++m) { bf16_t* rowp = KB + (size_t)(u.pm * BM + rl0 + ai * HALF + m * 16) * 512 + col0;
#pragma unroll
                    for (int bj = 0; bj < 2; ++bj) { const f32x4 v0 = acc[ai][bj][m][0], v1 = acc[ai][bj][m][1];
                        u32x4 w; w.x = cvt_pk_bf16(v0[0], v0[1]); w.y = cvt_pk_bf16(v0[2], v0[3]); w.z = cvt_pk_bf16(v1[0], v1[1]); w.w = cvt_pk_bf16(v1[2], v1[3]);
                        *(u32x4*)(rowp + bj * HALF) = w; } }
        } else {
            const int colv0 = (u.pn - 2) * BM + wc * 32 + 8 * fq;
#pragma unroll
            for (int ai = 0; ai < 2; ++ai)
#pragma unroll
                for (int m = 0; m < 4; ++m) { const int key = rl0 + ai * HALF + m * 16;
#pragma unroll
                    for (int bj = 0; bj < 2; ++bj)
#pragma unroll
                        for (int n = 0; n < 2; ++n)
#pragma unroll
                            for (int e = 0; e < 4; ++e) { const int cv = colv0 + bj * HALF + 4 * n + e;
                                VT[((size_t)u.pm * 512 + cv) * 256 + key] = (bf16_t)(cvt_pk_bf16(acc[ai][bj][m][n][e], 0.f) & 0xffffu); } }
        }
    }
};
struct EpiGateA {
    static constexpr bool PERM = true, AFTER_DRAIN = false, PRE = false;
    float* T; int ldc; const bf16_t* G; int ldg;
    __device__ __forceinline__ void operator()(const f32x4 (&acc)[2][2][4][2], const Unit& u, int wr, int wc, int fr, int fq) const {
        const int row0 = u.pm * BM + wr * 64 + fr, col0 = u.pn * BM + wc * 32 + 8 * fq;
#pragma unroll
        for (int ai = 0; ai < 2; ++ai)
#pragma unroll
            for (int m = 0; m < 4; ++m) { const size_t row = (size_t)(row0 + ai * HALF + m * 16);
#pragma unroll
                for (int bj = 0; bj < 2; ++bj) { const int c = col0 + bj * HALF; const u32x4 gw = *(const u32x4*)(G + row * ldg + c);
                    f32x4 v0 = acc[ai][bj][m][0], v1 = acc[ai][bj][m][1];
                    v0[0] *= fast_sigmoid(bf_lo(gw.x)); v0[1] *= fast_sigmoid(bf_hi(gw.x)); v0[2] *= fast_sigmoid(bf_lo(gw.y)); v0[3] *= fast_sigmoid(bf_hi(gw.y));
                    v1[0] *= fast_sigmoid(bf_lo(gw.z)); v1[1] *= fast_sigmoid(bf_hi(gw.z)); v1[2] *= fast_sigmoid(bf_lo(gw.w)); v1[3] *= fast_sigmoid(bf_hi(gw.w));
                    *(f32x4*)(T + row * ldc + c) = v0; *(f32x4*)(T + row * ldc + c + 4) = v1; } }
    }
};
struct EpiGateB {
    static constexpr bool PERM = true, AFTER_DRAIN = false, PRE = false;
    const float* T; bf16_t* O; int ldc; const bf16_t* G; int ldg;
    __device__ __forceinline__ void operator()(const f32x4 (&acc)[2][2][4][2], const Unit& u, int wr, int wc, int fr, int fq) const {
        const int row0 = u.pm * BM + wr * 64 + fr, col0 = u.pn * BM + wc * 32 + 8 * fq;
#pragma unroll
        for (int ai = 0; ai < 2; ++ai)
#pragma unroll
            for (int m = 0; m < 4; ++m) { const size_t row = (size_t)(row0 + ai * HALF + m * 16);
#pragma unroll
                for (int bj = 0; bj < 2; ++bj) { const int c = col0 + bj * HALF; const u32x4 gw = *(const u32x4*)(G + row * ldg + c);
                    const f32x4 t0 = *(const f32x4*)(T + row * ldc + c), t1 = *(const f32x4*)(T + row * ldc + c + 4);
                    f32x4 v0 = acc[ai][bj][m][0], v1 = acc[ai][bj][m][1];
                    v0[0] = t0[0] + v0[0] * fast_sigmoid(bf_lo(gw.x)); v0[1] = t0[1] + v0[1] * fast_sigmoid(bf_hi(gw.x)); v0[2] = t0[2] + v0[2] * fast_sigmoid(bf_lo(gw.y)); v0[3] = t0[3] + v0[3] * fast_sigmoid(bf_hi(gw.y));
                    v1[0] = t1[0] + v1[0] * fast_sigmoid(bf_lo(gw.z)); v1[1] = t1[1] + v1[1] * fast_sigmoid(bf_hi(gw.z)); v1[2] = t1[2] + v1[2] * fast_sigmoid(bf_lo(gw.w)); v1[3] = t1[3] + v1[3] * fast_sigmoid(bf_hi(gw.w));
                    u32x4 w; w.x = cvt_pk_bf16(v0[0], v0[1]); w.y = cvt_pk_bf16(v0[2], v0[3]); w.z = cvt_pk_bf16(v1[0], v1[1]); w.w = cvt_pk_bf16(v1[2], v1[3]);
                    *(u32x4*)(O + row * ldc + c) = w; } }
    }
};

struct OrderFfnKv : StaticOrder {
    const bf16_t* A1; const bf16_t* B1;
    __device__ __forceinline__ bool next(int i, Unit& u) const {
        if (StaticOrder::next(i, u)) return true;
        const long L = (long)i * G + c - nwg; if (L < 0 || L >= 16) return false;
        u.g = 1; u.pm = (int)(L >> 2); u.pn = (int)(L & 3); return true; }
    __device__ __forceinline__ const char* pa(const Gemm& g, const Unit& u, size_t tstepA) const { return (const char*)(u.g ? A1 : g.A) + (size_t)u.pm * tstepA; }
    __device__ __forceinline__ const char* pb(const Gemm& g, const Unit& u, size_t tstepB) const { return (const char*)(u.g ? B1 : g.Bt) + (size_t)u.pn * tstepB; }
};
struct EpiSwiGLUKV {
    static constexpr bool PERM = true, AFTER_DRAIN = false, PRE = false;
    EpiSwiGLU e0; EpiKV e1;
    __device__ __forceinline__ void operator()(const f32x4 (&acc)[2][2][4][2], const Unit& u, int wr, int wc, int fr, int fq) const { if (u.g == 0) e0(acc, u, wr, wc, fr, fq); else e1(acc, u, wr, wc, fr, fq); }
};
struct OrderSplitK4 {
    int G, c, ks_bytes;
    __device__ __forceinline__ bool next(int i, Unit& u) const { const long L = (long)i * G + c; if (L >= 256) return false; u.pm = (int)(L >> 3); u.pn = (int)((L >> 2) & 1); u.g = (int)(L & 3); return true; }
    __device__ __forceinline__ const char* pa(const Gemm& g, const Unit& u, size_t tstepA) const { return (const char*)g.A + (size_t)u.pm * tstepA + (size_t)u.g * ks_bytes; }
    __device__ __forceinline__ const char* pb(const Gemm& g, const Unit& u, size_t tstepB) const { return (const char*)g.Bt + (size_t)u.pn * tstepB + (size_t)u.g * ks_bytes; }
    __device__ __forceinline__ bool keep(const Unit&) const { return false; }
    __device__ __forceinline__ void a_ready(const Unit&) const {}
    __device__ __forceinline__ void done(const Unit&) const {}
};
struct EpiPartF32 {
    static constexpr bool PERM = false, AFTER_DRAIN = false, PRE = false;
    float* P; int ldc; size_t gstride;
    __device__ __forceinline__ void operator()(const f32x4 (&acc)[2][2][4][2], const Unit& u, int wr, int wc, int fr, int fq) const {
        const int row0 = u.pm * BM + wr * 64 + fr, col0 = u.pn * BM + wc * 32 + 4 * fq; float* out = P + (size_t)u.g * gstride;
#pragma unroll
        for (int ai = 0; ai < 2; ++ai)
#pragma unroll
            for (int m = 0; m < 4; ++m) { const size_t off = (size_t)(row0 + ai * HALF + m * 16) * ldc + col0;
#pragma unroll
                for (int bj = 0; bj < 2; ++bj)
#pragma unroll
                    for (int n = 0; n < 2; ++n) *(f32x4*)(out + off + bj * HALF + n * 16) = acc[ai][bj][m][n]; }
    }
};
struct OrderTwoPass : StaticOrder {
    const bf16_t* A1; const bf16_t* B1;
    __device__ __forceinline__ bool next(int i, Unit& u) const { if (!StaticOrder::next(i >> 1, u)) return false; u.g = i & 1; return true; }
    __device__ __forceinline__ const char* pa(const Gemm& g, const Unit& u, size_t tstepA) const { return (const char*)(u.g ? A1 : g.A) + (size_t)u.pm * tstepA; }
    __device__ __forceinline__ const char* pb(const Gemm& g, const Unit& u, size_t tstepB) const { return (const char*)(u.g ? B1 : g.Bt) + (size_t)u.pn * tstepB; }
    __device__ __forceinline__ bool keep(const Unit& u) const { return u.g == 0; }
};
struct EpiGateFused {
    static constexpr bool PERM = true, AFTER_DRAIN = false, PRE = false;
    bf16_t* O; int ldc; const bf16_t* GA; const bf16_t* GB; int ldg;
    __device__ __forceinline__ void operator()(f32x4 (&acc)[2][2][4][2], const Unit& u, int wr, int wc, int fr, int fq) const {
        const int row0 = u.pm * BM + wr * 64 + fr, col0 = u.pn * BM + wc * 32 + 8 * fq;
#pragma unroll
        for (int ai = 0; ai < 2; ++ai) {
            u32x4 gbv[4][2], gav[4][2];
#pragma unroll
            for (int m = 0; m < 4; ++m) { const size_t row = (size_t)(row0 + ai * HALF + m * 16);
#pragma unroll
                for (int bj = 0; bj < 2; ++bj) { gbv[m][bj] = *(const u32x4*)(GB + row * ldg + col0 + bj * HALF); if (u.g == 0) gav[m][bj] = *(const u32x4*)(GA + row * ldg + col0 + bj * HALF); } }
#pragma unroll
            for (int m = 0; m < 4; ++m) { const size_t row = (size_t)(row0 + ai * HALF + m * 16);
#pragma unroll
                for (int bj = 0; bj < 2; ++bj) { const int c = col0 + bj * HALF; const u32x4 gb = gbv[m][bj];
                    float eb[8] = {bf_lo(gb.x), bf_hi(gb.x), bf_lo(gb.y), bf_hi(gb.y), bf_lo(gb.z), bf_hi(gb.z), bf_lo(gb.w), bf_hi(gb.w)};
#pragma unroll
                    for (int e = 0; e < 8; ++e) eb[e] = 1.0f + __builtin_amdgcn_exp2f(-1.4426950408889634f * eb[e]);
                    if (u.g == 0) { const u32x4 ga = gav[m][bj];
                        float ea[8] = {bf_lo(ga.x), bf_hi(ga.x), bf_lo(ga.y), bf_hi(ga.y), bf_lo(ga.z), bf_hi(ga.z), bf_lo(ga.w), bf_hi(ga.w)};
#pragma unroll
                        for (int e = 0; e < 8; ++e) { const float rt = eb[e] * __builtin_amdgcn_rcpf(1.0f + __builtin_amdgcn_exp2f(-1.4426950408889634f * ea[e]));
                            acc[ai][bj][m][e >> 2][e & 3] *= rt; }
                    } else { f32x4 v0 = acc[ai][bj][m][0], v1 = acc[ai][bj][m][1];
#pragma unroll
                        for (int e = 0; e < 4; ++e) { v0[e] *= __builtin_amdgcn_rcpf(eb[e]); v1[e] *= __builtin_amdgcn_rcpf(eb[4 + e]); }
                        u32x4 w; w.x = cvt_pk_bf16(v0[0], v0[1]); w.y = cvt_pk_bf16(v0[2], v0[3]); w.z = cvt_pk_bf16(v1[0], v1[1]); w.w = cvt_pk_bf16(v1[2], v1[3]);
                        *(u32x4*)(O + row * ldc + c) = w; } } }
        }
    }
};


template <class Epi, class Sched, bool ALIGN_EPI = false, bool SP2 = false>
__device__ __forceinline__ void gemm_phase(PG8_LAS unsigned char* lds, const Gemm g, const Sched& S, const Epi& E) {
    const int tid = threadIdx.x, wid = __builtin_amdgcn_readfirstlane(tid >> 6), lane = tid & 63, wr = wid >> 2, wc = wid & 3, fr = lane & 15, fq = lane >> 4;
    const int K = g.K, nt = K / BK;
    unsigned voffA[2], voffB[2];
#pragma unroll
    for (int i = 0; i < 2; ++i) { int R, C; stage_rc(tid * 16 + i * 8192, R, C); const int Rb = Epi::PERM ? ((R & ~31) + perm32(R & 31)) : R;
        voffA[i] = (unsigned)(R * g.lda + C) * 2u; voffB[i] = (unsigned)(Rb * g.ldb + C) * 2u; }
    const size_t kstep = (size_t)(BK * 2);
    const size_t hstepA = (size_t)HALF * g.lda * 2, hstepB = (size_t)HALF * g.ldb * 2;
    const size_t tstepA = 2 * hstepA, tstepB = 2 * hstepB;
    const unsigned ldsw = (unsigned)wid * 1024u;
    const int aoff = lds_byte(wr * 64 + fr, fq * 8), boff = lds_byte(wc * 32 + fr, fq * 8);
#define PG8_SA(b, h) (((b) * 2 + (h)) * HTB)
#define PG8_SB(b, h) ((4 + (b) * 2 + (h)) * HTB)
#define PG8_STAGE(bufoff, gbase, voff) do { _Pragma("unroll") for (int _i = 0; _i < 2; ++_i) \
        __builtin_amdgcn_global_load_lds((const unsigned*)((const char*)(gbase) + (voff)[_i]), (PG8_LAS unsigned*)(lds + (bufoff) + ldsw + _i * 8192), 16, 0, 0); } while (0)
#define PG8_LDA(dst, b, h) do { _Pragma("unroll") for (int m = 0; m < 4; ++m) _Pragma("unroll") for (int k = 0; k < 2; ++k) dst[m][k] = *(const PG8_LAS bf16x8*)(lds + PG8_SA(b, h) + aoff + m * 2048 + k * 1024); } while (0)
#define PG8_LDB(dst, b, h) do { _Pragma("unroll") for (int n = 0; n < 2; ++n) _Pragma("unroll") for (int k = 0; k < 2; ++k) dst[n][k] = *(const PG8_LAS bf16x8*)(lds + PG8_SB(b, h) + boff + n * 2048 + k * 1024); } while (0)
#define PG8_MMA(ai, bj, At, Bt) do { __builtin_amdgcn_s_setprio(1); _Pragma("unroll") for (int m = 0; m < 4; ++m) _Pragma("unroll") for (int n = 0; n < 2; ++n) _Pragma("unroll") for (int k = 0; k < 2; ++k) \
        acc[ai][bj][m][n] = __builtin_amdgcn_mfma_f32_16x16x32_bf16(Bt[n][k], At[m][k], acc[ai][bj][m][n], 0, 0, 0); __builtin_amdgcn_s_setprio(0); } while (0)
#define PG8_WAIT_V(n) asm volatile("s_waitcnt vmcnt(" #n ")" ::: "memory")
#define PG8_WAIT_L(n) asm volatile("s_waitcnt lgkmcnt(" #n ")" ::: "memory")
#define PG8_BAR __builtin_amdgcn_s_barrier()
#define PG8_SCHED __builtin_amdgcn_sched_barrier(0)
    Unit cur, nxt; int ui = 0;
    if (!S.next(0, cur)) return;
    f32x4 acc[2][2][4][2];
#pragma unroll
    for (int a = 0; a < 2; ++a)
#pragma unroll
        for (int b = 0; b < 2; ++b)
#pragma unroll
            for (int m = 0; m < 4; ++m)
#pragma unroll
                for (int n = 0; n < 2; ++n) acc[a][b][m][n] = (f32x4){0.f, 0.f, 0.f, 0.f};
    bf16x8 At[4][2], B0[2][2], B1[2][2];
    const char* cA = S.pa(g, cur, tstepA); const char* cB = S.pb(g, cur, tstepB);
    PG8_LAS float* const rsl = (PG8_LAS float*)(lds + STAGE_BYTES); float pv = 0.f; int slot = 0;
    if constexpr (Epi::PRE) pv = E.pre_load(cur, tid);
    S.a_ready(cur);
    if constexpr (SP2) {
        PG8_STAGE(PG8_SB(0, 0), cB, voffB); PG8_STAGE(PG8_SB(0, 1), cB + hstepB, voffB); PG8_STAGE(PG8_SA(0, 0), cA, voffA); PG8_STAGE(PG8_SA(0, 1), cA + hstepA, voffA);
        if (wr == 1) PG8_BAR;
        PG8_WAIT_V(2); if constexpr (Epi::PRE) E.pre_store(rsl, tid, pv); PG8_BAR;
        PG8_STAGE(PG8_SB(1, 0), cB + kstep, voffB); PG8_STAGE(PG8_SA(1, 0), cA + kstep, voffA); PG8_STAGE(PG8_SB(1, 1), cB + hstepB + kstep, voffB);
        PG8_WAIT_V(6); PG8_BAR;
    } else {
        PG8_STAGE(PG8_SB(0, 0), cB, voffB); PG8_STAGE(PG8_SA(0, 0), cA, voffA); PG8_STAGE(PG8_SB(0, 1), cB + hstepB, voffB); PG8_STAGE(PG8_SA(0, 1), cA + hstepA, voffA);
        if (wr == 1) PG8_BAR;
        PG8_WAIT_V(4); if constexpr (Epi::PRE) E.pre_store(rsl, tid, pv); PG8_BAR;
        PG8_STAGE(PG8_SB(1, 0), cB + kstep, voffB); PG8_STAGE(PG8_SA(1, 0), cA + kstep, voffA); PG8_STAGE(PG8_SB(1, 1), cB + hstepB + kstep, voffB);
        PG8_WAIT_V(6); PG8_BAR;
    }
    for (;;) {
        const bool has_next = S.next(ui + 1, nxt);
        const char* nA = has_next ? S.pa(g, nxt, tstepA) : cA; const char* nB = has_next ? S.pb(g, nxt, tstepB) : cB;
        for (int t = 0; t < nt; t += 2) {
            const bool last = (t == nt - 2);
            const char* a1 = cA + (size_t)(t + 1) * kstep;
            const char* a2 = last ? nA : cA + (size_t)(t + 2) * kstep; const char* b2 = last ? nB : cB + (size_t)(t + 2) * kstep;
            const char* a3 = a2 + kstep; const char* b3 = b2 + kstep;
            if (last && has_next) S.a_ready(nxt);
            if constexpr (SP2) {
            PG8_LDB(B0, 0, 0); PG8_LDB(B1, 0, 1); PG8_SCHED; PG8_LDA(At, 0, 0); PG8_STAGE(PG8_SA(1, 1), a1 + hstepA, voffA);
            PG8_WAIT_V(8); PG8_WAIT_L(0); PG8_BAR; PG8_MMA(0, 0, At, B0); PG8_MMA(0, 1, At, B1); PG8_BAR; PG8_SCHED;
            PG8_LDA(At, 0, 1); PG8_STAGE(PG8_SB(0, 0), b2, voffB); PG8_STAGE(PG8_SB(0, 1), b2 + hstepB, voffB); PG8_STAGE(PG8_SA(0, 0), a2, voffA);
            PG8_WAIT_V(8); PG8_WAIT_L(0); PG8_BAR; PG8_MMA(1, 0, At, B0); PG8_MMA(1, 1, At, B1); PG8_BAR; PG8_SCHED;
            PG8_LDB(B0, 1, 0); PG8_LDB(B1, 1, 1); PG8_SCHED; PG8_LDA(At, 1, 0); PG8_STAGE(PG8_SA(0, 1), a2 + hstepA, voffA);
            PG8_WAIT_V(8); PG8_WAIT_L(0); PG8_BAR; PG8_MMA(0, 0, At, B0); PG8_MMA(0, 1, At, B1); PG8_BAR; PG8_SCHED;
            PG8_LDA(At, 1, 1); PG8_STAGE(PG8_SB(1, 0), b3, voffB); PG8_STAGE(PG8_SB(1, 1), b3 + hstepB, voffB); PG8_STAGE(PG8_SA(1, 0), a3, voffA);
            PG8_WAIT_V(8); PG8_WAIT_L(0); PG8_BAR; PG8_MMA(1, 0, At, B0); PG8_MMA(1, 1, At, B1); PG8_BAR; PG8_SCHED;
            } else {
            PG8_LDB(B0, 0, 0); PG8_SCHED; PG8_LDA(At, 0, 0); PG8_STAGE(PG8_SA(1, 1), a1 + hstepA, voffA);
            PG8_WAIT_L(8); PG8_BAR; PG8_WAIT_L(0); PG8_MMA(0, 0, At, B0); PG8_BAR; PG8_SCHED;
            PG8_LDB(B1, 0, 1); PG8_STAGE(PG8_SB(0, 0), b2, voffB);
            PG8_BAR; PG8_WAIT_L(0); PG8_MMA(0, 1, At, B1); PG8_BAR;
            PG8_LDA(At, 0, 1); PG8_STAGE(PG8_SA(0, 0), a2, voffA);
            PG8_BAR; PG8_WAIT_L(0); PG8_MMA(1, 0, At, B0); PG8_BAR; PG8_SCHED;
            PG8_STAGE(PG8_SB(0, 1), b2 + hstepB, voffB);
            PG8_WAIT_V(6); PG8_BAR; PG8_MMA(1, 1, At, B1); PG8_BAR;
            PG8_LDB(B0, 1, 0); PG8_SCHED; PG8_LDA(At, 1, 0); PG8_STAGE(PG8_SA(0, 1), a2 + hstepA, voffA);
            PG8_WAIT_L(8); PG8_BAR; PG8_WAIT_L(0); PG8_MMA(0, 0, At, B0); PG8_BAR; PG8_SCHED;
            PG8_LDB(B1, 1, 1); PG8_STAGE(PG8_SB(1, 0), b3, voffB);
            PG8_BAR; PG8_WAIT_L(0); PG8_MMA(0, 1, At, B1); PG8_BAR;
            PG8_LDA(At, 1, 1); PG8_STAGE(PG8_SA(1, 0), a3, voffA);
            PG8_BAR; PG8_WAIT_L(0); PG8_MMA(1, 0, At, B0); PG8_BAR; PG8_SCHED;
            PG8_STAGE(PG8_SB(1, 1), b3 + hstepB, voffB);
            PG8_WAIT_V(6); PG8_BAR; PG8_MMA(1, 1, At, B1); PG8_BAR;
            }
        }
        if constexpr (ALIGN_EPI) { if (wr == 0) PG8_BAR; }
        if constexpr (!Epi::AFTER_DRAIN) {
            if constexpr (Epi::PRE) { float pn_ = 0.f; if (has_next) pn_ = E.pre_load(nxt, tid); E(acc, cur, wr, wc, fr, fq, rsl + slot * 256); if (has_next) E.pre_store(rsl + (slot ^ 1) * 256, tid, pn_); slot ^= 1; }
            else E(acc, cur, wr, wc, fr, fq);
            S.done(cur); }
        if (!has_next) break;
        if (!S.keep(cur))
#pragma unroll
        for (int a = 0; a < 2; ++a)
#pragma unroll
            for (int b = 0; b < 2; ++b)
#pragma unroll
                for (int m = 0; m < 4; ++m)
#pragma unroll
                    for (int n = 0; n < 2; ++n) acc[a][b][m][n] = (f32x4){0.f, 0.f, 0.f, 0.f};
        cur = nxt; cA = nA; cB = nB; ++ui;
        if constexpr (ALIGN_EPI) { if (wr == 1) PG8_BAR; }
    }
    PG8_WAIT_V(0);
    if constexpr (!ALIGN_EPI) { if (wr == 0) PG8_BAR; }
    PG8_BAR;
    if constexpr (Epi::AFTER_DRAIN) { E.fused(acc, cur, wr, wc, fr, fq, lds, wid, lane); S.done(cur); }
#undef PG8_SA
#undef PG8_SB
#undef PG8_STAGE
#undef PG8_LDA
#undef PG8_LDB
#undef PG8_MMA
#undef PG8_WAIT_V
#undef PG8_WAIT_L
#undef PG8_BAR
#undef PG8_SCHED
}
}
#define GAS __attribute__((address_space(1)))
#define LAS __attribute__((address_space(3)))
typedef unsigned short bf16;
typedef unsigned v4u __attribute__((ext_vector_type(4)));
typedef float f32x4 __attribute__((ext_vector_type(4)));
typedef short bf16x8 __attribute__((ext_vector_type(8)));
typedef GAS unsigned gu32;
typedef GAS unsigned long long gu64;
#define RLX_AGENT __ATOMIC_RELAXED, __HIP_MEMORY_SCOPE_AGENT
#define LDS_WAIT() asm volatile("s_waitcnt lgkmcnt(0)" ::: "memory")
#define VM_WAIT() asm volatile("s_waitcnt vmcnt(0)" ::: "memory")
__device__ __forceinline__ unsigned long long rt() { return __builtin_amdgcn_s_memrealtime(); }
__device__ __forceinline__ unsigned f2bf(float f) { unsigned u = __builtin_bit_cast(unsigned, f); return (u + 0x7fffu + ((u >> 16) & 1u)) >> 16; }
__device__ __forceinline__ unsigned pk2(float lo, float hi) { return f2bf(lo) | (f2bf(hi) << 16); }

#define XB_TMO      128
#define XB_XCNT(j)  (256  + 64 * (j))
#define XB_XSUB(j)  (1280 + 64 * (j))
#define XB_XGEN(j)  (2304 + 64 * (j))
#define XB_TOP      3328
#define XB_TOPGEN   3392
#define XCD_BAR_WORDS 3456
#define XB_SPIN_CAP (1u << 18)

__device__ __forceinline__ unsigned xb_ld(unsigned* p)              { return __hip_atomic_load(p, __ATOMIC_RELAXED, __HIP_MEMORY_SCOPE_AGENT); }
__device__ __forceinline__ unsigned xb_add(unsigned* p, unsigned v) { return __hip_atomic_fetch_add(p, v, __ATOMIC_RELAXED, __HIP_MEMORY_SCOPE_AGENT); }
__device__ __forceinline__ unsigned xb_xcc_id() { return (unsigned)__builtin_amdgcn_s_getreg((3 << 11) | 20) & 0xFu; }
#define XB_SPIN(cond, bar) do { unsigned _sp = 0; while (cond) { __builtin_amdgcn_s_sleep(1); \
    if ((++_sp & 255u) == 0u) { if (xb_ld(&(bar)[XB_TMO])) break; if (_sp > XB_SPIN_CAP) { atomicAdd(&(bar)[XB_TMO], 1u); break; } } } } while (0)

struct XcdBarrier {
    unsigned* bar; unsigned x;
    volatile LAS unsigned* st;
};

__device__ __forceinline__ XcdBarrier xcd_barrier_post(unsigned* bar, volatile LAS unsigned* st) {
    XcdBarrier b; b.bar = bar; b.x = xb_xcc_id(); b.st = st;
    if (threadIdx.x == 0) (void)xb_add(&bar[XB_XCNT(b.x)], 1u);
    return b;
}
__device__ __forceinline__ void xcd_barrier_complete(unsigned* bar, unsigned x, unsigned& nloc, unsigned& nx) {
    const unsigned G = gridDim.x * gridDim.y * gridDim.z;
    unsigned sum, cnt, mine, sp = 0u;
    for (;;) {
        sum = 0u; cnt = 0u; mine = 0u;
#pragma unroll
        for (unsigned j = 0; j < 16; ++j) { const unsigned c = xb_ld(&bar[XB_XCNT(j)]); sum += c; cnt += (c > 0u) ? 1u : 0u; mine = (j == x) ? c : mine; }
        if (sum == G) break;
        __builtin_amdgcn_s_sleep(1);
        if ((++sp & 255u) == 0u) { if (xb_ld(&bar[XB_TMO])) break; if (sp > XB_SPIN_CAP) { atomicAdd(&bar[XB_TMO], 1u); break; } }
    }
    nloc = mine > 0u ? mine : 1u; nx = cnt > 0u ? cnt : 1u;
}

__device__ __forceinline__ void xcd_barrier(const XcdBarrier& b) {
    asm volatile("s_waitcnt vmcnt(0)" ::: "memory");
    __syncthreads();
    if (threadIdx.x == 0) {
        unsigned* bar = b.bar;
        __builtin_amdgcn_s_waitcnt(0);
        unsigned nloc = b.st[0], nx = b.st[1];
        if (nloc == 0u) { xcd_barrier_complete(bar, b.x, nloc, nx); b.st[0] = nloc; b.st[1] = nx; }
        const unsigned old = xb_add(&bar[XB_XSUB(b.x)], 1u);
        const unsigned gen = old / nloc;
        if (old + 1u == (gen + 1u) * nloc) {
            __builtin_amdgcn_fence(__ATOMIC_RELEASE, "agent");
            asm volatile("s_waitcnt vmcnt(0)" ::: "memory");
            const unsigned og = xb_add(&bar[XB_TOP], 1u);
            const unsigned tg = og / nx;
            if (og + 1u == (tg + 1u) * nx) xb_add(&bar[XB_TOPGEN], 1u);
            else XB_SPIN(xb_ld(&bar[XB_TOPGEN]) == tg, bar);
            __builtin_amdgcn_fence(__ATOMIC_ACQUIRE, "agent");
            xb_add(&bar[XB_XGEN(b.x)], 1u);
            asm volatile("s_waitcnt vmcnt(0)" ::: "memory");
        } else {
            XB_SPIN(xb_ld(&bar[XB_XGEN(b.x)]) == gen, bar);
            __builtin_amdgcn_fence(__ATOMIC_ACQUIRE, "agent");
            asm volatile("s_waitcnt vmcnt(0)" ::: "memory");
        }
    }
    __syncthreads();
}

constexpr int NWAVES = 8, NTHREADS = NWAVES * 64;
constexpr int BATCH = 4, SEQ = 2048, D = 4096, FF = 11008, M = BATCH * SEQ;
constexpr int CW = 2048, DNW = 2048, NH = 16, HD = 128, CH = 64, NCH = SEQ / CH;
constexpr int NPROJ = 22560, NPP = 22528;
constexpr int OFF_CX = 0, OFF_CC = 2048, OFF_CB = 4096, OFF_Q = 6144, OFF_Z = 12288, OFF_GA = 14336, OFF_GB = 18432;
constexpr int MEMT = 256, XW = 512;
constexpr float EPS = 1e-6f;
constexpr float SSQ_INVK = 1.0f / (4096.0f * 1048576.0f);
#ifndef PROBE_PHASE
#define PROBE_REPS 3
#define PROBE_SUB 0
#define PROBE_PHASE -1
#endif
constexpr int NPH = 15;

constexpr size_t MiB = 1u << 20;
constexpr size_t WS_CTL = 0, CTL_ZERO_BYTES = 1 * MiB;
constexpr size_t WS_W1GU = 1 * MiB, WS_W1D = 173 * MiB, WS_W2GU = 259 * MiB, WS_W2D = 431 * MiB, WS_WIN = 517 * MiB;
constexpr size_t WS_WA = 695 * MiB, WS_WB = 711 * MiB, WS_WO = 727 * MiB, WS_WQ = 759 * MiB, WS_WKV = 763 * MiB, WS_WXO = 771 * MiB;
constexpr size_t WS_XN = 775 * MiB;
constexpr size_t WS_R = 839 * MiB;
constexpr size_t WS_DN = 1195 * MiB;
constexpr size_t WS_WC = WS_DN, WS_UB = WS_DN + 64 * MiB, WS_QD = WS_DN + 128 * MiB, WS_KTT = WS_DN + 192 * MiB, WS_AQK = WS_DN + 256 * MiB, WS_GL = WS_DN + 288 * MiB;
constexpr size_t WS_TMP = WS_DN;
constexpr size_t WS_MN = 1484 * MiB, WS_KB = 1492 * MiB, WS_VT = 1493 * MiB, WS_AB = 1494 * MiB, WS_XNB = 1498 * MiB, WS_END = 1562 * MiB;
constexpr size_t WS_O = WS_W1GU, WS_CONVA = WS_W1GU + 64 * MiB, WS_ON = WS_W1GU + 96 * MiB, WS_XO = WS_W1GU + 136 * MiB;
constexpr size_t WS_QP = WS_O;
constexpr int CW_TMO = 0, CW_BAR = 4096;
constexpr size_t WS_SSQ = 65536;
constexpr int RING_BYTES = 131072;
constexpr int ATT_LDS = 256 * 272 + 128 * 528;
constexpr int MISC_OFF = 147456;
constexpr int LDS_BYTES = 151552;
static_assert(ATT_LDS <= MISC_OFF && MISC_OFF + 128 <= LDS_BYTES, "LDS map");

__device__ __forceinline__ float bfl(unsigned w) { return __uint_as_float(w << 16); }
__device__ __forceinline__ float bfh(unsigned w) { return __uint_as_float(w & 0xffff0000u); }
__device__ __forceinline__ float bf1(bf16 v) { return __uint_as_float(((unsigned)v) << 16); }
__device__ __forceinline__ float sigm(float x) { return __builtin_amdgcn_rcpf(1.0f + __builtin_amdgcn_exp2f(-1.4426950408889634f * x)); }
__device__ __forceinline__ float wave_sum(float v) {
#pragma unroll
    for (int o = 1; o < 64; o <<= 1) v += __shfl_xor(v, o);
    return v;
}

struct TwItem { int k0, n0, drow0; };
__device__ __forceinline__ TwItem tw_item(int item, int nblk, int mode, int roff) {
    TwItem t; const int kb = item / nblk, nb = item - kb * nblk; t.k0 = 64 * kb; t.n0 = 32 * nb;
    t.drow0 = (mode == 0) ? (roff + t.n0) : (mode == 3) ? ((t.n0 < 14336) ? t.n0 : (t.n0 < 14368) ? (NPP + t.n0 - 14336) : (t.n0 - 32))
                                          : (256 * (t.n0 >> 7) + 128 * (mode - 1) + (t.n0 & 127));
    return t;
}
__device__ __forceinline__ void tw_load(float (&r)[32], const float* W, int N, const TwItem& t, int lane) {
    const float* p = W + (size_t)(t.k0 + (lane >> 5)) * N + t.n0 + (lane & 31);
#pragma unroll
    for (int i = 0; i < 32; ++i) r[i] = __builtin_nontemporal_load(p + (size_t)(2 * i) * N);
}
__device__ __forceinline__ void tw_store(const float (&r)[32], bf16* WT, int ldk, const float* gain, const TwItem& t, LAS float* scr, int lane) {
#pragma unroll
    for (int i = 0; i < 32; ++i) scr[(2 * i + (lane >> 5)) * 33 + (lane & 31)] = r[i];
    LDS_WAIT(); asm volatile("" ::: "memory");
    const int c = lane & 7;
    f32x4 g0 = {1.f, 1.f, 1.f, 1.f}, g1 = {1.f, 1.f, 1.f, 1.f};
    if (gain) { g0 = *(const f32x4*)(gain + t.k0 + 8 * c); g1 = *(const f32x4*)(gain + t.k0 + 8 * c + 4); }
#pragma unroll
    for (int j = 0; j < 4; ++j) { const int n = (lane >> 3) + 8 * j; const LAS float* s = scr + (8 * c) * 33 + n;
        v4u o; o.x = pk2(s[0 * 33] * g0.x, s[1 * 33] * g0.y); o.y = pk2(s[2 * 33] * g0.z, s[3 * 33] * g0.w); o.z = pk2(s[4 * 33] * g1.x, s[5 * 33] * g1.y); o.w = pk2(s[6 * 33] * g1.z, s[7 * 33] * g1.w);
        *(v4u*)(WT + (size_t)(t.drow0 + n) * ldk + t.k0 + 8 * c) = o; }
    LDS_WAIT(); asm volatile("" ::: "memory");
}
__device__ __forceinline__ void transpose_weight(const float* W, int K, int N, bf16* WT, int ldk, int mode, int roff, const float* gain, LAS float* scr, int gw, int NGW, int lane) {
    const int nblk = N / 32, nitems = (K / 64) * nblk;
    int item = gw; if (item >= nitems) return;
    float ra[32], rb[32];
    TwItem ta = tw_item(item, nblk, mode, roff), tb = ta;
    tw_load(ra, W, N, ta, lane);
    for (;;) {
        bool hn = item + NGW < nitems;
        if (hn) { tb = tw_item(item + NGW, nblk, mode, roff); tw_load(rb, W, N, tb, lane); }
        tw_store(ra, WT, ldk, gain, ta, scr, lane);
        if (!hn) break;
        item += NGW; hn = item + NGW < nitems;
        if (hn) { ta = tw_item(item + NGW, nblk, mode, roff); tw_load(ra, W, N, ta, lane); }
        tw_store(rb, WT, ldk, gain, tb, scr, lane);
        if (!hn) break;
        item += NGW;
    }
}
template <bool OUT_F32>
__device__ __forceinline__ void rms_rows(const float* X, const float* w, void* out, int nrows, int gw, int NGW, int lane) {
    for (int m = gw; m < nrows; m += NGW) {
        const f32x4* xr = (const f32x4*)(X + (size_t)m * D) + lane;
        f32x4 v[16]; float s = 0.f;
#pragma unroll
        for (int j = 0; j < 16; ++j) { v[j] = xr[64 * j]; s += (v[j].x * v[j].x + v[j].y * v[j].y) + (v[j].z * v[j].z + v[j].w * v[j].w); }
        const float rstd = 1.0f / sqrtf(wave_sum(s) * (1.0f / D) + EPS);
        const f32x4* wr = (const f32x4*)w + lane;
        if (OUT_F32) { f32x4* o = (f32x4*)((float*)out + (size_t)m * D) + lane;
#pragma unroll
            for (int j = 0; j < 16; ++j) { const f32x4 g = wr[64 * j]; o[64 * j] = v[j] * rstd * g; }
        } else { unsigned long long* o8 = (unsigned long long*)((bf16*)out + (size_t)m * D) + lane;
#pragma unroll
            for (int j = 0; j < 16; ++j) { const f32x4 g = wr[64 * j]; const f32x4 y = v[j] * rstd * g;
                o8[64 * j] = (unsigned long long)pk2(y.x, y.y) | ((unsigned long long)pk2(y.z, y.w) << 32); } }
    }
}

__device__ __forceinline__ void final_norm(const bf16* HBp, const unsigned long long* ssq, const float* w, float* out, int gw, int NGW, int lane) {
    for (int m = gw; m < M; m += NGW) {
        const float rstd = 1.0f / sqrtf((float)ssq[m] * SSQ_INVK + EPS);
        const v4u* hr = (const v4u*)(HBp + (size_t)m * D) + lane; f32x4* o = (f32x4*)(out + (size_t)m * D) + 2 * lane; const f32x4* wr = (const f32x4*)w + 2 * lane;
#pragma unroll
        for (int j = 0; j < 8; ++j) { const v4u h = hr[64 * j]; const f32x4 g0 = wr[128 * j], g1 = wr[128 * j + 1];
            o[128 * j] = (f32x4){bfl(h.x), bfh(h.x), bfl(h.y), bfh(h.y)} * rstd * g0; o[128 * j + 1] = (f32x4){bfl(h.z), bfh(h.z), bfl(h.w), bfh(h.w)} * rstd * g1; }
    }
}

__device__ __forceinline__ void conv_branch_a(const bf16* proj, const float* conv_w, bf16* outA, int idx0, int idx1, int stride) {
    for (int idx = idx0; idx < idx1; idx += stride) {
        const int row = idx >> 8, c0 = (idx & 255) * 8, s = row & (SEQ - 1);
        float y[8];
#pragma unroll
        for (int e = 0; e < 8; ++e) y[e] = 0.f;
#pragma unroll
        for (int k = 0; k < 3; ++k) {
            const int sk = s - 2 + k; const float mk = (sk >= 0) ? 1.f : 0.f;
            const bf16* pr = proj + (size_t)(sk >= 0 ? row - 2 + k : row) * NPP;
            const v4u xc = *(const v4u*)(pr + OFF_CX + c0), cc = *(const v4u*)(pr + OFF_CC + c0);
            const f32x4 w0 = *(const f32x4*)(conv_w + k * CW + c0) * mk, w1 = *(const f32x4*)(conv_w + k * CW + c0 + 4) * mk;
            y[0] += w0.x * (bfl(xc.x) * bfl(cc.x)); y[1] += w0.y * (bfh(xc.x) * bfh(cc.x)); y[2] += w0.z * (bfl(xc.y) * bfl(cc.y)); y[3] += w0.w * (bfh(xc.y) * bfh(cc.y));
            y[4] += w1.x * (bfl(xc.z) * bfl(cc.z)); y[5] += w1.y * (bfh(xc.z) * bfh(cc.z)); y[6] += w1.z * (bfl(xc.w) * bfl(cc.w)); y[7] += w1.w * (bfh(xc.w) * bfh(cc.w));
        }
        const v4u cb = *(const v4u*)(proj + (size_t)row * NPP + OFF_CB + c0);
        v4u o; o.x = pk2(y[0] * bfl(cb.x), y[1] * bfh(cb.x)); o.y = pk2(y[2] * bfl(cb.y), y[3] * bfh(cb.y)); o.z = pk2(y[4] * bfl(cb.z), y[5] * bfh(cb.z)); o.w = pk2(y[6] * bfl(cb.w), y[7] * bfh(cb.w));
        *(v4u*)(outA + (size_t)row * CW + c0) = o;
    }
}

constexpr int XS = 136, LS = 68;
constexpr int CH_LDS = 3 * 64 * XS * 2 + 64 * LS * 4 + 4 * 64 * 4;
static_assert(2 * CH_LDS <= MISC_OFF, "two chunks per workgroup");
__device__ __forceinline__ void dn_chunk_pair(const bf16* proj, const float* AB, const unsigned long long* ssq, const float* qkv_w, const float* a_log, const float* dt_bias, unsigned char* ws, LAS unsigned char* lds, int pair, int tid, const float* conv_w, bf16* convA) {
    const int lane = tid & 63, wave = __builtin_amdgcn_readfirstlane(tid >> 6), half = wave >> 2, wv = wave & 3, th = tid & 255;
    const int cid = pair * 2 + half, bh = cid >> 5, n = cid & 31, b = bh >> 4, h = bh & 15;
    LAS unsigned char* hb = lds + half * CH_LDS;
    LAS bf16* Qb = (LAS bf16*)hb; LAS bf16* Kb = Qb + 64 * XS; LAS bf16* Vb = Kb + 64 * XS; LAS float* Lt = (LAS float*)(Vb + 64 * XS);
    LAS float* GC = Lt + 64 * LS; LAS float* BETA = GC + 64; LAS float* EGC = BETA + 64; LAS float* ETAIL = EGC + 64;
    const size_t rowb = (size_t)b * SEQ;
    bf16* WC = (bf16*)(ws + WS_WC) + (size_t)cid * 8192; float* UB = (float*)(ws + WS_UB) + (size_t)cid * 8192; bf16* QD = (bf16*)(ws + WS_QD) + (size_t)cid * 8192;
    bf16* KTT = (bf16*)(ws + WS_KTT) + (size_t)cid * 8192; bf16* AQK = (bf16*)(ws + WS_AQK) + (size_t)cid * 4096; float* GL = (float*)(ws + WS_GL);
    float egc_l, etail_l;
    {
        const size_t row = rowb + n * CH + lane;
        float al = 0.f, bl = 0.f;
#pragma unroll
        for (int q = 0; q < 4; ++q) { al += AB[(size_t)q * M * 32 + row * 32 + 16 + h]; bl += AB[(size_t)q * M * 32 + row * 32 + h]; }
        const float rs = 1.0f / sqrtf((float)ssq[row] * SSQ_INVK + EPS); al *= rs; bl *= rs;
        const float xx = al + dt_bias[h];
        const float sp = fmaxf(xx, 0.f) + log1pf(expf(-fabsf(xx)));
        float g = -expf(a_log[h]) * sp;
#pragma unroll
        for (int d = 1; d < 64; d <<= 1) { const float t = __shfl_up(g, d); if (lane >= d) g += t; }
        const float glast = __shfl(g, 63);
        egc_l = expf(g); etail_l = expf(glast - g);
        if (wv == 0) { GC[lane] = g; BETA[lane] = 1.0f / (1.0f + expf(-bl)); EGC[lane] = egc_l; ETAIL[lane] = etail_l; if (lane == 63) GL[cid] = expf(glast); }
    }
    {
        const int c0 = (th & 15) * 8, i0 = (th >> 4) * 4;
#pragma unroll
        for (int mat = 0; mat < 3; ++mat) {
            const int wcol = mat * DNW + h * HD + c0;
            f32x4 w[4][2];
#pragma unroll
            for (int j = 0; j < 4; ++j) { w[j][0] = *(const f32x4*)(qkv_w + j * (3 * DNW) + wcol); w[j][1] = *(const f32x4*)(qkv_w + j * (3 * DNW) + wcol + 4); }
            v4u raw[7];
#pragma unroll
            for (int t = 0; t < 7; ++t) { const int st = n * CH + i0 - 3 + t; raw[t] = *(const v4u*)(proj + (rowb + (st >= 0 ? st : 0)) * NPP + OFF_Q + wcol); if (st < 0) raw[t] = (v4u){0u, 0u, 0u, 0u}; }
            LAS bf16* X = (mat == 0) ? Qb : (mat == 1) ? Kb : Vb;
#pragma unroll
            for (int j4 = 0; j4 < 4; ++j4) {
                const int i = i0 + j4;
                f32x4 a0 = {0.f, 0.f, 0.f, 0.f}, a1 = {0.f, 0.f, 0.f, 0.f};
#pragma unroll
                for (int j = 0; j < 4; ++j) { const v4u r = raw[j4 + j];
                    a0.x += w[j][0].x * bfl(r.x); a0.y += w[j][0].y * bfh(r.x); a0.z += w[j][0].z * bfl(r.y); a0.w += w[j][0].w * bfh(r.y);
                    a1.x += w[j][1].x * bfl(r.z); a1.y += w[j][1].y * bfh(r.z); a1.z += w[j][1].z * bfl(r.w); a1.w += w[j][1].w * bfh(r.w); }
#pragma unroll
                for (int e = 0; e < 4; ++e) { a0[e] = a0[e] * sigm(a0[e]); a1[e] = a1[e] * sigm(a1[e]); }
                if (mat < 2) {
                    float ss = (a0.x * a0.x + a0.y * a0.y) + (a0.z * a0.z + a0.w * a0.w) + (a1.x * a1.x + a1.y * a1.y) + (a1.z * a1.z + a1.w * a1.w);
                    ss += __shfl_xor(ss, 1); ss += __shfl_xor(ss, 2); ss += __shfl_xor(ss, 4); ss += __shfl_xor(ss, 8);
                    float sc = 1.0f / sqrtf(ss + EPS); if (mat == 0) sc *= 0.08838834764831845f;
                    a0 = a0 * sc; a1 = a1 * sc;
                }
                v4u o; o.x = pk2(a0.x, a0.y); o.y = pk2(a0.z, a0.w); o.z = pk2(a1.x, a1.y); o.w = pk2(a1.z, a1.w);
                *(LAS v4u*)(X + i * XS + c0) = o;
                if (mat == 0) { const float eg = __shfl(egc_l, i); a0 = a0 * eg; a1 = a1 * eg;
                    v4u q; q.x = pk2(a0.x, a0.y); q.y = pk2(a0.z, a0.w); q.z = pk2(a1.x, a1.y); q.w = pk2(a1.z, a1.w); *(v4u*)(QD + i * 128 + c0) = q; }
            }
        }
    }
    __syncthreads();
    {
        const int r = lane & 15, kq = lane >> 4;
        for (int job = wv; job < 26; job += 4) {
            int prod, it, jt;
            if (job < 10) { prod = 0; it = (job >= 6) ? 3 : (job >= 3) ? 2 : (job >= 1) ? 1 : 0; jt = job - (it * (it + 1)) / 2; }
            else { prod = 1; it = (job - 10) >> 2; jt = (job - 10) & 3; }
            f32x4 acc = {0.f, 0.f, 0.f, 0.f};
            if (jt <= it) {
                const LAS bf16* Ab = (prod ? Qb : Kb) + (16 * it + r) * XS + 8 * kq; const LAS bf16* Bb = Kb + (16 * jt + r) * XS + 8 * kq;
#pragma unroll
                for (int ks = 0; ks < 4; ++ks) acc = __builtin_amdgcn_mfma_f32_16x16x32_bf16(*(const LAS bf16x8*)(Ab + 32 * ks), *(const LAS bf16x8*)(Bb + 32 * ks), acc, 0, 0, 0);
            }
            const int jx = 16 * jt + r; const float gcj = GC[jx];
            f32x4 o;
#pragma unroll
            for (int reg = 0; reg < 4; ++reg) { const int ix = 16 * it + 4 * kq + reg; const float dec = expf(GC[ix] - gcj);
                if (prod == 0) o[reg] = (ix > jx) ? BETA[ix] * acc[reg] * dec : 0.f;
                else o[reg] = (ix >= jx) ? acc[reg] * dec : 0.f; }
            if (prod == 0) *(LAS f32x4*)(Lt + jx * LS + 16 * it + 4 * kq) = o;
            else {
#pragma unroll
                for (int reg = 0; reg < 4; ++reg) AQK[(16 * it + 4 * kq + reg) * 64 + jx] = (bf16)f2bf(o[reg]); }
        }
    }
    __syncthreads();
    constexpr int TS = 68;
    LAS bf16* Tv = Qb; LAS bf16* Tk = Qb + 64 * TS;
    if (wv == half) {
        int zv = 0; asm volatile("" : "+v"(zv));
        const LAS float* LtV = Lt + zv;
        float x[64];
#pragma unroll
        for (int i = 0; i < 64; ++i) x[i] = (i == lane) ? 1.0f : 0.0f;
        f32x4 lr[16];
#define DN_FMAQ(J, Q) { _Pragma("unroll") for (int ii = 4 * (Q); ii < 4 * (Q) + 4; ++ii) { if (ii >= (((J) + 1) >> 2)) { _Pragma("unroll") for (int e = 0; e < 4; ++e) { if (4 * ii + e > (J)) x[4 * ii + e] -= lr[ii][e] * xj; } } } }
#define DN_LDQ(J, Q) { _Pragma("unroll") for (int ii = 4 * (Q); ii < 4 * (Q) + 4; ++ii) { if ((J) < 63 && ii >= (((J) + 1) >> 2)) lr[ii] = *(const LAS f32x4*)(LtV + (J) * LS + 4 * ii); } __builtin_amdgcn_sched_barrier(0); }
#define DN_ROW(J) { const float xj = x[J]; DN_FMAQ(J, 0) DN_LDQ((J) + 1, 0) DN_FMAQ(J, 1) DN_LDQ((J) + 1, 1) DN_FMAQ(J, 2) DN_LDQ((J) + 1, 2) DN_FMAQ(J, 3) DN_LDQ((J) + 1, 3) }
        DN_LDQ(0, 0) DN_LDQ(0, 1) DN_LDQ(0, 2) DN_LDQ(0, 3)
        DN_ROW(0)
        DN_ROW(1)
        DN_ROW(2)
        DN_ROW(3)
        DN_ROW(4)
        DN_ROW(5)
        DN_ROW(6)
        DN_ROW(7)
        DN_ROW(8)
        DN_ROW(9)
        DN_ROW(10)
        DN_ROW(11)
        DN_ROW(12)
        DN_ROW(13)
        DN_ROW(14)
        DN_ROW(15)
        DN_ROW(16)
        DN_ROW(17)
        DN_ROW(18)
        DN_ROW(19)
        DN_ROW(20)
        DN_ROW(21)
        DN_ROW(22)
        DN_ROW(23)
        DN_ROW(24)
        DN_ROW(25)
        DN_ROW(26)
        DN_ROW(27)
        DN_ROW(28)
        DN_ROW(29)
        DN_ROW(30)
        DN_ROW(31)
        DN_ROW(32)
        DN_ROW(33)
        DN_ROW(34)
        DN_ROW(35)
        DN_ROW(36)
        DN_ROW(37)
        DN_ROW(38)
        DN_ROW(39)
        DN_ROW(40)
        DN_ROW(41)
        DN_ROW(42)
        DN_ROW(43)
        DN_ROW(44)
        DN_ROW(45)
        DN_ROW(46)
        DN_ROW(47)
        DN_ROW(48)
        DN_ROW(49)
        DN_ROW(50)
        DN_ROW(51)
        DN_ROW(52)
        DN_ROW(53)
        DN_ROW(54)
        DN_ROW(55)
        DN_ROW(56)
        DN_ROW(57)
        DN_ROW(58)
        DN_ROW(59)
        DN_ROW(60)
        DN_ROW(61)
        DN_ROW(62)
#undef DN_FMAQ
#undef DN_LDQ
#undef DN_ROW
        const float bv = BETA[lane], bk = bv * EGC[lane];
#pragma unroll
        for (int i = 0; i < 64; ++i) { Tv[i * TS + lane] = (bf16)f2bf(x[i] * bv); Tk[i * TS + lane] = (bf16)f2bf(x[i] * bk); }
    } else {
        const int w3 = (wv > half) ? wv - 1 : wv; const float et = etail_l; const int i = lane;
#pragma unroll 4
        for (int d = w3; d < 128; d += 3) KTT[d * 64 + i] = (bf16)f2bf(bf1(Kb[i * XS + d]) * et);
        conv_branch_a(proj, conv_w, convA, pair * 2048 + (half * 3 + w3) * 64 + lane, (pair + 1) * 2048, 384);
    }
    __syncthreads();
    {
        typedef short v4i16_t __attribute__((ext_vector_type(4)));
        const int r = lane & 15, kq = lane >> 4, q4 = r >> 2, p4 = r & 3;
        bf16x8 av[2], ak[2];
#pragma unroll
        for (int ks = 0; ks < 2; ++ks) { const LAS unsigned long long* pv = (const LAS unsigned long long*)(Tv + (16 * wv + r) * TS + 32 * ks + 8 * kq); const LAS unsigned long long* pk = (const LAS unsigned long long*)(Tk + (16 * wv + r) * TS + 32 * ks + 8 * kq);
            const unsigned long long v0 = pv[0], v1 = pv[1], k0 = pk[0], k1 = pk[1];
            v4u wv4; wv4.x = (unsigned)v0; wv4.y = (unsigned)(v0 >> 32); wv4.z = (unsigned)v1; wv4.w = (unsigned)(v1 >> 32); av[ks] = __builtin_bit_cast(bf16x8, wv4);
            v4u wk4; wk4.x = (unsigned)k0; wk4.y = (unsigned)(k0 >> 32); wk4.z = (unsigned)k1; wk4.w = (unsigned)(k1 >> 32); ak[ks] = __builtin_bit_cast(bf16x8, wk4); }
#pragma unroll
        for (int part = 0; part < 2; ++part) {
            const LAS bf16* Bsrc = part ? Kb : Vb;
#pragma unroll
            for (int ct = 0; ct < 8; ++ct) {
                f32x4 acc = {0.f, 0.f, 0.f, 0.f};
#pragma unroll
                for (int ks = 0; ks < 2; ++ks) {
                    const LAS bf16* bp = Bsrc + (32 * ks + 8 * kq + q4) * XS + 16 * ct + 4 * p4;
                    const v4i16_t t0 = __builtin_amdgcn_ds_read_tr16_b64_v4i16((LAS v4i16_t*)bp), t1 = __builtin_amdgcn_ds_read_tr16_b64_v4i16((LAS v4i16_t*)(bp + 4 * XS));
                    bf16x8 bfrag; bfrag[0] = t0[0]; bfrag[1] = t0[1]; bfrag[2] = t0[2]; bfrag[3] = t0[3]; bfrag[4] = t1[0]; bfrag[5] = t1[1]; bfrag[6] = t1[2]; bfrag[7] = t1[3];
                    acc = __builtin_amdgcn_mfma_f32_16x16x32_bf16(bfrag, part ? ak[ks] : av[ks], acc, 0, 0, 0);
                }
                const int o = (16 * wv + r) * 128 + 16 * ct + 4 * kq;
                if (part == 0) *(f32x4*)(UB + o) = acc;
                else *(unsigned long long*)(WC + o) = (unsigned long long)pk2(-acc.x, -acc.y) | ((unsigned long long)pk2(-acc.z, -acc.w) << 32);
            }
        }
    }
    __syncthreads();
}

constexpr int SSB = 136, USB = 72;
#define LDS_BARRIER() do { asm volatile("s_waitcnt lgkmcnt(0)" ::: "memory"); __builtin_amdgcn_s_barrier(); asm volatile("" ::: "memory"); } while (0)
__device__ __forceinline__ unsigned long long pk4(const f32x4 v) { return (unsigned long long)pk2(v.x, v.y) | ((unsigned long long)pk2(v.z, v.w) << 32); }
struct ScanOps { bf16x8 wcf[4], qdf[4], aqf[2], ktf[2]; f32x4 ubv; };
struct SideJob { const float* Wg; const float* Wu; const float* Wd; bf16* Tgu; bf16* Td; const float* gain; LAS float* scr; int q0; };
__device__ __forceinline__ void side_item(const SideJob& J, int q, const float*& W, int& N, bf16*& WT, int& ldk, const float*& gain, TwItem& t) {
    constexpr int IG = (D / 64) * (FF / 32);
    if (q < IG) { W = J.Wg; N = FF; WT = J.Tgu; ldk = D; gain = J.gain; t = tw_item(q, FF / 32, 1, 0); }
    else if (q < 2 * IG) { W = J.Wu; N = FF; WT = J.Tgu; ldk = D; gain = J.gain; t = tw_item(q - IG, FF / 32, 2, 0); }
    else { W = J.Wd; N = D; WT = J.Td; ldk = FF; gain = nullptr; t = tw_item(q - 2 * IG, D / 32, 0, 0); }
}
constexpr int SIDE_SCAN_STEPS = 24, SIDE_ITEMS = 2048 * SIDE_SCAN_STEPS;
__device__ __forceinline__ void side_convert_range(const SideJob& J, int q_begin, int q_end, int gw2, int NGW2, int lane) {
    int q = q_begin + gw2; if (q >= q_end) return;
    float ra[32], rb[32]; const float* W; int N; bf16* WT; int ldk; const float* gain; TwItem ta, tb;
    side_item(J, q, W, N, WT, ldk, gain, ta); tw_load(ra, W, N, ta, lane);
    for (;;) {
        bool hn = q + NGW2 < q_end;
        if (hn) { side_item(J, q + NGW2, W, N, WT, ldk, gain, tb); tw_load(rb, W, N, tb, lane); }
        side_item(J, q, W, N, WT, ldk, gain, ta); tw_store(ra, WT, ldk, gain, ta, J.scr, lane);
        if (!hn) break;
        q += NGW2; hn = q + NGW2 < q_end;
        if (hn) { side_item(J, q + NGW2, W, N, WT, ldk, gain, ta); tw_load(ra, W, N, ta, lane); }
        side_item(J, q, W, N, WT, ldk, gain, tb); tw_store(rb, WT, ldk, gain, tb, J.scr, lane);
        if (!hn) break;
        q += NGW2;
    }
}
struct ScanPtrs { const bf16* WCb; const bf16* QDb; const bf16* KTb; const bf16* AQb; const float* UBb; const float* GLb; int offW, offA, offK, offU; };
__device__ __forceinline__ void scan_load_a(ScanOps& o, const ScanPtrs& p, int n) {
#pragma unroll
    for (int ks = 0; ks < 4; ++ks) { o.wcf[ks] = *(const bf16x8*)(p.WCb + (size_t)n * 8192 + p.offW + 32 * ks); o.qdf[ks] = *(const bf16x8*)(p.QDb + (size_t)n * 8192 + p.offW + 32 * ks); }
#pragma unroll
    for (int reg = 0; reg < 4; ++reg) o.ubv[reg] = p.UBb[(size_t)n * 8192 + p.offU + reg * 128];
}
__device__ __forceinline__ void scan_load_b(ScanOps& o, const ScanPtrs& p, int n) {
#pragma unroll
    for (int ks = 0; ks < 2; ++ks) { o.aqf[ks] = *(const bf16x8*)(p.AQb + (size_t)n * 4096 + p.offA + 32 * ks); o.ktf[ks] = *(const bf16x8*)(p.KTb + (size_t)n * 8192 + p.offK + 32 * ks); }
}
__device__ __forceinline__ void scan_step(const ScanOps& cur, ScanOps& nxt, const ScanPtrs& p, LAS bf16* St, LAS bf16* Ut, f32x4& s0, f32x4& s1, float* orow, float gl, int nn, int r, int kq, int rt, int ct, int wave,
                                          const SideJob& J, const float (&sc_cur)[32], float (&sc_nxt)[32], int qcur, int qnxt, int lane) {
    f32x4 accU = cur.ubv, accO = {0.f, 0.f, 0.f, 0.f};
    const LAS bf16* srow = St + (16 * ct + r) * SSB + 8 * kq;
#pragma unroll
    for (int ks = 0; ks < 4; ++ks) { const bf16x8 sf = *(const LAS bf16x8*)(srow + 32 * ks);
        accU = __builtin_amdgcn_mfma_f32_16x16x32_bf16(cur.wcf[ks], sf, accU, 0, 0, 0); accO = __builtin_amdgcn_mfma_f32_16x16x32_bf16(cur.qdf[ks], sf, accO, 0, 0, 0); }
    *(LAS unsigned long long*)(Ut + (16 * ct + r) * USB + 16 * rt + 4 * kq) = pk4(accU);
    scan_load_a(nxt, p, nn);
    { const float* W; int N; bf16* WT; int ldk; const float* gain; TwItem t; if (qnxt >= 0) { side_item(J, qnxt, W, N, WT, ldk, gain, t); tw_load(sc_nxt, W, N, t, lane); } }
    LDS_BARRIER();
    const LAS bf16* urow = Ut + (16 * ct + r) * USB + 8 * kq;
#pragma unroll
    for (int ks = 0; ks < 2; ++ks) { const bf16x8 uf = *(const LAS bf16x8*)(urow + 32 * ks); accO = __builtin_amdgcn_mfma_f32_16x16x32_bf16(cur.aqf[ks], uf, accO, 0, 0, 0); }
#pragma unroll
    for (int reg = 0; reg < 4; ++reg) orow[(size_t)reg * DNW] = accO[reg];
    s0 = s0 * gl; s1 = s1 * gl;
    const LAS bf16* u0 = Ut + r * USB + 8 * kq; const LAS bf16* u1 = Ut + (16 + r) * USB + 8 * kq;
#pragma unroll
    for (int ks = 0; ks < 2; ++ks) { const bf16x8 a8 = *(const LAS bf16x8*)(u0 + 32 * ks), b8 = *(const LAS bf16x8*)(u1 + 32 * ks);
        s0 = __builtin_amdgcn_mfma_f32_16x16x32_bf16(cur.ktf[ks], a8, s0, 0, 0, 0); s1 = __builtin_amdgcn_mfma_f32_16x16x32_bf16(cur.ktf[ks], b8, s1, 0, 0, 0); }
    scan_load_b(nxt, p, nn);
    { const float* W; int N; bf16* WT; int ldk; const float* gain; TwItem t; if (qcur >= 0) { side_item(J, qcur, W, N, WT, ldk, gain, t); tw_store(sc_cur, WT, ldk, gain, t, J.scr, lane); } }
    *(LAS unsigned long long*)(St + r * SSB + 16 * wave + 4 * kq) = pk4(s0); *(LAS unsigned long long*)(St + (16 + r) * SSB + 16 * wave + 4 * kq) = pk4(s1);
    LDS_BARRIER();
}
__device__ __forceinline__ void dn_scan_unit(unsigned char* ws, LAS unsigned char* lds, float* O, int unit, int tid, SideJob J) {
    const int lane = tid & 63, wave = __builtin_amdgcn_readfirstlane(tid >> 6), r = lane & 15, kq = lane >> 4;
    const int bh = unit >> 2, vs = unit & 3, b = bh >> 4, h = bh & 15;
    const int rt = wave >> 1, ct = wave & 1;
    LAS bf16* St = (LAS bf16*)lds; LAS bf16* Ut = St + 32 * SSB;
    { int tz = tid; asm volatile("" : "+v"(tz));
      for (int i = tz; i < 32 * SSB / 2; i += NTHREADS) ((LAS unsigned*)St)[i] = 0u; }
    f32x4 s0 = {0.f, 0.f, 0.f, 0.f}, s1 = {0.f, 0.f, 0.f, 0.f};
    ScanPtrs p;
    p.offW = (16 * rt + r) * 128 + 8 * kq; p.offA = (16 * rt + r) * 64 + 8 * kq; p.offK = (16 * wave + r) * 64 + 8 * kq; p.offU = (16 * rt + 4 * kq) * 128 + vs * 32 + 16 * ct + r;
    p.WCb = (const bf16*)(ws + WS_WC) + (size_t)bh * NCH * 8192; p.UBb = (const float*)(ws + WS_UB) + (size_t)bh * NCH * 8192; p.QDb = (const bf16*)(ws + WS_QD) + (size_t)bh * NCH * 8192;
    p.KTb = (const bf16*)(ws + WS_KTT) + (size_t)bh * NCH * 8192; p.AQb = (const bf16*)(ws + WS_AQK) + (size_t)bh * NCH * 4096; p.GLb = (const float*)(ws + WS_GL) + (size_t)bh * NCH;
    ScanOps A, B;
    scan_load_a(A, p, 0); scan_load_b(A, p, 0);
    float scA[32], scB[32];
    J.scr = (LAS float*)(lds + 16384 + wave * 8704);
    { const float* W; int N; bf16* WT; int ldk; const float* gain; TwItem t; side_item(J, J.q0, W, N, WT, ldk, gain, t); tw_load(scA, W, N, t, lane); }
    const int glall = __float_as_int(p.GLb[lane & 31]);
    LDS_BARRIER();
    float* orow = O + ((size_t)b * SEQ + 16 * rt + 4 * kq) * DNW + h * HD + vs * 32 + 16 * ct + r;
#pragma unroll
    for (int n = 0; n < NCH; n += 2) {
        scan_step(A, B, p, St, Ut, s0, s1, orow + (size_t)n * CH * DNW, __int_as_float(__builtin_amdgcn_readlane(glall, n)), n + 1, r, kq, rt, ct, wave, J, scA, scB, (n < SIDE_SCAN_STEPS) ? J.q0 + n : -1, (n + 1 < SIDE_SCAN_STEPS) ? J.q0 + n + 1 : -1, lane);
        scan_step(B, A, p, St, Ut, s0, s1, orow + (size_t)(n + 1) * CH * DNW, __int_as_float(__builtin_amdgcn_readlane(glall, n + 1)), (n + 2 < NCH) ? n + 2 : n + 1, r, kq, rt, ct, wave, J, scB, scA, (n + 1 < SIDE_SCAN_STEPS) ? J.q0 + n + 1 : -1, (n + 2 < SIDE_SCAN_STEPS) ? J.q0 + n + 2 : -1, lane);
    }
    __syncthreads();
}

__device__ __forceinline__ void ab_logits(const bf16* XN, const bf16* Wab, float* ABP, int job, int lane) {
    const int r = lane & 15, kq = lane >> 4, tile = job >> 2, q = job & 3;
    const bf16* ap = XN + (size_t)(16 * tile + r) * D + q * (D / 4) + 8 * kq; const bf16* b0p = Wab + (size_t)r * D + q * (D / 4) + 8 * kq; const bf16* b1p = b0p + (size_t)16 * D;
    f32x4 acc0 = {0.f, 0.f, 0.f, 0.f}, acc1 = {0.f, 0.f, 0.f, 0.f};
#pragma unroll 16
    for (int ks = 0; ks < D / 128; ++ks) { const bf16x8 a = *(const bf16x8*)(ap + 32 * ks), b0 = *(const bf16x8*)(b0p + 32 * ks), b1 = *(const bf16x8*)(b1p + 32 * ks);
        acc0 = __builtin_amdgcn_mfma_f32_16x16x32_bf16(a, b0, acc0, 0, 0, 0); acc1 = __builtin_amdgcn_mfma_f32_16x16x32_bf16(a, b1, acc1, 0, 0, 0); }
    float* o = ABP + (size_t)q * M * 32 + (size_t)(16 * tile + 4 * kq) * 32 + r;
#pragma unroll
    for (int reg = 0; reg < 4; ++reg) { o[reg * 32] = acc0[reg]; o[reg * 32 + 16] = acc1[reg]; }
}

__device__ __forceinline__ void dn_gated_norm(const float* O, const bf16* proj, const float* wn, bf16* ON, int gtid, int NT) {
    for (int idx = gtid; idx < M * NH * 16; idx += NT) {
        const int pair = idx >> 4, sub = idx & 15, row = pair >> 4, h = pair & 15, c = h * HD + sub * 8;
        const f32x4 o0 = *(const f32x4*)(O + (size_t)row * DNW + c), o1 = *(const f32x4*)(O + (size_t)row * DNW + c + 4);
        float ss = (o0.x * o0.x + o0.y * o0.y) + (o0.z * o0.z + o0.w * o0.w) + (o1.x * o1.x + o1.y * o1.y) + (o1.z * o1.z + o1.w * o1.w);
        ss += __shfl_xor(ss, 1); ss += __shfl_xor(ss, 2); ss += __shfl_xor(ss, 4); ss += __shfl_xor(ss, 8);
        const float rstd = 1.0f / sqrtf(ss * (1.0f / HD) + EPS);
        const v4u z = *(const v4u*)(proj + (size_t)row * NPP + OFF_Z + c);
        const f32x4 w0 = *(const f32x4*)(wn + sub * 8), w1 = *(const f32x4*)(wn + sub * 8 + 4);
        const float z0 = bfl(z.x), z1 = bfh(z.x), z2 = bfl(z.y), z3 = bfh(z.y), z4 = bfl(z.z), z5 = bfh(z.z), z6 = bfl(z.w), z7 = bfh(z.w);
        v4u o; o.x = pk2(o0.x * rstd * w0.x * (z0 * sigm(z0)), o0.y * rstd * w0.y * (z1 * sigm(z1))); o.y = pk2(o0.z * rstd * w0.z * (z2 * sigm(z2)), o0.w * rstd * w0.w * (z3 * sigm(z3)));
        o.z = pk2(o1.x * rstd * w1.x * (z4 * sigm(z4)), o1.y * rstd * w1.y * (z5 * sigm(z5))); o.w = pk2(o1.z * rstd * w1.z * (z6 * sigm(z6)), o1.w * rstd * w1.w * (z7 * sigm(z7)));
        *(v4u*)(ON + (size_t)row * DNW + c) = o;
    }
}

__device__ __forceinline__ void xattn_unit(const float* QP, const unsigned long long* ssq, const bf16* KB, const bf16* VT, bf16* XO, LAS unsigned char* lds, int unit, int tid) {
    const int lane = tid & 63, wave = __builtin_amdgcn_readfirstlane(tid >> 6), r = lane & 15, kq = lane >> 4;
    const int b = unit >> 6, hd = (unit >> 4) & 3, qt = unit & 15;
    LAS unsigned char* Ksm = lds; LAS unsigned char* Vtm = lds + 256 * 272;
    {
        const int seg = tid & 15, rr = tid >> 4;
#pragma unroll
        for (int p = 0; p < 8; ++p) { const int key = rr + 32 * p; const v4u v = *(const v4u*)(KB + (size_t)(b * MEMT + key) * XW + hd * HD + seg * 8); *(LAS v4u*)(Ksm + key * 272 + seg * 16) = v; }
        const int seg2 = tid & 31, r2 = tid >> 5;
#pragma unroll
        for (int p = 0; p < 8; ++p) { const int d = r2 + 16 * p; const v4u v = *(const v4u*)(VT + ((size_t)(b * 4 + hd) * HD + d) * MEMT + seg2 * 8); *(LAS v4u*)(Vtm + d * 528 + seg2 * 16) = v; }
    }
    const size_t qrow = (size_t)b * SEQ + qt * 128 + wave * 16 + r;
    bf16x8 qf[4];
    const float qs = 0.08838834764831845f * 1.4426950408889634f / sqrtf((float)ssq[qrow] * SSQ_INVK + EPS);
#pragma unroll
    for (int ks = 0; ks < 4; ++ks) { const float* qp = QP + qrow * XW + hd * HD + 32 * ks + 8 * kq; f32x4 a = {0.f, 0.f, 0.f, 0.f}, c = {0.f, 0.f, 0.f, 0.f};
#pragma unroll
        for (int g = 0; g < 4; ++g) { a += *(const f32x4*)(qp + (size_t)g * M * XW); c += *(const f32x4*)(qp + (size_t)g * M * XW + 4); }
        a = a * qs; c = c * qs;
        v4u w; w.x = pk2(a.x, a.y); w.y = pk2(a.z, a.w); w.z = pk2(c.x, c.y); w.w = pk2(c.z, c.w); qf[ks] = __builtin_bit_cast(bf16x8, w); }
    __syncthreads();
    f32x4 sc[16];
#pragma unroll
    for (int t = 0; t < 16; ++t) { sc[t] = (f32x4){0.f, 0.f, 0.f, 0.f};
#pragma unroll
        for (int ks = 0; ks < 4; ++ks) { const bf16x8 kf = *(const LAS bf16x8*)(Ksm + (16 * t + r) * 272 + (32 * ks + 8 * kq) * 2);
            sc[t] = __builtin_amdgcn_mfma_f32_16x16x32_bf16(kf, qf[ks], sc[t], 0, 0, 0); } }
    float mx = -3.0e38f;
#pragma unroll
    for (int t = 0; t < 16; ++t) mx = fmaxf(mx, fmaxf(fmaxf(sc[t].x, sc[t].y), fmaxf(sc[t].z, sc[t].w)));
    mx = fmaxf(mx, __shfl_xor(mx, 16)); mx = fmaxf(mx, __shfl_xor(mx, 32));
    float sum = 0.f;
#pragma unroll
    for (int t = 0; t < 16; ++t) {
#pragma unroll
        for (int e = 0; e < 4; ++e) { sc[t][e] = __builtin_amdgcn_exp2f(sc[t][e] - mx); sum += sc[t][e]; } }
    sum += __shfl_xor(sum, 16); sum += __shfl_xor(sum, 32);
    const float inv = 1.0f / sum;
    bf16x8 pf[8];
#pragma unroll
    for (int s = 0; s < 8; ++s) { v4u w; w.x = pk2(sc[2 * s].x, sc[2 * s].y); w.y = pk2(sc[2 * s].z, sc[2 * s].w); w.z = pk2(sc[2 * s + 1].x, sc[2 * s + 1].y); w.w = pk2(sc[2 * s + 1].z, sc[2 * s + 1].w);
        pf[s] = __builtin_bit_cast(bf16x8, w); }
#pragma unroll
    for (int dt = 0; dt < 8; ++dt) { f32x4 o = {0.f, 0.f, 0.f, 0.f};
#pragma unroll
        for (int s = 0; s < 8; ++s) { const LAS unsigned char* vp = Vtm + (16 * dt + r) * 528 + (32 * s + 4 * kq) * 2;
            const unsigned long long lo = *(const LAS unsigned long long*)vp, hi = *(const LAS unsigned long long*)(vp + 32);
            v4u w; w.x = (unsigned)lo; w.y = (unsigned)(lo >> 32); w.z = (unsigned)hi; w.w = (unsigned)(hi >> 32);
            o = __builtin_amdgcn_mfma_f32_16x16x32_bf16(__builtin_bit_cast(bf16x8, w), pf[s], o, 0, 0, 0); }
        o = o * inv;
        *(unsigned long long*)(XO + qrow * XW + hd * HD + 16 * dt + 4 * kq) = (unsigned long long)pk2(o.x, o.y) | ((unsigned long long)pk2(o.z, o.w) << 32); }
    __syncthreads();
}

struct Args { const float* in[27]; float* out; unsigned char* ws; int ph_lo, ph_hi; };
enum { I_X = 0, I_MEM, I_F1N, I_F1G, I_F1U, I_F1D, I_MIXN, I_WIN, I_CONVW, I_QKVW, I_ALOG, I_DTB, I_DNN, I_WOC, I_WOD, I_WO, I_XAN, I_MEMN, I_XWQ, I_XWK, I_XWV, I_XWO, I_F2N, I_F2G, I_F2U, I_F2D, I_FINN };

typedef const __attribute__((address_space(4))) Args* KArgs;
__device__ __forceinline__ KArgs kargs() { KArgs p = (KArgs)__builtin_amdgcn_kernarg_segment_ptr(); asm volatile("" : "+s"(p)); return p; }
#define PH_BEGIN KArgs A = kargs(); unsigned char* const ws = A->ws; (void)ws;
#define W1GU ((bf16*)(ws + WS_W1GU))
#define W1D ((bf16*)(ws + WS_W1D))
#define W2GU ((bf16*)(ws + WS_W2GU))
#define W2D ((bf16*)(ws + WS_W2D))
#define WIN ((bf16*)(ws + WS_WIN))
#define WA ((bf16*)(ws + WS_WA))
#define WB ((bf16*)(ws + WS_WB))
#define WO ((bf16*)(ws + WS_WO))
#define WQ ((bf16*)(ws + WS_WQ))
#define WKV ((bf16*)(ws + WS_WKV))
#define WXO ((bf16*)(ws + WS_WXO))
#define XN ((bf16*)(ws + WS_XN))
#define ACT ((bf16*)(ws + WS_R))
#define PROJ ((bf16*)(ws + WS_R))
#define MN ((bf16*)(ws + WS_MN))
#define KB ((bf16*)(ws + WS_KB))
#define VT ((bf16*)(ws + WS_VT))
#define OB ((float*)(ws + WS_O))
#define CONVA ((bf16*)(ws + WS_CONVA))
#define ON ((bf16*)(ws + WS_ON))
#define QP ((float*)(ws + WS_QP))
#define AB ((float*)(ws + WS_AB))
#define HB ((bf16*)(ws + WS_XNB))
#define SSQ(i) ((unsigned long long*)(ws + WS_SSQ) + (i) * M)
#define XO ((bf16*)(ws + WS_XO))
#define H (A->out)
#define INP(i) (A->in[i])
__global__ void __launch_bounds__(NTHREADS, 2) fwd_kernel(Args args) {
    extern __shared__ __attribute__((aligned(16))) unsigned char lds_raw[];
    LAS unsigned char* lds = (LAS unsigned char*)lds_raw;
    volatile LAS unsigned* MISC = (volatile LAS unsigned*)(lds + MISC_OFF);
    const int tid = threadIdx.x, lane = tid & 63, wave = __builtin_amdgcn_readfirstlane(tid >> 6);
    const int G = gridDim.x, bx = blockIdx.x;
    const int vcu = (G % 8 == 0) ? (bx % 8) * (G / 8) + bx / 8 : bx;
    const int gw = vcu * NWAVES + wave, NGW = G * NWAVES, gtid = vcu * NTHREADS + tid, NT = G * NTHREADS;
    gu32* ctl = (gu32*)(args.ws + WS_CTL);
    for (int u = tid; u < (LDS_BYTES - MISC_OFF) / 4; u += NTHREADS) ((LAS unsigned*)(lds + MISC_OFF))[u] = 0u;
    __syncthreads();
    XcdBarrier bar; bar.bar = (unsigned*)(ctl + CW_BAR); bar.x = 0; bar.st = nullptr;
    const int lo = args.ph_lo, hi = args.ph_hi;
    if (hi - lo > 1) bar = xcd_barrier_post((unsigned*)(ctl + CW_BAR), MISC + 8);
#define IN(k) (lo <= (k) && (k) < hi)
#define SEAM(k) do { if (IN(k) && IN((k) + 1)) xcd_barrier(bar); } while (0)
    if (IN(0)) for (int rep_ = 0; rep_ < (PROBE_PHASE == 0 ? PROBE_REPS : 1); ++rep_) { PH_BEGIN
        LAS float* scr = (LAS float*)(lds + wave * 16384);
        transpose_weight(INP(I_F1D), FF, D, W1D, FF, 0, 0, nullptr, scr, gw, NGW, lane);
        transpose_weight(INP(I_WIN), D, NPROJ, WIN, D, 3, 0, INP(I_MIXN), scr, gw, NGW, lane);
        transpose_weight(INP(I_XWQ), D, XW, WQ, D, 0, 0, INP(I_XAN), scr, gw, NGW, lane);
        transpose_weight(INP(I_XWK), D, XW, WKV, D, 0, 0, nullptr, scr, gw, NGW, lane);
        transpose_weight(INP(I_XWV), D, XW, WKV, D, 0, XW, nullptr, scr, gw, NGW, lane);
        transpose_weight(INP(I_XWO), XW, D, WXO, XW, 0, 0, nullptr, scr, gw, NGW, lane);
        transpose_weight(INP(I_F1G), D, FF, W1GU, D, 1, 0, nullptr, scr, gw, NGW, lane);
        transpose_weight(INP(I_F1U), D, FF, W1GU, D, 2, 0, nullptr, scr, gw, NGW, lane);
        rms_rows<false>(INP(I_X), INP(I_F1N), XN, M, gw, NGW, lane);
        rms_rows<false>(INP(I_MEM), INP(I_MEMN), MN, BATCH * MEMT, gw, NGW, lane);
    }
    SEAM(0);
    if (IN(1)) for (int rep_ = 0; rep_ < (PROBE_PHASE == 1 ? PROBE_REPS : 1); ++rep_) { PH_BEGIN
        pg8::Gemm g{XN, W1GU, M, 2 * FF, D, D, D}; pg8::OrderFfnKv S; S.init(M, 2 * FF, G, bx); S.A1 = MN; S.B1 = WKV;
        pg8::EpiSwiGLUKV E{{ACT, FF, nullptr, 0.f, 0.f}, {KB, VT}};
        pg8::gemm_phase<pg8::EpiSwiGLUKV, pg8::OrderFfnKv, true, true>(lds, g, S, E);
        const int rounds = (S.nwg + 16 + G - 1) / G, first_idle = S.nwg + 16 - (rounds - 1) * G;
        if (first_idle < G) { if (bx >= first_idle) { const int gw2 = (bx - first_idle) * NWAVES + wave, NGW2 = (G - first_idle) * NWAVES; LAS float* scr = (LAS float*)(lds + wave * 16384);
            transpose_weight(INP(I_WOC), CW, D, WA, CW, 0, 0, nullptr, scr, gw2, NGW2, lane);
            transpose_weight(INP(I_WOD), DNW, D, WB, DNW, 0, 0, nullptr, scr, gw2, NGW2, lane);
            transpose_weight(INP(I_WO), D, D, WO, D, 0, 0, nullptr, scr, gw2, NGW2, lane); } }
        else { LAS float* scr = (LAS float*)(lds + wave * 16384);
            transpose_weight(INP(I_WOC), CW, D, WA, CW, 0, 0, nullptr, scr, gw, NGW, lane);
            transpose_weight(INP(I_WOD), DNW, D, WB, DNW, 0, 0, nullptr, scr, gw, NGW, lane);
            transpose_weight(INP(I_WO), D, D, WO, D, 0, 0, nullptr, scr, gw, NGW, lane); }
    }
    SEAM(1);
    if (IN(2)) { PH_BEGIN
        pg8::Gemm g{ACT, W1D, M, D, FF, FF, FF}; pg8::StaticOrder S; S.init(M, D, G, bx);
        pg8::EpiResidBf<true> E{INP(I_X), HB, D, 0.5f, SSQ(0)};
        pg8::gemm_phase<pg8::EpiResidBf<true>, pg8::StaticOrder, true, true>(lds, g, S, E);
    }
    SEAM(2);
    if (IN(3)) for (int rep_ = 0; rep_ < (PROBE_PHASE == 3 ? PROBE_REPS : 1); ++rep_) { PH_BEGIN
        pg8::Gemm g{HB, WIN, M, NPP, D, D, D}; pg8::StaticOrder S; S.init(M, NPP, G, bx);
        pg8::EpiStoreBf16 E{PROJ, NPP, SSQ(0), SSQ_INVK, EPS};
        pg8::gemm_phase<pg8::EpiStoreBf16, pg8::StaticOrder, true, true>(lds, g, S, E);
        for (int job = gw; job < (M / 16) * 4; job += NGW) ab_logits(HB, WIN + (size_t)NPP * D, AB, job, lane);
    }
    SEAM(3);
    if (IN(4)) for (int rep_ = 0; rep_ < (PROBE_PHASE == 4 ? PROBE_REPS : 1); ++rep_) { PH_BEGIN
        for (int pair = vcu; pair < BATCH * NH * NCH / 2; pair += G) dn_chunk_pair(PROJ, AB, SSQ(0), INP(I_QKVW), INP(I_ALOG), INP(I_DTB), ws, lds, pair, tid, INP(I_CONVW), CONVA);
    }
    SEAM(4);
    if (IN(5)) for (int rep_ = 0; rep_ < (PROBE_PHASE == 5 ? PROBE_REPS : 1); ++rep_) { PH_BEGIN for (int unit = vcu; unit < BATCH * NH * 4; unit += G) { SideJob J{INP(I_F2G), INP(I_F2U), INP(I_F2D), W2GU, W2D, INP(I_F2N), nullptr, (unit * NWAVES + wave) * SIDE_SCAN_STEPS}; dn_scan_unit(ws, lds, OB, unit, tid, J); } }
    SEAM(5);
    if (IN(6)) for (int rep_ = 0; rep_ < (PROBE_PHASE == 6 ? PROBE_REPS : 1); ++rep_) { PH_BEGIN dn_gated_norm(OB, PROJ, INP(I_DNN), ON, gtid, NT); }
    SEAM(6);
    if (IN(7)) for (int rep_ = 0; rep_ < (PROBE_PHASE == 7 ? PROBE_REPS : 1); ++rep_) { PH_BEGIN
        pg8::Gemm g{CONVA, WA, M, D, CW, CW, CW}; pg8::OrderTwoPass S; S.init(M, D, G, bx); S.A1 = ON; S.B1 = WB;
        pg8::EpiGateFused E{XN, D, PROJ + OFF_GA, PROJ + OFF_GB, NPP};
        pg8::gemm_phase<pg8::EpiGateFused, pg8::OrderTwoPass, true, true>(lds, g, S, E);
    }
    SEAM(7);
    if (IN(8)) { PH_BEGIN
        pg8::Gemm g{XN, WO, M, D, D, D, D}; pg8::StaticOrder S; S.init(M, D, G, bx);
        pg8::EpiResidBf<false> E{HB, HB, D, 1.0f, SSQ(1)};
        pg8::gemm_phase<pg8::EpiResidBf<false>, pg8::StaticOrder, true, true>(lds, g, S, E);
    }
    SEAM(8);
    if (IN(9)) for (int rep_ = 0; rep_ < (PROBE_PHASE == 9 ? PROBE_REPS : 1); ++rep_) { PH_BEGIN
        pg8::Gemm g{HB, WQ, M, XW, D / 4, D, D}; pg8::OrderSplitK4 S{G, bx, (D / 4) * 2};
        pg8::EpiPartF32 E{QP, XW, (size_t)M * XW};
        pg8::gemm_phase<pg8::EpiPartF32, pg8::OrderSplitK4, true, true>(lds, g, S, E);
    }
    SEAM(9);
    if (IN(10)) for (int rep_ = 0; rep_ < (PROBE_PHASE == 10 ? PROBE_REPS : 1); ++rep_) { PH_BEGIN for (int unit = vcu; unit < BATCH * 4 * (SEQ / 128); unit += G) xattn_unit(QP, SSQ(1), KB, VT, XO, lds, unit, tid); }
    SEAM(10);
    if (IN(11)) { PH_BEGIN
        pg8::Gemm g{XO, WXO, M, D, XW, XW, XW}; pg8::StaticOrder S; S.init(M, D, G, bx);
        pg8::EpiResidBf<false> E{HB, HB, D, 1.0f, SSQ(2)};
        pg8::gemm_phase<pg8::EpiResidBf<false>, pg8::StaticOrder, true, true>(lds, g, S, E);
    }
    SEAM(11);
    if (IN(12)) for (int rep_ = 0; rep_ < (PROBE_PHASE == 12 ? PROBE_REPS : 1); ++rep_) { PH_BEGIN
        const int NCONV = (G == 256) ? 5 : 0, GG = G - NCONV;
        if (bx < GG) {
            pg8::Gemm g{HB, W2GU, M, 2 * FF, D, D, D}; pg8::StaticOrder S; S.init(M, 2 * FF, GG, bx);
            pg8::EpiSwiGLUrs E{ACT, FF, SSQ(2), SSQ_INVK, EPS};
            pg8::gemm_phase<pg8::EpiSwiGLUrs, pg8::StaticOrder, true, true>(lds, g, S, E);
        }
        if (bx >= GG || NCONV == 0) {
            SideJob J{INP(I_F2G), INP(I_F2U), INP(I_F2D), W2GU, W2D, INP(I_F2N), (LAS float*)(lds + wave * 16384), 0};
            side_convert_range(J, SIDE_ITEMS, 3 * (D / 64) * (FF / 32), NCONV ? (bx - GG) * NWAVES + wave : gw, NCONV ? NCONV * NWAVES : NGW, lane);
        }
    }
    SEAM(12);
    if (IN(13)) { PH_BEGIN
        pg8::Gemm g{ACT, W2D, M, D, FF, FF, FF}; pg8::StaticOrder S; S.init(M, D, G, bx);
        pg8::EpiResidBf<false> E{HB, HB, D, 0.5f, SSQ(3)};
        pg8::gemm_phase<pg8::EpiResidBf<false>, pg8::StaticOrder, true, true>(lds, g, S, E);
    }
    SEAM(13);
    if (IN(14)) { PH_BEGIN final_norm(HB, SSQ(3), INP(I_FINN), H, gw, NGW, lane); }
#undef IN
#undef SEAM
}

extern "C" void kernel_launch(void* const* d_in, const int* in_sizes, int n_in, void* d_out, int out_size, void* d_ws, size_t ws_size, hipStream_t stream) {
    static int grid = 0;
    if (grid == 0) {
        if (n_in != 27 || out_size != M * D || ws_size < WS_END) { fprintf(stderr, "kernel_launch: unexpected problem (n_in %d, out %d, ws %zu < %zu)\n", n_in, out_size, ws_size, (size_t)WS_END); grid = -1; return; }
        int dev = 0, cus = 0, per_cu = 0;
        if (hipGetDevice(&dev) != hipSuccess || hipDeviceGetAttribute(&cus, hipDeviceAttributeMultiprocessorCount, dev) != hipSuccess) { grid = -1; return; }
        if (hipFuncSetAttribute((const void*)fwd_kernel, hipFuncAttributeMaxDynamicSharedMemorySize, LDS_BYTES) != hipSuccess) { fprintf(stderr, "kernel_launch: hipFuncSetAttribute failed\n"); grid = -1; return; }
        if (hipOccupancyMaxActiveBlocksPerMultiprocessor(&per_cu, (const void*)fwd_kernel, NTHREADS, LDS_BYTES) != hipSuccess || per_cu < 1) { fprintf(stderr, "kernel_launch: occupancy query reports %d blocks per CU\n", per_cu); (void)hipGetLastError(); grid = -1; return; }
        grid = cus;
    }
    if (grid < 0) return;
    (void)hipMemsetAsync((char*)d_ws + WS_CTL, 0, CTL_ZERO_BYTES, stream);
    Args a{};
    for (int i = 0; i < 27; ++i) a.in[i] = (const float*)d_in[i];
    a.out = (float*)d_out; a.ws = (unsigned char*)d_ws;
#if MK_N_LAUNCHES == 1
    a.ph_lo = 0; a.ph_hi = NPH;
    hipLaunchKernelGGL(fwd_kernel, dim3(grid), dim3(NTHREADS), LDS_BYTES, stream, a);
#else
    for (int p = 0; p < NPH; ++p) { a.ph_lo = p; a.ph_hi = p + 1; hipLaunchKernelGGL(fwd_kernel, dim3(grid), dim3(NTHREADS), LDS_BYTES, stream, a); }
#endif
}
```

```cpp
#include <hip/hip_runtime.h>
#include <cstdio>
#include <cstdint>
#ifndef MK_N_LAUNCHES
#define MK_N_LAUNCHES 1
#endif
namespace pg8 {
#define PG8_LAS __attribute__((address_space(3)))
typedef unsigned short bf16_t;
typedef short bf16x8 __attribute__((ext_vector_type(8)));
typedef float f32x4 __attribute__((ext_vector_type(4)));
typedef unsigned u32x4 __attribute__((ext_vector_type(4)));
constexpr int BM = 256, BK = 64, HALF = 128, HTB = HALF * BK * 2  , STAGE_BYTES = 8 * HTB, NXCD = 8, WGM = 8;

__host__ __device__ __forceinline__ int lds_byte(int r, int c) { const int st = (r >> 4) * 2 + (c >> 5), rr = r & 15, cc = c & 31, ob = rr * 64 + cc * 2; return st * 1024 + (ob ^ (((ob >> 9) & 1) << 5)); }
__host__ __device__ __forceinline__ void stage_rc(int b, int& R, int& C) { const int st = b / 1024, sb = b % 1024, swz = sb ^ (((sb >> 9) & 1) << 5); R = (st >> 1) * 16 + swz / 64; C = (st & 1) * 32 + (swz % 64) / 2; }
__host__ __device__ __forceinline__ int perm32(int rho) { const int n = rho >> 4, i = rho & 15; return 8 * (i >> 2) + 4 * n + (i & 3); }

struct Unit { int pm, pn, g; };
struct Gemm { const bf16_t* A; const bf16_t* Bt; int M, N, K, lda, ldb; };

struct StaticOrder {
    int nM, nN, nwg, G, c;
    __host__ __device__ void init(int M, int N, int G_, int c_) { nM = M / BM; nN = N / BM; nwg = nM * nN; G = G_; c = c_; }
    __host__ __device__ bool next(int i, Unit& u) const {
        const long L = (long)i * G + c; if (L >= nwg) return false;
        int wgid = (int)L; { const int q = nwg / NXCD, r = nwg % NXCD, xcd = wgid % NXCD, off = wgid / NXCD; wgid = (xcd < r ? xcd * (q + 1) : r * (q + 1) + (xcd - r) * q) + off; }
        const int nig = WGM * nN, gid = wgid / nig, fm = gid * WGM, gsz = (nM - fm) < WGM ? (nM - fm) : WGM;
        u.pm = fm + ((wgid % nig) % gsz); u.pn = (wgid % nig) / gsz; u.g = 0; return true;
    }
    __device__ __forceinline__ const char* pa(const Gemm& g, const Unit& u, size_t tstepA) const { return (const char*)g.A + (size_t)u.pm * tstepA; }
    __device__ __forceinline__ const char* pb(const Gemm& g, const Unit& u, size_t tstepB) const { return (const char*)g.Bt + (size_t)u.pn * tstepB; }
    __device__ __forceinline__ bool keep(const Unit&) const { return false; }
    __device__ __forceinline__ void a_ready(const Unit&) const {}
    __device__ __forceinline__ void done(const Unit&) const {}
};

__device__ __forceinline__ unsigned cvt_pk_bf16(float lo, float hi) { unsigned r; asm volatile("v_cvt_pk_bf16_f32 %0, %1, %2" : "=v"(r) : "v"(lo), "v"(hi)); return r; }
__device__ __forceinline__ float bf_lo(unsigned w) { return __uint_as_float(w << 16); }
__device__ __forceinline__ float bf_hi(unsigned w) { return __uint_as_float(w & 0xffff0000u); }
__device__ __forceinline__ float fast_sigmoid(float x) { return __builtin_amdgcn_rcpf(1.0f + __builtin_amdgcn_exp2f(-1.4426950408889634f * x)); }
__device__ __forceinline__ float fast_silu(float x) { return x * fast_sigmoid(x); }

template <bool RS> struct EpiSwiGLUT {
    static constexpr bool PERM = true, AFTER_DRAIN = false, PRE = RS;
    bf16_t* O; int ldc; const unsigned long long* ssq; float inv_k, eps;
    __device__ __forceinline__ float pre_load(const Unit& u, int tid) const { return (tid < BM) ? (float)ssq[u.pm * BM + tid] : 0.f; }
    __device__ __forceinline__ void pre_store(PG8_LAS float* slot, int tid, float v) const { if (tid < BM) slot[tid] = 1.0f / sqrtf(v * inv_k + eps); }
    __device__ __forceinline__ void operator()(const f32x4 (&acc)[2][2][4][2], const Unit& u, int wr, int wc, int fr, int fq, const PG8_LAS float* rsl = nullptr) const {
        const int row0 = u.pm * BM + wr * 64 + fr, col0 = u.pn * HALF + wc * 32 + 8 * fq;
#pragma unroll
        for (int ai = 0; ai < 2; ++ai)
#pragma unroll
            for (int m = 0; m < 4; ++m) { bf16_t* rowp = O + (size_t)(row0 + ai * HALF + m * 16) * ldc + col0;
                const float rs = RS ? rsl[wr * 64 + fr + ai * HALF + m * 16] : 1.0f;
                const f32x4 g0 = acc[ai][0][m][0] * rs, g1 = acc[ai][0][m][1] * rs, u0 = acc[ai][1][m][0] * rs, u1 = acc[ai][1][m][1] * rs;
                f32x4 v0, v1;
#pragma unroll
                for (int j = 0; j < 4; ++j) { v0[j] = fast_silu(g0[j]) * u0[j]; v1[j] = fast_silu(g1[j]) * u1[j]; }
                u32x4 w; w.x = cvt_pk_bf16(v0[0], v0[1]); w.y = cvt_pk_bf16(v0[2], v0[3]); w.z = cvt_pk_bf16(v1[0], v1[1]); w.w = cvt_pk_bf16(v1[2], v1[3]);
                *(u32x4*)rowp = w; }
    }
};
typedef EpiSwiGLUT<false> EpiSwiGLU;
typedef EpiSwiGLUT<true> EpiSwiGLUrs;
template <bool XF32> struct EpiResidBf {
    static constexpr bool PERM = true, AFTER_DRAIN = false, PRE = false;
    const void* base; bf16_t* out; int ldc; float alpha; unsigned long long* ssq;
    __device__ __forceinline__ void operator()(const f32x4 (&acc)[2][2][4][2], const Unit& u, int wr, int wc, int fr, int fq) const {
        const int row0 = u.pm * BM + wr * 64 + fr, col0 = u.pn * BM + wc * 32 + 8 * fq;
#pragma unroll
        for (int ai = 0; ai < 2; ++ai) {
            f32x4 b[4][2][2];
#pragma unroll
            for (int m = 0; m < 4; ++m) { const size_t off = (size_t)(row0 + ai * HALF + m * 16) * ldc + col0;
#pragma unroll
                for (int bj = 0; bj < 2; ++bj) {
                    if (XF32) { b[m][bj][0] = *(const f32x4*)((const float*)base + off + bj * HALF); b[m][bj][1] = *(const f32x4*)((const float*)base + off + bj * HALF + 4); }
                    else { const u32x4 w = *(const u32x4*)((const bf16_t*)base + off + bj * HALF);
                        b[m][bj][0] = (f32x4){bf_lo(w.x), bf_hi(w.x), bf_lo(w.y), bf_hi(w.y)}; b[m][bj][1] = (f32x4){bf_lo(w.z), bf_hi(w.z), bf_lo(w.w), bf_hi(w.w)}; } } }
#pragma unroll
            for (int m = 0; m < 4; ++m) { const size_t off = (size_t)(row0 + ai * HALF + m * 16) * ldc + col0; float ss = 0.f;
#pragma unroll
                for (int bj = 0; bj < 2; ++bj) { const f32x4 o0 = b[m][bj][0] + acc[ai][bj][m][0] * alpha, o1 = b[m][bj][1] + acc[ai][bj][m][1] * alpha;
                    ss += ((o0[0] * o0[0] + o0[1] * o0[1]) + (o0[2] * o0[2] + o0[3] * o0[3])) + ((o1[0] * o1[0] + o1[1] * o1[1]) + (o1[2] * o1[2] + o1[3] * o1[3]));
                    u32x4 w; w.x = cvt_pk_bf16(o0[0], o0[1]); w.y = cvt_pk_bf16(o0[2], o0[3]); w.z = cvt_pk_bf16(o1[0], o1[1]); w.w = cvt_pk_bf16(o1[2], o1[3]);
                    *(u32x4*)(out + off + bj * HALF) = w; }
                ss += __shfl_xor(ss, 16); ss += __shfl_xor(ss, 32);
                if (fq == 0) __hip_atomic_fetch_add(ssq + row0 + ai * HALF + m * 16, (unsigned long long)(ss * 1048576.0f + 0.5f), __ATOMIC_RELAXED, __HIP_MEMORY_SCOPE_AGENT); }
        }
    }
};
struct EpiStoreBf16 {
    static constexpr bool PERM = true, AFTER_DRAIN = false, PRE = true;
    bf16_t* O; int ldc; const unsigned long long* ssq; float inv_k, eps;
    __device__ __forceinline__ float pre_load(const Unit& u, int tid) const { return (tid < BM) ? (float)ssq[u.pm * BM + tid] : 0.f; }
    __device__ __forceinline__ void pre_store(PG8_LAS float* slot, int tid, float v) const { if (tid < BM) slot[tid] = 1.0f / sqrtf(v * inv_k + eps); }
    __device__ __forceinline__ void operator()(const f32x4 (&acc)[2][2][4][2], const Unit& u, int wr, int wc, int fr, int fq, const PG8_LAS float* rsl) const {
        const int row0 = u.pm * BM + wr * 64 + fr, col0 = u.pn * BM + wc * 32 + 8 * fq;
#pragma unroll
        for (int ai = 0; ai < 2; ++ai)
#pragma unroll
            for (int m = 0; m < 4; ++m) { bf16_t* rowp = O + (size_t)(row0 + ai * HALF + m * 16) * ldc + col0;
                const float scale = rsl[wr * 64 + fr + ai * HALF + m * 16];
#pragma unroll
                for (int bj = 0; bj < 2; ++bj) { const f32x4 v0 = acc[ai][bj][m][0] * scale, v1 = acc[ai][bj][m][1] * scale;
                    u32x4 w; w.x = cvt_pk_bf16(v0[0], v0[1]); w.y = cvt_pk_bf16(v0[2], v0[3]); w.z = cvt_pk_bf16(v1[0], v1[1]); w.w = cvt_pk_bf16(v1[2], v1[3]);
                    *(u32x4*)(rowp + bj * HALF) = w; } }
    }
};
struct EpiKV {
    static constexpr bool PERM = true, AFTER_DRAIN = false, PRE = false;
    bf16_t* KB; bf16_t* VT;
    __device__ __forceinline__ void operator()(const f32x4 (&acc)[2][2][4][2], const Unit& u, int wr, int wc, int fr, int fq) const {
        const int rl0 = wr * 64 + fr;
        if (u.pn < 2) {
            const int col0 = u.pn * BM + wc * 32 + 8 * fq;
#pragma unroll
            for (int ai = 0; ai < 2; ++ai)
#pragma unroll
                for (int m = 0; m < 4; ++m) { bf16_t* rowp = KB + (size_t)(u.pm * BM + rl0 + ai * HALF + m * 16) * 512 + col0;
#pragma unroll
                    for (int bj = 0; bj < 2; ++bj) { const f32x4 v0 = acc[ai][bj][m][0], v1 = acc[ai][bj][m][1];
                        u32x4 w; w.x = cvt_pk_bf16(v0[0], v0[1]); w.y = cvt_pk_bf16(v0[2], v0[3]); w.z = cvt_pk_bf16(v1[0], v1[1]); w.w = cvt_pk_bf16(v1[2], v1[3]);
                        *(u32x4*)(rowp + bj * HALF) = w; } }
        } else {
            const int colv0 = (u.pn - 2) * BM + wc * 32 + 8 * fq;
#pragma unroll
            for (int ai = 0; ai < 2; ++ai)
#pragma unroll
                for (int m = 0; m < 4; ++m) { const int key = rl0 + ai * HALF + m * 16;
#pragma unroll
                    for (int bj = 0; bj < 2; ++bj)
#pragma unroll
                        for (int n = 0; n < 2; ++n)
#pragma unroll
                            for (int e = 0; e < 4; ++e) { const int cv = colv0 + bj * HALF + 4 * n + e;
                                VT[((size_t)u.pm * 512 + cv) * 256 + key] = (bf16_t)(cvt_pk_bf16(acc[ai][bj][m][n][e], 0.f) & 0xffffu); } }
        }
    }
};
struct EpiGateA {
    static constexpr bool PERM = true, AFTER_DRAIN = false, PRE = false;
    float* T; int ldc; const bf16_t* G; int ldg;
    __device__ __forceinline__ void operator()(const f32x4 (&acc)[2][2][4][2], const Unit& u, int wr, int wc, int fr, int fq) const {
        const int row0 = u.pm * BM + wr * 64 + fr, col0 = u.pn * BM + wc * 32 + 8 * fq;
#pragma unroll
        for (int ai = 0; ai < 2; ++ai)
#pragma unroll
            for (int m = 0; m < 4; ++m) { const size_t row = (size_t)(row0 + ai * HALF + m * 16);
#pragma unroll
                for (int bj = 0; bj < 2; ++bj) { const int c = col0 + bj * HALF; const u32x4 gw = *(const u32x4*)(G + row * ldg + c);
                    f32x4 v0 = acc[ai][bj][m][0], v1 = acc[ai][bj][m][1];
                    v0[0] *= fast_sigmoid(bf_lo(gw.x)); v0[1] *= fast_sigmoid(bf_hi(gw.x)); v0[2] *= fast_sigmoid(bf_lo(gw.y)); v0[3] *= fast_sigmoid(bf_hi(gw.y));
                    v1[0] *= fast_sigmoid(bf_lo(gw.z)); v1[1] *= fast_sigmoid(bf_hi(gw.z)); v1[2] *= fast_sigmoid(bf_lo(gw.w)); v1[3] *= fast_sigmoid(bf_hi(gw.w));
                    *(f32x4*)(T + row * ldc + c) = v0; *(f32x4*)(T + row * ldc + c + 4) = v1; } }
    }
};
struct EpiGateB {
    static constexpr bool PERM = true, AFTER_DRAIN = false, PRE = false;
    const float* T; bf16_t* O; int ldc; const bf16_t* G; int ldg;
    __device__ __forceinline__ void operator()(const f32x4 (&acc)[2][2][4][2], const Unit& u, int wr, int wc, int fr, int fq) const {
        const int row0 = u.pm * BM + wr * 64 + fr, col0 = u.pn * BM + wc * 32 + 8 * fq;
#pragma unroll
        for (int ai = 0; ai < 2; ++ai)
#pragma unroll
            for (int m = 0; m < 4; ++m) { const size_t row = (size_t)(row0 + ai * HALF + m * 16);
#pragma unroll
                for (int bj = 0; bj < 2; ++bj) { const int c = col0 + bj * HALF; const u32x4 gw = *(const u32x4*)(G + row * ldg + c);
                    const f32x4 t0 = *(const f32x4*)(T + row * ldc + c), t1 = *(const f32x4*)(T + row * ldc + c + 4);
                    f32x4 v0 = acc[ai][bj][m][0], v1 = acc[ai][bj][m][1];
                    v0[0] = t0[0] + v0[0] * fast_sigmoid(bf_lo(gw.x)); v0[1] = t0[1] + v0[1] * fast_sigmoid(bf_hi(gw.x)); v0[2] = t0[2] + v0[2] * fast_sigmoid(bf_lo(gw.y)); v0[3] = t0[3] + v0[3] * fast_sigmoid(bf_hi(gw.y));
                    v1[0] = t1[0] + v1[0] * fast_sigmoid(bf_lo(gw.z)); v1[1] = t1[1] + v1[1] * fast_sigmoid(bf_hi(gw.z)); v1[2] = t1[2] + v1[2] * fast_sigmoid(bf_lo(gw.w)); v1[3] = t1[3] + v1[3] * fast_sigmoid(bf_hi(gw.w));
                    u32x4 w; w.x = cvt_pk_bf16(v0[0], v0[1]); w.y = cvt_pk_bf16(v0[2], v0[3]); w.z = cvt_pk_bf16(v1[0], v1[1]); w.w = cvt_pk_bf16(v1[2], v1[3]);
                    *(u32x4*)(O + row * ldc + c) = w; } }
    }
};

struct OrderFfnKv : StaticOrder {
    const bf16_t* A1; const bf16_t* B1;
    __device__ __forceinline__ bool next(int i, Unit& u) const {
        if (StaticOrder::next(i, u)) return true;
        const long L = (long)i * G + c - nwg; if (L < 0 || L >= 16) return false;
        u.g = 1; u.pm = (int)(L >> 2); u.pn = (int)(L & 3); return true; }
    __device__ __forceinline__ const char* pa(const Gemm& g, const Unit& u, size_t tstepA) const { return (const char*)(u.g ? A1 : g.A) + (size_t)u.pm * tstepA; }
    __device__ __forceinline__ const char* pb(const Gemm& g, const Unit& u, size_t tstepB) const { return (const char*)(u.g ? B1 : g.Bt) + (size_t)u.pn * tstepB; }
};
struct EpiSwiGLUKV {
    static constexpr bool PERM = true, AFTER_DRAIN = false, PRE = false;
    EpiSwiGLU e0; EpiKV e1;
    __device__ __forceinline__ void operator()(const f32x4 (&acc)[2][2][4][2], const Unit& u, int wr, int wc, int fr, int fq) const { if (u.g == 0) e0(acc, u, wr, wc, fr, fq); else e1(acc, u, wr, wc, fr, fq); }
};
struct OrderSplitK4 {
    int G, c, ks_bytes;
    __device__ __forceinline__ bool next(int i, Unit& u) const { const long L = (long)i * G + c; if (L >= 256) return false; u.pm = (int)(L >> 3); u.pn = (int)((L >> 2) & 1); u.g = (int)(L & 3); return true; }
    __device__ __forceinline__ const char* pa(const Gemm& g, const Unit& u, size_t tstepA) const { return (const char*)g.A + (size_t)u.pm * tstepA + (size_t)u.g * ks_bytes; }
    __device__ __forceinline__ const char* pb(const Gemm& g, const Unit& u, size_t tstepB) const { return (const char*)g.Bt + (size_t)u.pn * tstepB + (size_t)u.g * ks_bytes; }
    __device__ __forceinline__ bool keep(const Unit&) const { return false; }
    __device__ __forceinline__ void a_ready(const Unit&) const {}
    __device__ __forceinline__ void done(const Unit&) const {}
};
struct EpiPartF32 {
    static constexpr bool PERM = false, AFTER_DRAIN = false, PRE = false;
    float* P; int ldc; size_t gstride;
    __device__ __forceinline__ void operator()(const f32x4 (&acc)[2][2][4][2], const Unit& u, int wr, int wc, int fr, int fq) const {
        const int row0 = u.pm * BM + wr * 64 + fr, col0 = u.pn * BM + wc * 32 + 4 * fq; float* out = P + (size_t)u.g * gstride;
#pragma unroll
        for (int ai = 0; ai < 2; ++ai)
#pragma unroll
            for (int m = 0; m < 4; ++m) { const size_t off = (size_t)(row0 + ai * HALF + m * 16) * ldc + col0;
#pragma unroll
                for (int bj = 0; bj < 2; ++bj)
#pragma unroll
                    for (int n = 0; n < 2; ++n) *(f32x4*)(out + off + bj * HALF + n * 16) = acc[ai][bj][m][n]; }
    }
};
struct OrderTwoPass : StaticOrder {
    const bf16_t* A1; const bf16_t* B1;
    __device__ __forceinline__ bool next(int i, Unit& u) const { if (!StaticOrder::next(i >> 1, u)) return false; u.g = i & 1; return true; }
    __device__ __forceinline__ const char* pa(const Gemm& g, const Unit& u, size_t tstepA) const { return (const char*)(u.g ? A1 : g.A) + (size_t)u.pm * tstepA; }
    __device__ __forceinline__ const char* pb(const Gemm& g, const Unit& u, size_t tstepB) const { return (const char*)(u.g ? B1 : g.Bt) + (size_t)u.pn * tstepB; }
    __device__ __forceinline__ bool keep(const Unit& u) const { return u.g == 0; }
};
struct EpiGateFused {
    static constexpr bool PERM = true, AFTER_DRAIN = false, PRE = false;
    bf16_t* O; int ldc; const bf16_t* GA; const bf16_t* GB; int ldg;
    __device__ __forceinline__ void operator()(f32x4 (&acc)[2][2][4][2], const Unit& u, int wr, int wc, int fr, int fq) const {
        const int row0 = u.pm * BM + wr * 64 + fr, col0 = u.pn * BM + wc * 32 + 8 * fq;
#pragma unroll
        for (int ai = 0; ai < 2; ++ai) {
            u32x4 gbv[4][2], gav[4][2];
#pragma unroll
            for (int m = 0; m < 4; ++m) { const size_t row = (size_t)(row0 + ai * HALF + m * 16);
#pragma unroll
                for (int bj = 0; bj < 2; ++bj) { gbv[m][bj] = *(const u32x4*)(GB + row * ldg + col0 + bj * HALF); if (u.g == 0) gav[m][bj] = *(const u32x4*)(GA + row * ldg + col0 + bj * HALF); } }
#pragma unroll
            for (int m = 0; m < 4; ++m) { const size_t row = (size_t)(row0 + ai * HALF + m * 16);
#pragma unroll
                for (int bj = 0; bj < 2; ++bj) { const int c = col0 + bj * HALF; const u32x4 gb = gbv[m][bj];
                    float eb[8] = {bf_lo(gb.x), bf_hi(gb.x), bf_lo(gb.y), bf_hi(gb.y), bf_lo(gb.z), bf_hi(gb.z), bf_lo(gb.w), bf_hi(gb.w)};
#pragma unroll
                    for (int e = 0; e < 8; ++e) eb[e] = 1.0f + __builtin_amdgcn_exp2f(-1.4426950408889634f * eb[e]);
                    if (u.g == 0) { const u32x4 ga = gav[m][bj];
                        float ea[8] = {bf_lo(ga.x), bf_hi(ga.x), bf_lo(ga.y), bf_hi(ga.y), bf_lo(ga.z), bf_hi(ga.z), bf_lo(ga.w), bf_hi(ga.w)};
#pragma unroll
                        for (int e = 0; e < 8; ++e) { const float rt = eb[e] * __builtin_amdgcn_rcpf(1.0f + __builtin_amdgcn_exp2f(-1.4426950408889634f * ea[e]));
                            acc[ai][bj][m][e >> 2][e & 3] *= rt; }
                    } else { f32x4 v0 = acc[ai][bj][m][0], v1 = acc[ai][bj][m][1];
#pragma unroll
                        for (int e = 0; e < 4; ++e) { v0[e] *= __builtin_amdgcn_rcpf(eb[e]); v1[e] *= __builtin_amdgcn_rcpf(eb[4 + e]); }
                        u32x4 w; w.x = cvt_pk_bf16(v0[0], v0[1]); w.y = cvt_pk_bf16(v0[2], v0[3]); w.z = cvt_pk_bf16(v1[0], v1[1]); w.w = cvt_pk_bf16(v1[2], v1[3]);
                        *(u32x4*)(O + row * ldc + c) = w; } } }
        }
    }
};


template <class Epi, class Sched, bool ALIGN_EPI = false, bool SP2 = false>
__device__ __forceinline__ void gemm_phase(PG8_LAS unsigned char* lds, const Gemm g, const Sched& S, const Epi& E) {
    const int tid = threadIdx.x, wid = __builtin_amdgcn_readfirstlane(tid >> 6), lane = tid & 63, wr = wid >> 2, wc = wid & 3, fr = lane & 15, fq = lane >> 4;
    const int K = g.K, nt = K / BK;
    unsigned voffA[2], voffB[2];
#pragma unroll
    for (int i = 0; i < 2; ++i) { int R, C; stage_rc(tid * 16 + i * 8192, R, C); const int Rb = Epi::PERM ? ((R & ~31) + perm32(R & 31)) : R;
        voffA[i] = (unsigned)(R * g.lda + C) * 2u; voffB[i] = (unsigned)(Rb * g.ldb + C) * 2u; }
    const size_t kstep = (size_t)(BK * 2);
    const size_t hstepA = (size_t)HALF * g.lda * 2, hstepB = (size_t)HALF * g.ldb * 2;
    const size_t tstepA = 2 * hstepA, tstepB = 2 * hstepB;
    const unsigned ldsw = (unsigned)wid * 1024u;
    const int aoff = lds_byte(wr * 64 + fr, fq * 8), boff = lds_byte(wc * 32 + fr, fq * 8);
#define PG8_SA(b, h) (((b) * 2 + (h)) * HTB)
#define PG8_SB(b, h) ((4 + (b) * 2 + (h)) * HTB)
#define PG8_STAGE(bufoff, gbase, voff) do { _Pragma("unroll") for (int _i = 0; _i < 2; ++_i) \
        __builtin_amdgcn_global_load_lds((const unsigned*)((const char*)(gbase) + (voff)[_i]), (PG8_LAS unsigned*)(lds + (bufoff) + ldsw + _i * 8192), 16, 0, 0); } while (0)
#define PG8_LDA(dst, b, h) do { _Pragma("unroll") for (int m = 0; m < 4; ++m) _Pragma("unroll") for (int k = 0; k < 2; ++k) dst[m][k] = *(const PG8_LAS bf16x8*)(lds + PG8_SA(b, h) + aoff + m * 2048 + k * 1024); } while (0)
#define PG8_LDB(dst, b, h) do { _Pragma("unroll") for (int n = 0; n < 2; ++n) _Pragma("unroll") for (int k = 0; k < 2; ++k) dst[n][k] = *(const PG8_LAS bf16x8*)(lds + PG8_SB(b, h) + boff + n * 2048 + k * 1024); } while (0)
#define PG8_MMA(ai, bj, At, Bt) do { __builtin_amdgcn_s_setprio(1); _Pragma("unroll") for (int m = 0; m < 4; ++m) _Pragma("unroll") for (int n = 0; n < 2; ++n) _Pragma("unroll") for (int k = 0; k < 2; ++k) \
        acc[ai][bj][m][n] = __builtin_amdgcn_mfma_f32_16x16x32_bf16(Bt[n][k], At[m][k], acc[ai][bj][m][n], 0, 0, 0); __builtin_amdgcn_s_setprio(0); } while (0)
#define PG8_WAIT_V(n) asm volatile("s_waitcnt vmcnt(" #n ")" ::: "memory")
#define PG8_WAIT_L(n) asm volatile("s_waitcnt lgkmcnt(" #n ")" ::: "memory")
#define PG8_BAR __builtin_amdgcn_s_barrier()
#define PG8_SCHED __builtin_amdgcn_sched_barrier(0)
    Unit cur, nxt; int ui = 0;
    if (!S.next(0, cur)) return;
    f32x4 acc[2][2][4][2];
#pragma unroll
    for (int a = 0; a < 2; ++a)
#pragma unroll
        for (int b = 0; b < 2; ++b)
#pragma unroll
            for (int m = 0; m < 4; ++m)
#pragma unroll
                for (int n = 0; n < 2; ++n) acc[a][b][m][n] = (f32x4){0.f, 0.f, 0.f, 0.f};
    bf16x8 At[4][2], B0[2][2], B1[2][2];
    const char* cA = S.pa(g, cur, tstepA); const char* cB = S.pb(g, cur, tstepB);
    PG8_LAS float* const rsl = (PG8_LAS float*)(lds + STAGE_BYTES); float pv = 0.f; int slot = 0;
    if constexpr (Epi::PRE) pv = E.pre_load(cur, tid);
    S.a_ready(cur);
    if constexpr (SP2) {
        PG8_STAGE(PG8_SB(0, 0), cB, voffB); PG8_STAGE(PG8_SB(0, 1), cB + hstepB, voffB); PG8_STAGE(PG8_SA(0, 0), cA, voffA); PG8_STAGE(PG8_SA(0, 1), cA + hstepA, voffA);
        if (wr == 1) PG8_BAR;
        PG8_WAIT_V(2); if constexpr (Epi::PRE) E.pre_store(rsl, tid, pv); PG8_BAR;
        PG8_STAGE(PG8_SB(1, 0), cB + kstep, voffB); PG8_STAGE(PG8_SA(1, 0), cA + kstep, voffA); PG8_STAGE(PG8_SB(1, 1), cB + hstepB + kstep, voffB);
        PG8_WAIT_V(6); PG8_BAR;
    } else {
        PG8_STAGE(PG8_SB(0, 0), cB, voffB); PG8_STAGE(PG8_SA(0, 0), cA, voffA); PG8_STAGE(PG8_SB(0, 1), cB + hstepB, voffB); PG8_STAGE(PG8_SA(0, 1), cA + hstepA, voffA);
        if (wr == 1) PG8_BAR;
        PG8_WAIT_V(4); if constexpr (Epi::PRE) E.pre_store(rsl, tid, pv); PG8_BAR;
        PG8_STAGE(PG8_SB(1, 0), cB + kstep, voffB); PG8_STAGE(PG8_SA(1, 0), cA + kstep, voffA); PG8_STAGE(PG8_SB(1, 1), cB + hstepB + kstep, voffB);
        PG8_WAIT_V(6); PG8_BAR;
    }
    for (;;) {
        const bool has_next = S.next(ui + 1, nxt);
        const char* nA = has_next ? S.pa(g, nxt, tstepA) : cA; const char* nB = has_next ? S.pb(g, nxt, tstepB) : cB;
        for (int t = 0; t < nt; t += 2) {
            const bool last = (t == nt - 2);
            const char* a1 = cA + (size_t)(t + 1) * kstep;
            const char* a2 = last ? nA : cA + (size_t)(t + 2) * kstep; const char* b2 = last ? nB : cB + (size_t)(t + 2) * kstep;
            const char* a3 = a2 + kstep; const char* b3 = b2 + kstep;
            if (last && has_next) S.a_ready(nxt);
            if constexpr (SP2) {
            PG8_LDB(B0, 0, 0); PG8_LDB(B1, 0, 1); PG8_SCHED; PG8_LDA(At, 0, 0); PG8_STAGE(PG8_SA(1, 1), a1 + hstepA, voffA);
            PG8_WAIT_V(8); PG8_WAIT_L(0); PG8_BAR; PG8_MMA(0, 0, At, B0); PG8_MMA(0, 1, At, B1); PG8_BAR; PG8_SCHED;
            PG8_LDA(At, 0, 1); PG8_STAGE(PG8_SB(0, 0), b2, voffB); PG8_STAGE(PG8_SB(0, 1), b2 + hstepB, voffB); PG8_STAGE(PG8_SA(0, 0), a2, voffA);
            PG8_WAIT_V(8); PG8_WAIT_L(0); PG8_BAR; PG8_MMA(1, 0, At, B0); PG8_MMA(1, 1, At, B1); PG8_BAR; PG8_SCHED;
            PG8_LDB(B0, 1, 0); PG8_LDB(B1, 1, 1); PG8_SCHED; PG8_LDA(At, 1, 0); PG8_STAGE(PG8_SA(0, 1), a2 + hstepA, voffA);
            PG8_WAIT_V(8); PG8_WAIT_L(0); PG8_BAR; PG8_MMA(0, 0, At, B0); PG8_MMA(0, 1, At, B1); PG8_BAR; PG8_SCHED;
            PG8_LDA(At, 1, 1); PG8_STAGE(PG8_SB(1, 0), b3, voffB); PG8_STAGE(PG8_SB(1, 1), b3 + hstepB, voffB); PG8_STAGE(PG8_SA(1, 0), a3, voffA);
            PG8_WAIT_V(8); PG8_WAIT_L(0); PG8_BAR; PG8_MMA(1, 0, At, B0); PG8_MMA(1, 1, At, B1); PG8_BAR; PG8_SCHED;
            } else {
            PG8_LDB(B0, 0, 0); PG8_SCHED; PG8_LDA(At, 0, 0); PG8_STAGE(PG8_SA(1, 1), a1 + hstepA, voffA);
            PG8_WAIT_L(8); PG8_BAR; PG8_WAIT_L(0); PG8_MMA(0, 0, At, B0); PG8_BAR; PG8_SCHED;
            PG8_LDB(B1, 0, 1); PG8_STAGE(PG8_SB(0, 0), b2, voffB);
            PG8_BAR; PG8_WAIT_L(0); PG8_MMA(0, 1, At, B1); PG8_BAR;
            PG8_LDA(At, 0, 1); PG8_STAGE(PG8_SA(0, 0), a2, voffA);
            PG8_BAR; PG8_WAIT_L(0); PG8_MMA(1, 0, At, B0); PG8_BAR; PG8_SCHED;
            PG8_STAGE(PG8_SB(0, 1), b2 + hstepB, voffB);
            PG8_WAIT_V(6); PG8_BAR; PG8_MMA(1, 1, At, B1); PG8_BAR;
            PG8_LDB(B0, 1, 0); PG8_SCHED; PG8_LDA(At, 1, 0); PG8_STAGE(PG8_SA(0, 1), a2 + hstepA, voffA);
            PG8_WAIT_L(8); PG8_BAR; PG8_WAIT_L(0); PG8_MMA(0, 0, At, B0); PG8_BAR; PG8_SCHED;
            PG8_LDB(B1, 1, 1); PG8_STAGE(PG8_SB(1, 0), b3, voffB);
            PG8_BAR; PG8_WAIT_L(0); PG8_MMA(0, 1, At, B1); PG8_BAR;
            PG8_LDA(At, 1, 1); PG8_STAGE(PG8_SA(1, 0), a3, voffA);
            PG8_BAR; PG8_WAIT_L(0); PG8_MMA(1, 0, At, B0); PG8_BAR; PG8_SCHED;
            PG8_STAGE(PG8_SB(1, 1), b3 + hstepB, voffB);
            PG8_WAIT_V(6); PG8_BAR; PG8_MMA(1, 1, At, B1); PG8_BAR;
            }
        }
        if constexpr (ALIGN_EPI) { if (wr == 0) PG8_BAR; }
        if constexpr (!Epi::AFTER_DRAIN) {
            if constexpr (Epi::PRE) { float pn_ = 0.f; if (has_next) pn_ = E.pre_load(nxt, tid); E(acc, cur, wr, wc, fr, fq, rsl + slot * 256); if (has_next) E.pre_store(rsl + (slot ^ 1) * 256, tid, pn_); slot ^= 1; }
            else E(acc, cur, wr, wc, fr, fq);
            S.done(cur); }
        if (!has_next) break;
        if (!S.keep(cur))
#pragma unroll
        for (int a = 0; a < 2; ++a)
#pragma unroll
            for (int b = 0; b < 2; ++b)
#pragma unroll
                for (int m = 0; m < 4; ++m)
#pragma unroll
                    for (int n = 0; n < 2; ++n) acc[a][b][m][n] = (f32x4){0.f, 0.f, 0.f, 0.f};
        cur = nxt; cA = nA; cB = nB; ++ui;
        if constexpr (ALIGN_EPI) { if (wr == 1) PG8_BAR; }
    }
    PG8_WAIT_V(0);
    if constexpr (!ALIGN_EPI) { if (wr == 0) PG8_BAR; }
    PG8_BAR;
    if constexpr (Epi::AFTER_DRAIN) { E.fused(acc, cur, wr, wc, fr, fq, lds, wid, lane); S.done(cur); }
#undef PG8_SA
#undef PG8_SB
#undef PG8_STAGE
#undef PG8_LDA
#undef PG8_LDB
#undef PG8_MMA
#undef PG8_WAIT_V
#undef PG8_WAIT_L
#undef PG8_BAR
#undef PG8_SCHED
}
}
#define GAS __attribute__((address_space(1)))
#define LAS __attribute__((address_space(3)))
typedef unsigned short bf16;
typedef unsigned v4u __attribute__((ext_vector_type(4)));
typedef float f32x4 __attribute__((ext_vector_type(4)));
typedef short bf16x8 __attribute__((ext_vector_type(8)));
typedef GAS unsigned gu32;
typedef GAS unsigned long long gu64;
#define RLX_AGENT __ATOMIC_RELAXED, __HIP_MEMORY_SCOPE_AGENT
#define LDS_WAIT() asm volatile("s_waitcnt lgkmcnt(0)" ::: "memory")
#define VM_WAIT() asm volatile("s_waitcnt vmcnt(0)" ::: "memory")
__device__ __forceinline__ unsigned long long rt() { return __builtin_amdgcn_s_memrealtime(); }
__device__ __forceinline__ unsigned f2bf(float f) { unsigned u = __builtin_bit_cast(unsigned, f); return (u + 0x7fffu + ((u >> 16) & 1u)) >> 16; }
__device__ __forceinline__ unsigned pk2(float lo, float hi) { return f2bf(lo) | (f2bf(hi) << 16); }

#define XB_TMO      128
#define XB_XCNT(j)  (256  + 64 * (j))
#define XB_XSUB(j)  (1280 + 64 * (j))
#define XB_XGEN(j)  (2304 + 64 * (j))
#define XB_TOP      3328
#define XB_TOPGEN   3392
#define XCD_BAR_WORDS 3456
#define XB_SPIN_CAP (1u << 18)

__device__ __forceinline__ unsigned xb_ld(unsigned* p)              { return __hip_atomic_load(p, __ATOMIC_RELAXED, __HIP_MEMORY_SCOPE_AGENT); }
__device__ __forceinline__ unsigned xb_add(unsigned* p, unsigned v) { return __hip_atomic_fetch_add(p, v, __ATOMIC_RELAXED, __HIP_MEMORY_SCOPE_AGENT); }
__device__ __forceinline__ unsigned xb_xcc_id() { return (unsigned)__builtin_amdgcn_s_getreg((3 << 11) | 20) & 0xFu; }
#define XB_SPIN(cond, bar) do { unsigned _sp = 0; while (cond) { __builtin_amdgcn_s_sleep(1); \
    if ((++_sp & 255u) == 0u) { if (xb_ld(&(bar)[XB_TMO])) break; if (_sp > XB_SPIN_CAP) { atomicAdd(&(bar)[XB_TMO], 1u); break; } } } } while (0)

struct XcdBarrier {
    unsigned* bar; unsigned x;
    volatile LAS unsigned* st;
};

__device__ __forceinline__ XcdBarrier xcd_barrier_post(unsigned* bar, volatile LAS unsigned* st) {
    XcdBarrier b; b.bar = bar; b.x = xb_xcc_id(); b.st = st;
    if (threadIdx.x == 0) (void)xb_add(&bar[XB_XCNT(b.x)], 1u);
    return b;
}
__device__ __forceinline__ void xcd_barrier_complete(unsigned* bar, unsigned x, unsigned& nloc, unsigned& nx) {
    const unsigned G = gridDim.x * gridDim.y * gridDim.z;
    unsigned sum, cnt, mine, sp = 0u;
    for (;;) {
        sum = 0u; cnt = 0u; mine = 0u;
#pragma unroll
        for (unsigned j = 0; j < 16; ++j) { const unsigned c = xb_ld(&bar[XB_XCNT(j)]); sum += c; cnt += (c > 0u) ? 1u : 0u; mine = (j == x) ? c : mine; }
        if (sum == G) break;
        __builtin_amdgcn_s_sleep(1);
        if ((++sp & 255u) == 0u) { if (xb_ld(&bar[XB_TMO])) break; if (sp > XB_SPIN_CAP) { atomicAdd(&bar[XB_TMO], 1u); break; } }
    }
    nloc = mine > 0u ? mine : 1u; nx = cnt > 0u ? cnt : 1u;
}

__device__ __forceinline__ void xcd_barrier(const XcdBarrier& b) {
    asm volatile("s_waitcnt vmcnt(0)" ::: "memory");
    __syncthreads();
    if (threadIdx.x == 0) {
        unsigned* bar = b.bar;
        __builtin_amdgcn_s_waitcnt(0);
        unsigned nloc = b.st[0], nx = b.st[1];
        if (nloc == 0u) { xcd_barrier_complete(bar, b.x, nloc, nx); b.st[0] = nloc; b.st[1] = nx; }
        const unsigned old = xb_add(&bar[XB_XSUB(b.x)], 1u);
        const unsigned gen = old / nloc;
        if (old + 1u == (gen + 1u) * nloc) {
            __builtin_amdgcn_fence(__ATOMIC_RELEASE, "agent");
            asm volatile("s_waitcnt vmcnt(0)" ::: "memory");
            const unsigned og = xb_add(&bar[XB_TOP], 1u);
            const unsigned tg = og / nx;
            if (og + 1u == (tg + 1u) * nx) xb_add(&bar[XB_TOPGEN], 1u);
            else XB_SPIN(xb_ld(&bar[XB_TOPGEN]) == tg, bar);
            __builtin_amdgcn_fence(__ATOMIC_ACQUIRE, "agent");
            xb_add(&bar[XB_XGEN(b.x)], 1u);
            asm volatile("s_waitcnt vmcnt(0)" ::: "memory");
        } else {
            XB_SPIN(xb_ld(&bar[XB_XGEN(b.x)]) == gen, bar);
            __builtin_amdgcn_fence(__ATOMIC_ACQUIRE, "agent");
            asm volatile("s_waitcnt vmcnt(0)" ::: "memory");
        }
    }
    __syncthreads();
}

constexpr int NWAVES = 8, NTHREADS = NWAVES * 64;
constexpr int BATCH = 4, SEQ = 2048, D = 4096, FF = 11008, M = BATCH * SEQ;
constexpr int CW = 2048, DNW = 2048, NH = 16, HD = 128, CH = 64, NCH = SEQ / CH;
constexpr int NPROJ = 22560, NPP = 22528;
constexpr int OFF_CX = 0, OFF_CC = 2048, OFF_CB = 4096, OFF_Q = 6144, OFF_Z = 12288, OFF_GA = 14336, OFF_GB = 18432;
constexpr int MEMT = 256, XW = 512;
constexpr float EPS = 1e-6f;
constexpr float SSQ_INVK = 1.0f / (4096.0f * 1048576.0f);
#ifndef PROBE_PHASE
#define PROBE_REPS 3
#define PROBE_SUB 0
#define PROBE_PHASE -1
#endif
constexpr int NPH = 15;

constexpr size_t MiB = 1u << 20;
constexpr size_t WS_CTL = 0, CTL_ZERO_BYTES = 1 * MiB;
constexpr size_t WS_W1GU = 1 * MiB, WS_W1D = 173 * MiB, WS_W2GU = 259 * MiB, WS_W2D = 431 * MiB, WS_WIN = 517 * MiB;
constexpr size_t WS_WA = 695 * MiB, WS_WB = 711 * MiB, WS_WO = 727 * MiB, WS_WQ = 759 * MiB, WS_WKV = 763 * MiB, WS_WXO = 771 * MiB;
constexpr size_t WS_XN = 775 * MiB;
constexpr size_t WS_R = 839 * MiB;
constexpr size_t WS_DN = 1195 * MiB;
constexpr size_t WS_WC = WS_DN, WS_UB = WS_DN + 64 * MiB, WS_QD = WS_DN + 128 * MiB, WS_KTT = WS_DN + 192 * MiB, WS_AQK = WS_DN + 256 * MiB, WS_GL = WS_DN + 288 * MiB;
constexpr size_t WS_TMP = WS_DN;
constexpr size_t WS_MN = 1484 * MiB, WS_KB = 1492 * MiB, WS_VT = 1493 * MiB, WS_AB = 1494 * MiB, WS_XNB = 1498 * MiB, WS_END = 1562 * MiB;
constexpr size_t WS_O = WS_W1GU, WS_CONVA = WS_W1GU + 64 * MiB, WS_ON = WS_W1GU + 96 * MiB, WS_XO = WS_W1GU + 136 * MiB;
constexpr size_t WS_QP = WS_O;
constexpr int CW_TMO = 0, CW_BAR = 4096;
constexpr size_t WS_SSQ = 65536;
constexpr int RING_BYTES = 131072;
constexpr int ATT_LDS = 256 * 272 + 128 * 528;
constexpr int MISC_OFF = 147456;
constexpr int LDS_BYTES = 151552;
static_assert(ATT_LDS <= MISC_OFF && MISC_OFF + 128 <= LDS_BYTES, "LDS map");

__device__ __forceinline__ float bfl(unsigned w) { return __uint_as_float(w << 16); }
__device__ __forceinline__ float bfh(unsigned w) { return __uint_as_float(w & 0xffff0000u); }
__device__ __forceinline__ float bf1(bf16 v) { return __uint_as_float(((unsigned)v) << 16); }
__device__ __forceinline__ float sigm(float x) { return __builtin_amdgcn_rcpf(1.0f + __builtin_amdgcn_exp2f(-1.4426950408889634f * x)); }
__device__ __forceinline__ float wave_sum(float v) {
#pragma unroll
    for (int o = 1; o < 64; o <<= 1) v += __shfl_xor(v, o);
    return v;
}

#define TW_GAS __attribute__((address_space(1)))
struct TwItem { int k0, n0, drow0; };
__device__ __forceinline__ TwItem tw_item(int kb, int nb, int mode, int roff) {
    TwItem t; t.k0 = 64 * kb; t.n0 = 32 * nb;
    t.drow0 = (mode == 0) ? (roff + t.n0) : (mode == 3) ? ((t.n0 < 14336) ? t.n0 : (t.n0 < 14368) ? (NPP + t.n0 - 14336) : (t.n0 - 32))
                                          : (256 * (t.n0 >> 7) + 128 * (mode - 1) + (t.n0 & 127));
    return t;
}
struct TwDesc { const float* W; bf16* WT; const float* gain; int N, ldk; TwItem t; };
struct TwSet { f32x4 r[10]; bf16* dst; int ldk; int hg; };
__device__ __forceinline__ void tw_load4(TwSet& s, const TwDesc& d, int lane) {
    const float* p = d.W + (size_t)(d.t.k0 + (lane >> 3)) * d.N + d.t.n0 + 4 * (lane & 7);
#pragma unroll
    for (int i = 0; i < 8; ++i) s.r[i] = __builtin_nontemporal_load((const TW_GAS f32x4*)(p + (size_t)(8 * i) * d.N));
    const float* gp = (d.gain ? d.gain : d.W) + d.t.k0 + 8 * (lane & 7);
    s.r[8] = *(const TW_GAS f32x4*)gp; s.r[9] = *(const TW_GAS f32x4*)(gp + 4);
    s.dst = d.WT + (size_t)(d.t.drow0 + (lane >> 3)) * d.ldk + d.t.k0 + 8 * (lane & 7); s.ldk = d.ldk; s.hg = d.gain != nullptr;
}
__device__ __forceinline__ void tw_store4(const TwSet& s, LAS float* scr, int lane) {
#pragma unroll
    for (int i = 0; i < 8; ++i) { LAS float* w = scr + (8 * i + (lane >> 3)) * 33 + 4 * (lane & 7); w[0] = s.r[i].x; w[1] = s.r[i].y; w[2] = s.r[i].z; w[3] = s.r[i].w; }
    LDS_WAIT(); asm volatile("" ::: "memory");
    const int c = lane & 7; const f32x4 one = {1.f, 1.f, 1.f, 1.f};
    const f32x4 g0 = s.hg ? s.r[8] : one, g1 = s.hg ? s.r[9] : one;
#pragma unroll
    for (int j = 0; j < 4; ++j) { const LAS float* t = scr + (8 * c) * 33 + (lane >> 3) + 8 * j;
        v4u o; o.x = pk2(t[0 * 33] * g0.x, t[1 * 33] * g0.y); o.y = pk2(t[2 * 33] * g0.z, t[3 * 33] * g0.w); o.z = pk2(t[4 * 33] * g1.x, t[5 * 33] * g1.y); o.w = pk2(t[6 * 33] * g1.z, t[7 * 33] * g1.w);
        *(TW_GAS v4u*)(s.dst + (size_t)(8 * j) * s.ldk) = o; }
    LDS_WAIT(); asm volatile("" ::: "memory");
}
struct TwJob { const float* W; bf16* WT; const float* gain; int N, ldk, mode, roff, start; };
__device__ __forceinline__ TwJob tw_job(const float* W, int N, bf16* WT, int ldk, int mode, int roff, const float* gain, int start) { TwJob j; j.W = W; j.WT = WT; j.gain = gain; j.N = N; j.ldk = ldk; j.mode = mode; j.roff = roff; j.start = start; return j; }
__device__ __forceinline__ void tw_table_put(LAS int* tb, int idx, const TwJob& j, int lane) {
    if (lane == 0) { LAS int* e = tb + 16 * idx; const unsigned long long w = (unsigned long long)j.W, t = (unsigned long long)j.WT, g = (unsigned long long)j.gain; const unsigned nblk = (unsigned)j.N / 32u;
        e[0] = (int)(unsigned)w; e[1] = (int)(unsigned)(w >> 32); e[2] = (int)(unsigned)t; e[3] = (int)(unsigned)(t >> 32); e[4] = (int)(unsigned)g; e[5] = (int)(unsigned)(g >> 32);
        e[6] = j.N; e[7] = j.ldk; e[8] = j.mode; e[9] = j.roff; e[10] = (int)nblk; e[11] = j.start; e[12] = (int)(0xFFFFFFFFu / nblk + 1u); }
}
template <int NJ>
__device__ __forceinline__ void tw_lookup(const LAS int* tb, const int (&st)[NJ], int q, TwDesc& d) {
    int seg = 0;
#pragma unroll
    for (int j = 1; j < NJ; ++j) seg += (q >= st[j]) ? 1 : 0;
    const LAS int* e = tb + 16 * seg;
#define TW_RF(i) __builtin_amdgcn_readfirstlane(e[i])
    const unsigned wl = TW_RF(0), wh = TW_RF(1), tl = TW_RF(2), th = TW_RF(3), gl = TW_RF(4), gh = TW_RF(5);
    d.W = (const float*)(((unsigned long long)wh << 32) | wl); d.WT = (bf16*)(((unsigned long long)th << 32) | tl); d.gain = (const float*)(((unsigned long long)gh << 32) | gl);
    d.N = TW_RF(6); d.ldk = TW_RF(7);
    const int mode = TW_RF(8), roff = TW_RF(9), nblk = TW_RF(10), start = TW_RF(11); const unsigned magic = TW_RF(12);
#undef TW_RF
    const int item = q - start, kb = (int)__umulhi((unsigned)item, magic), nb = item - kb * nblk;
    d.t = tw_item(kb, nb, mode, roff);
}
template <int NJ>
__device__ __forceinline__ void conv_pipe(const LAS int* tb, const int (&st)[NJ], int q_begin, int q_end, int gw2, int NGW2, LAS float* scr, int lane) {
    const int q0 = q_begin + gw2; if (q0 >= q_end) return;
    const int cnt = (q_end - 1 - q0) / NGW2 + 1;
    TwSet a, b, c, e; TwDesc d;
#define CP_LD(S, idx) { const int i_ = (idx); tw_lookup<NJ>(tb, st, i_ < cnt ? q0 + i_ * NGW2 : q_begin, d); tw_load4(S, d, lane); }
    CP_LD(a, 0) CP_LD(b, 1) CP_LD(c, 2)
    int j = 0;
    for (; j + 4 <= cnt; j += 4) {
        CP_LD(e, j + 3) tw_store4(a, scr, lane);
        CP_LD(a, j + 4) tw_store4(b, scr, lane);
        CP_LD(b, j + 5) tw_store4(c, scr, lane);
        CP_LD(c, j + 6) tw_store4(e, scr, lane);
    }
    const int rem = cnt - j;
    if (rem >= 1) tw_store4(a, scr, lane);
    if (rem >= 2) tw_store4(b, scr, lane);
    if (rem >= 3) tw_store4(c, scr, lane);
#undef CP_LD
}
constexpr int TW_TABLE = 2304;
template <bool OUT_F32>
__device__ __forceinline__ void rms_rows(const float* X, const float* w, void* out, int nrows, int gw, int NGW, int lane) {
    for (int m = gw; m < nrows; m += NGW) {
        const f32x4* xr = (const f32x4*)(X + (size_t)m * D) + lane;
        f32x4 v[16]; float s = 0.f;
#pragma unroll
        for (int j = 0; j < 16; ++j) { v[j] = xr[64 * j]; s += (v[j].x * v[j].x + v[j].y * v[j].y) + (v[j].z * v[j].z + v[j].w * v[j].w); }
        const float rstd = 1.0f / sqrtf(wave_sum(s) * (1.0f / D) + EPS);
        const f32x4* wr = (const f32x4*)w + lane;
        if (OUT_F32) { f32x4* o = (f32x4*)((float*)out + (size_t)m * D) + lane;
#pragma unroll
            for (int j = 0; j < 16; ++j) { const f32x4 g = wr[64 * j]; o[64 * j] = v[j] * rstd * g; }
        } else { unsigned long long* o8 = (unsigned long long*)((bf16*)out + (size_t)m * D) + lane;
#pragma unroll
            for (int j = 0; j < 16; ++j) { const f32x4 g = wr[64 * j]; const f32x4 y = v[j] * rstd * g;
                o8[64 * j] = (unsigned long long)pk2(y.x, y.y) | ((unsigned long long)pk2(y.z, y.w) << 32); } }
    }
}

__device__ __forceinline__ void final_norm(const bf16* HBp, const unsigned long long* ssq, const float* w, float* out, int gw, int NGW, int lane) {
    for (int m = gw; m < M; m += NGW) {
        const float rstd = 1.0f / sqrtf((float)ssq[m] * SSQ_INVK + EPS);
        const v4u* hr = (const v4u*)(HBp + (size_t)m * D) + lane; f32x4* o = (f32x4*)(out + (size_t)m * D) + 2 * lane; const f32x4* wr = (const f32x4*)w + 2 * lane;
#pragma unroll
        for (int j = 0; j < 8; ++j) { const v4u h = hr[64 * j]; const f32x4 g0 = wr[128 * j], g1 = wr[128 * j + 1];
            o[128 * j] = (f32x4){bfl(h.x), bfh(h.x), bfl(h.y), bfh(h.y)} * rstd * g0; o[128 * j + 1] = (f32x4){bfl(h.z), bfh(h.z), bfl(h.w), bfh(h.w)} * rstd * g1; }
    }
}

__device__ __forceinline__ void conv_branch_a(const bf16* proj, const float* conv_w, bf16* outA, int idx0, int idx1, int stride) {
    for (int idx = idx0; idx < idx1; idx += stride) {
        const int row = idx >> 8, c0 = (idx & 255) * 8, s = row & (SEQ - 1);
        float y[8];
#pragma unroll
        for (int e = 0; e < 8; ++e) y[e] = 0.f;
#pragma unroll
        for (int k = 0; k < 3; ++k) {
            const int sk = s - 2 + k; const float mk = (sk >= 0) ? 1.f : 0.f;
            const bf16* pr = proj + (size_t)(sk >= 0 ? row - 2 + k : row) * NPP;
            const v4u xc = *(const v4u*)(pr + OFF_CX + c0), cc = *(const v4u*)(pr + OFF_CC + c0);
            const f32x4 w0 = *(const f32x4*)(conv_w + k * CW + c0) * mk, w1 = *(const f32x4*)(conv_w + k * CW + c0 + 4) * mk;
            y[0] += w0.x * (bfl(xc.x) * bfl(cc.x)); y[1] += w0.y * (bfh(xc.x) * bfh(cc.x)); y[2] += w0.z * (bfl(xc.y) * bfl(cc.y)); y[3] += w0.w * (bfh(xc.y) * bfh(cc.y));
            y[4] += w1.x * (bfl(xc.z) * bfl(cc.z)); y[5] += w1.y * (bfh(xc.z) * bfh(cc.z)); y[6] += w1.z * (bfl(xc.w) * bfl(cc.w)); y[7] += w1.w * (bfh(xc.w) * bfh(cc.w));
        }
        const v4u cb = *(const v4u*)(proj + (size_t)row * NPP + OFF_CB + c0);
        v4u o; o.x = pk2(y[0] * bfl(cb.x), y[1] * bfh(cb.x)); o.y = pk2(y[2] * bfl(cb.y), y[3] * bfh(cb.y)); o.z = pk2(y[4] * bfl(cb.z), y[5] * bfh(cb.z)); o.w = pk2(y[6] * bfl(cb.w), y[7] * bfh(cb.w));
        *(v4u*)(outA + (size_t)row * CW + c0) = o;
    }
}

constexpr int XS = 136, LS = 68;
constexpr int CH_LDS = 3 * 64 * XS * 2 + 64 * LS * 4 + 4 * 64 * 4;
static_assert(2 * CH_LDS <= MISC_OFF, "two chunks per workgroup");
__device__ __forceinline__ void dn_chunk_pair(const bf16* proj, const float* AB, const unsigned long long* ssq, const float* qkv_w, const float* a_log, const float* dt_bias, unsigned char* ws, LAS unsigned char* lds, int pair, int tid, const float* conv_w, bf16* convA) {
    const int lane = tid & 63, wave = __builtin_amdgcn_readfirstlane(tid >> 6), half = wave >> 2, wv = wave & 3, th = tid & 255;
    const int cid = pair * 2 + half, bh = cid >> 5, n = cid & 31, b = bh >> 4, h = bh & 15;
    LAS unsigned char* hb = lds + half * CH_LDS;
    LAS bf16* Qb = (LAS bf16*)hb; LAS bf16* Kb = Qb + 64 * XS; LAS bf16* Vb = Kb + 64 * XS; LAS float* Lt = (LAS float*)(Vb + 64 * XS);
    LAS float* GC = Lt + 64 * LS; LAS float* BETA = GC + 64; LAS float* EGC = BETA + 64; LAS float* ETAIL = EGC + 64;
    const size_t rowb = (size_t)b * SEQ;
    bf16* WC = (bf16*)(ws + WS_WC) + (size_t)cid * 8192; float* UB = (float*)(ws + WS_UB) + (size_t)cid * 8192; bf16* QD = (bf16*)(ws + WS_QD) + (size_t)cid * 8192;
    bf16* KTT = (bf16*)(ws + WS_KTT) + (size_t)cid * 8192; bf16* AQK = (bf16*)(ws + WS_AQK) + (size_t)cid * 4096; float* GL = (float*)(ws + WS_GL);
    float egc_l, etail_l;
    {
        const size_t row = rowb + n * CH + lane;
        float al = 0.f, bl = 0.f;
#pragma unroll
        for (int q = 0; q < 4; ++q) { al += AB[(size_t)q * M * 32 + row * 32 + 16 + h]; bl += AB[(size_t)q * M * 32 + row * 32 + h]; }
        const float rs = 1.0f / sqrtf((float)ssq[row] * SSQ_INVK + EPS); al *= rs; bl *= rs;
        const float xx = al + dt_bias[h];
        const float sp = fmaxf(xx, 0.f) + log1pf(expf(-fabsf(xx)));
        float g = -expf(a_log[h]) * sp;
#pragma unroll
        for (int d = 1; d < 64; d <<= 1) { const float t = __shfl_up(g, d); if (lane >= d) g += t; }
        const float glast = __shfl(g, 63);
        egc_l = expf(g); etail_l = expf(glast - g);
        if (wv == 0) { GC[lane] = g; BETA[lane] = 1.0f / (1.0f + expf(-bl)); EGC[lane] = egc_l; ETAIL[lane] = etail_l; if (lane == 63) GL[cid] = expf(glast); }
    }
    {
        const int c0 = (th & 15) * 8, i0 = (th >> 4) * 4;
#pragma unroll
        for (int mat = 0; mat < 3; ++mat) {
            const int wcol = mat * DNW + h * HD + c0;
            f32x4 w[4][2];
#pragma unroll
            for (int j = 0; j < 4; ++j) { w[j][0] = *(const f32x4*)(qkv_w + j * (3 * DNW) + wcol); w[j][1] = *(const f32x4*)(qkv_w + j * (3 * DNW) + wcol + 4); }
            v4u raw[7];
#pragma unroll
            for (int t = 0; t < 7; ++t) { const int st = n * CH + i0 - 3 + t; raw[t] = *(const v4u*)(proj + (rowb + (st >= 0 ? st : 0)) * NPP + OFF_Q + wcol); if (st < 0) raw[t] = (v4u){0u, 0u, 0u, 0u}; }
            LAS bf16* X = (mat == 0) ? Qb : (mat == 1) ? Kb : Vb;
#pragma unroll
            for (int j4 = 0; j4 < 4; ++j4) {
                const int i = i0 + j4;
                f32x4 a0 = {0.f, 0.f, 0.f, 0.f}, a1 = {0.f, 0.f, 0.f, 0.f};
#pragma unroll
                for (int j = 0; j < 4; ++j) { const v4u r = raw[j4 + j];
                    a0.x += w[j][0].x * bfl(r.x); a0.y += w[j][0].y * bfh(r.x); a0.z += w[j][0].z * bfl(r.y); a0.w += w[j][0].w * bfh(r.y);
                    a1.x += w[j][1].x * bfl(r.z); a1.y += w[j][1].y * bfh(r.z); a1.z += w[j][1].z * bfl(r.w); a1.w += w[j][1].w * bfh(r.w); }
#pragma unroll
                for (int e = 0; e < 4; ++e) { a0[e] = a0[e] * sigm(a0[e]); a1[e] = a1[e] * sigm(a1[e]); }
                if (mat < 2) {
                    float ss = (a0.x * a0.x + a0.y * a0.y) + (a0.z * a0.z + a0.w * a0.w) + (a1.x * a1.x + a1.y * a1.y) + (a1.z * a1.z + a1.w * a1.w);
                    ss += __shfl_xor(ss, 1); ss += __shfl_xor(ss, 2); ss += __shfl_xor(ss, 4); ss += __shfl_xor(ss, 8);
                    float sc = 1.0f / sqrtf(ss + EPS); if (mat == 0) sc *= 0.08838834764831845f;
                    a0 = a0 * sc; a1 = a1 * sc;
                }
                v4u o; o.x = pk2(a0.x, a0.y); o.y = pk2(a0.z, a0.w); o.z = pk2(a1.x, a1.y); o.w = pk2(a1.z, a1.w);
                *(LAS v4u*)(X + i * XS + c0) = o;
                if (mat == 0) { const float eg = __shfl(egc_l, i); a0 = a0 * eg; a1 = a1 * eg;
                    v4u q; q.x = pk2(a0.x, a0.y); q.y = pk2(a0.z, a0.w); q.z = pk2(a1.x, a1.y); q.w = pk2(a1.z, a1.w); *(v4u*)(QD + i * 128 + c0) = q; }
            }
        }
    }
    __syncthreads();
    {
        const int r = lane & 15, kq = lane >> 4;
        for (int job = wv; job < 26; job += 4) {
            int prod, it, jt;
            if (job < 10) { prod = 0; it = (job >= 6) ? 3 : (job >= 3) ? 2 : (job >= 1) ? 1 : 0; jt = job - (it * (it + 1)) / 2; }
            else { prod = 1; it = (job - 10) >> 2; jt = (job - 10) & 3; }
            f32x4 acc = {0.f, 0.f, 0.f, 0.f};
            if (jt <= it) {
                const LAS bf16* Ab = (prod ? Qb : Kb) + (16 * it + r) * XS + 8 * kq; const LAS bf16* Bb = Kb + (16 * jt + r) * XS + 8 * kq;
#pragma unroll
                for (int ks = 0; ks < 4; ++ks) acc = __builtin_amdgcn_mfma_f32_16x16x32_bf16(*(const LAS bf16x8*)(Ab + 32 * ks), *(const LAS bf16x8*)(Bb + 32 * ks), acc, 0, 0, 0);
            }
            const int jx = 16 * jt + r; const float gcj = GC[jx];
            f32x4 o;
#pragma unroll
            for (int reg = 0; reg < 4; ++reg) { const int ix = 16 * it + 4 * kq + reg; const float dec = expf(GC[ix] - gcj);
                if (prod == 0) o[reg] = (ix > jx) ? BETA[ix] * acc[reg] * dec : 0.f;
                else o[reg] = (ix >= jx) ? acc[reg] * dec : 0.f; }
            if (prod == 0) *(LAS f32x4*)(Lt + jx * LS + 16 * it + 4 * kq) = o;
            else {
#pragma unroll
                for (int reg = 0; reg < 4; ++reg) AQK[(16 * it + 4 * kq + reg) * 64 + jx] = (bf16)f2bf(o[reg]); }
        }
    }
    __syncthreads();
    constexpr int TS = 68;
    LAS bf16* Tv = Qb; LAS bf16* Tk = Qb + 64 * TS;
    if (wv == half) {
        int zv = 0; asm volatile("" : "+v"(zv));
        const LAS float* LtV = Lt + zv;
        float x[64];
#pragma unroll
        for (int i = 0; i < 64; ++i) x[i] = (i == lane) ? 1.0f : 0.0f;
        f32x4 lr[16];
#define DN_FMAQ(J, Q) { _Pragma("unroll") for (int ii = 4 * (Q); ii < 4 * (Q) + 4; ++ii) { if (ii >= (((J) + 1) >> 2)) { _Pragma("unroll") for (int e = 0; e < 4; ++e) { if (4 * ii + e > (J)) x[4 * ii + e] -= lr[ii][e] * xj; } } } }
#define DN_LDQ(J, Q) { _Pragma("unroll") for (int ii = 4 * (Q); ii < 4 * (Q) + 4; ++ii) { if ((J) < 63 && ii >= (((J) + 1) >> 2)) lr[ii] = *(const LAS f32x4*)(LtV + (J) * LS + 4 * ii); } __builtin_amdgcn_sched_barrier(0); }
#define DN_ROW(J) { const float xj = x[J]; DN_FMAQ(J, 0) DN_LDQ((J) + 1, 0) DN_FMAQ(J, 1) DN_LDQ((J) + 1, 1) DN_FMAQ(J, 2) DN_LDQ((J) + 1, 2) DN_FMAQ(J, 3) DN_LDQ((J) + 1, 3) }
        DN_LDQ(0, 0) DN_LDQ(0, 1) DN_LDQ(0, 2) DN_LDQ(0, 3)
        DN_ROW(0)
        DN_ROW(1)
        DN_ROW(2)
        DN_ROW(3)
        DN_ROW(4)
        DN_ROW(5)
        DN_ROW(6)
        DN_ROW(7)
        DN_ROW(8)
        DN_ROW(9)
        DN_ROW(10)
        DN_ROW(11)
        DN_ROW(12)
        DN_ROW(13)
        DN_ROW(14)
        DN_ROW(15)
        DN_ROW(16)
        DN_ROW(17)
        DN_ROW(18)
        DN_ROW(19)
        DN_ROW(20)
        DN_ROW(21)
        DN_ROW(22)
        DN_ROW(23)
        DN_ROW(24)
        DN_ROW(25)
        DN_ROW(26)
        DN_ROW(27)
        DN_ROW(28)
        DN_ROW(29)
        DN_ROW(30)
        DN_ROW(31)
        DN_ROW(32)
        DN_ROW(33)
        DN_ROW(34)
        DN_ROW(35)
        DN_ROW(36)
        DN_ROW(37)
        DN_ROW(38)
        DN_ROW(39)
        DN_ROW(40)
        DN_ROW(41)
        DN_ROW(42)
        DN_ROW(43)
        DN_ROW(44)
        DN_ROW(45)
        DN_ROW(46)
        DN_ROW(47)
        DN_ROW(48)
        DN_ROW(49)
        DN_ROW(50)
        DN_ROW(51)
        DN_ROW(52)
        DN_ROW(53)
        DN_ROW(54)
        DN_ROW(55)
        DN_ROW(56)
        DN_ROW(57)
        DN_ROW(58)
        DN_ROW(59)
        DN_ROW(60)
        DN_ROW(61)
        DN_ROW(62)
#undef DN_FMAQ
#undef DN_LDQ
#undef DN_ROW
        const float bv = BETA[lane], bk = bv * EGC[lane];
#pragma unroll
        for (int i = 0; i < 64; ++i) { Tv[i * TS + lane] = (bf16)f2bf(x[i] * bv); Tk[i * TS + lane] = (bf16)f2bf(x[i] * bk); }
    } else {
        const int w3 = (wv > half) ? wv - 1 : wv; const float et = etail_l; const int i = lane;
#pragma unroll 4
        for (int d = w3; d < 128; d += 3) KTT[d * 64 + i] = (bf16)f2bf(bf1(Kb[i * XS + d]) * et);
        conv_branch_a(proj, conv_w, convA, pair * 2048 + (half * 3 + w3) * 64 + lane, (pair + 1) * 2048, 384);
    }
    __syncthreads();
    {
        typedef short v4i16_t __attribute__((ext_vector_type(4)));
        const int r = lane & 15, kq = lane >> 4, q4 = r >> 2, p4 = r & 3;
        bf16x8 av[2], ak[2];
#pragma unroll
        for (int ks = 0; ks < 2; ++ks) { const LAS unsigned long long* pv = (const LAS unsigned long long*)(Tv + (16 * wv + r) * TS + 32 * ks + 8 * kq); const LAS unsigned long long* pk = (const LAS unsigned long long*)(Tk + (16 * wv + r) * TS + 32 * ks + 8 * kq);
            const unsigned long long v0 = pv[0], v1 = pv[1], k0 = pk[0], k1 = pk[1];
            v4u wv4; wv4.x = (unsigned)v0; wv4.y = (unsigned)(v0 >> 32); wv4.z = (unsigned)v1; wv4.w = (unsigned)(v1 >> 32); av[ks] = __builtin_bit_cast(bf16x8, wv4);
            v4u wk4; wk4.x = (unsigned)k0; wk4.y = (unsigned)(k0 >> 32); wk4.z = (unsigned)k1; wk4.w = (unsigned)(k1 >> 32); ak[ks] = __builtin_bit_cast(bf16x8, wk4); }
#pragma unroll
        for (int part = 0; part < 2; ++part) {
            const LAS bf16* Bsrc = part ? Kb : Vb;
#pragma unroll
            for (int ct = 0; ct < 8; ++ct) {
                f32x4 acc = {0.f, 0.f, 0.f, 0.f};
#pragma unroll
                for (int ks = 0; ks < 2; ++ks) {
                    const LAS bf16* bp = Bsrc + (32 * ks + 8 * kq + q4) * XS + 16 * ct + 4 * p4;
                    const v4i16_t t0 = __builtin_amdgcn_ds_read_tr16_b64_v4i16((LAS v4i16_t*)bp), t1 = __builtin_amdgcn_ds_read_tr16_b64_v4i16((LAS v4i16_t*)(bp + 4 * XS));
                    bf16x8 bfrag; bfrag[0] = t0[0]; bfrag[1] = t0[1]; bfrag[2] = t0[2]; bfrag[3] = t0[3]; bfrag[4] = t1[0]; bfrag[5] = t1[1]; bfrag[6] = t1[2]; bfrag[7] = t1[3];
                    acc = __builtin_amdgcn_mfma_f32_16x16x32_bf16(bfrag, part ? ak[ks] : av[ks], acc, 0, 0, 0);
                }
                const int o = (16 * wv + r) * 128 + 16 * ct + 4 * kq;
                if (part == 0) *(f32x4*)(UB + o) = acc;
                else *(unsigned long long*)(WC + o) = (unsigned long long)pk2(-acc.x, -acc.y) | ((unsigned long long)pk2(-acc.z, -acc.w) << 32);
            }
        }
    }
    __syncthreads();
}

constexpr int SSB = 136, USB = 72;
#define LDS_BARRIER() do { asm volatile("s_waitcnt lgkmcnt(0)" ::: "memory"); __builtin_amdgcn_s_barrier(); asm volatile("" ::: "memory"); } while (0)
__device__ __forceinline__ unsigned long long pk4(const f32x4 v) { return (unsigned long long)pk2(v.x, v.y) | ((unsigned long long)pk2(v.z, v.w) << 32); }
struct ScanOps { bf16x8 wcf[4], qdf[4], aqf[2], ktf[2]; f32x4 ubv; };
struct SideJob { const float* Wg; const float* Wu; const float* Wd; bf16* Tgu; bf16* Td; const float* gain; LAS float* scr; int q0; };
constexpr int SIDE_IG = (D / 64) * (FF / 32);
__device__ __forceinline__ void side_desc(const SideJob& J, int q, TwDesc& d) {
    if (q < SIDE_IG) { d.W = J.Wg; d.N = FF; d.WT = J.Tgu; d.ldk = D; d.gain = J.gain; d.t = tw_item(q / (FF / 32), q % (FF / 32), 1, 0); }
    else if (q < 2 * SIDE_IG) { const int i = q - SIDE_IG; d.W = J.Wu; d.N = FF; d.WT = J.Tgu; d.ldk = D; d.gain = J.gain; d.t = tw_item(i / (FF / 32), i % (FF / 32), 2, 0); }
    else { const int i = q - 2 * SIDE_IG; d.W = J.Wd; d.N = D; d.WT = J.Td; d.ldk = FF; d.gain = nullptr; d.t = tw_item(i / (D / 32), i % (D / 32), 0, 0); }
}
constexpr int SIDE_SCAN_STEPS = 24, SIDE_ITEMS = 2048 * SIDE_SCAN_STEPS;
struct ScanPtrs { const bf16* WCb; const bf16* QDb; const bf16* KTb; const bf16* AQb; const float* UBb; const float* GLb; int offW, offA, offK, offU; };
__device__ __forceinline__ void scan_load_a(ScanOps& o, const ScanPtrs& p, int n) {
#pragma unroll
    for (int ks = 0; ks < 4; ++ks) { o.wcf[ks] = *(const bf16x8*)(p.WCb + (size_t)n * 8192 + p.offW + 32 * ks); o.qdf[ks] = *(const bf16x8*)(p.QDb + (size_t)n * 8192 + p.offW + 32 * ks); }
#pragma unroll
    for (int reg = 0; reg < 4; ++reg) o.ubv[reg] = p.UBb[(size_t)n * 8192 + p.offU + reg * 128];
}
__device__ __forceinline__ void scan_load_b(ScanOps& o, const ScanPtrs& p, int n) {
#pragma unroll
    for (int ks = 0; ks < 2; ++ks) { o.aqf[ks] = *(const bf16x8*)(p.AQb + (size_t)n * 4096 + p.offA + 32 * ks); o.ktf[ks] = *(const bf16x8*)(p.KTb + (size_t)n * 8192 + p.offK + 32 * ks); }
}
__device__ __forceinline__ void scan_step(const ScanOps& cur, ScanOps& nxt, const ScanPtrs& p, LAS bf16* St, LAS bf16* Ut, f32x4& s0, f32x4& s1, float* orow, float gl, int nn, int r, int kq, int rt, int ct, int wave,
                                          const SideJob& J, const TwSet& sc_cur, TwSet& sc_nxt, int qcur, int qnxt, int lane) {
    f32x4 accU = cur.ubv, accO = {0.f, 0.f, 0.f, 0.f};
    const LAS bf16* srow = St + (16 * ct + r) * SSB + 8 * kq;
#pragma unroll
    for (int ks = 0; ks < 4; ++ks) { const bf16x8 sf = *(const LAS bf16x8*)(srow + 32 * ks);
        accU = __builtin_amdgcn_mfma_f32_16x16x32_bf16(cur.wcf[ks], sf, accU, 0, 0, 0); accO = __builtin_amdgcn_mfma_f32_16x16x32_bf16(cur.qdf[ks], sf, accO, 0, 0, 0); }
    *(LAS unsigned long long*)(Ut + (16 * ct + r) * USB + 16 * rt + 4 * kq) = pk4(accU);
    scan_load_a(nxt, p, nn);
    if (qnxt >= 0) { TwDesc d; side_desc(J, qnxt, d); tw_load4(sc_nxt, d, lane); }
    LDS_BARRIER();
    const LAS bf16* urow = Ut + (16 * ct + r) * USB + 8 * kq;
#pragma unroll
    for (int ks = 0; ks < 2; ++ks) { const bf16x8 uf = *(const LAS bf16x8*)(urow + 32 * ks); accO = __builtin_amdgcn_mfma_f32_16x16x32_bf16(cur.aqf[ks], uf, accO, 0, 0, 0); }
#pragma unroll
    for (int reg = 0; reg < 4; ++reg) orow[(size_t)reg * DNW] = accO[reg];
    s0 = s0 * gl; s1 = s1 * gl;
    const LAS bf16* u0 = Ut + r * USB + 8 * kq; const LAS bf16* u1 = Ut + (16 + r) * USB + 8 * kq;
#pragma unroll
    for (int ks = 0; ks < 2; ++ks) { const bf16x8 a8 = *(const LAS bf16x8*)(u0 + 32 * ks), b8 = *(const LAS bf16x8*)(u1 + 32 * ks);
        s0 = __builtin_amdgcn_mfma_f32_16x16x32_bf16(cur.ktf[ks], a8, s0, 0, 0, 0); s1 = __builtin_amdgcn_mfma_f32_16x16x32_bf16(cur.ktf[ks], b8, s1, 0, 0, 0); }
    scan_load_b(nxt, p, nn);
    if (qcur >= 0) tw_store4(sc_cur, J.scr, lane);
    *(LAS unsigned long long*)(St + r * SSB + 16 * wave + 4 * kq) = pk4(s0); *(LAS unsigned long long*)(St + (16 + r) * SSB + 16 * wave + 4 * kq) = pk4(s1);
    LDS_BARRIER();
}
__device__ __forceinline__ void dn_scan_unit(unsigned char* ws, LAS unsigned char* lds, float* O, int unit, int tid, SideJob J) {
    const int lane = tid & 63, wave = __builtin_amdgcn_readfirstlane(tid >> 6), r = lane & 15, kq = lane >> 4;
    const int bh = unit >> 2, vs = unit & 3, b = bh >> 4, h = bh & 15;
    const int rt = wave >> 1, ct = wave & 1;
    LAS bf16* St = (LAS bf16*)lds; LAS bf16* Ut = St + 32 * SSB;
    { int tz = tid; asm volatile("" : "+v"(tz));
      for (int i = tz; i < 32 * SSB / 2; i += NTHREADS) ((LAS unsigned*)St)[i] = 0u; }
    f32x4 s0 = {0.f, 0.f, 0.f, 0.f}, s1 = {0.f, 0.f, 0.f, 0.f};
    ScanPtrs p;
    p.offW = (16 * rt + r) * 128 + 8 * kq; p.offA = (16 * rt + r) * 64 + 8 * kq; p.offK = (16 * wave + r) * 64 + 8 * kq; p.offU = (16 * rt + 4 * kq) * 128 + vs * 32 + 16 * ct + r;
    p.WCb = (const bf16*)(ws + WS_WC) + (size_t)bh * NCH * 8192; p.UBb = (const float*)(ws + WS_UB) + (size_t)bh * NCH * 8192; p.QDb = (const bf16*)(ws + WS_QD) + (size_t)bh * NCH * 8192;
    p.KTb = (const bf16*)(ws + WS_KTT) + (size_t)bh * NCH * 8192; p.AQb = (const bf16*)(ws + WS_AQK) + (size_t)bh * NCH * 4096; p.GLb = (const float*)(ws + WS_GL) + (size_t)bh * NCH;
    ScanOps A, B;
    scan_load_a(A, p, 0); scan_load_b(A, p, 0);
    TwSet scA, scB;
    J.scr = (LAS float*)(lds + 16384 + wave * 8704);
    { TwDesc d; side_desc(J, J.q0, d); tw_load4(scA, d, lane); }
    const int glall = __float_as_int(p.GLb[lane & 31]);
    LDS_BARRIER();
    float* orow = O + ((size_t)b * SEQ + 16 * rt + 4 * kq) * DNW + h * HD + vs * 32 + 16 * ct + r;
#pragma unroll
    for (int n = 0; n < NCH; n += 2) {
        scan_step(A, B, p, St, Ut, s0, s1, orow + (size_t)n * CH * DNW, __int_as_float(__builtin_amdgcn_readlane(glall, n)), n + 1, r, kq, rt, ct, wave, J, scA, scB, (n < SIDE_SCAN_STEPS) ? J.q0 + n : -1, (n + 1 < SIDE_SCAN_STEPS) ? J.q0 + n + 1 : -1, lane);
        scan_step(B, A, p, St, Ut, s0, s1, orow + (size_t)(n + 1) * CH * DNW, __int_as_float(__builtin_amdgcn_readlane(glall, n + 1)), (n + 2 < NCH) ? n + 2 : n + 1, r, kq, rt, ct, wave, J, scB, scA, (n + 1 < SIDE_SCAN_STEPS) ? J.q0 + n + 1 : -1, (n + 2 < SIDE_SCAN_STEPS) ? J.q0 + n + 2 : -1, lane);
    }
    __syncthreads();
}

__device__ __forceinline__ void ab_logits(const bf16* XN, const bf16* Wab, float* ABP, int job, int lane) {
    const int r = lane & 15, kq = lane >> 4, tile = job >> 2, q = job & 3;
    const bf16* ap = XN + (size_t)(16 * tile + r) * D + q * (D / 4) + 8 * kq; const bf16* b0p = Wab + (size_t)r * D + q * (D / 4) + 8 * kq; const bf16* b1p = b0p + (size_t)16 * D;
    f32x4 acc0 = {0.f, 0.f, 0.f, 0.f}, acc1 = {0.f, 0.f, 0.f, 0.f};
#pragma unroll 16
    for (int ks = 0; ks < D / 128; ++ks) { const bf16x8 a = *(const bf16x8*)(ap + 32 * ks), b0 = *(const bf16x8*)(b0p + 32 * ks), b1 = *(const bf16x8*)(b1p + 32 * ks);
        acc0 = __builtin_amdgcn_mfma_f32_16x16x32_bf16(a, b0, acc0, 0, 0, 0); acc1 = __builtin_amdgcn_mfma_f32_16x16x32_bf16(a, b1, acc1, 0, 0, 0); }
    float* o = ABP + (size_t)q * M * 32 + (size_t)(16 * tile + 4 * kq) * 32 + r;
#pragma unroll
    for (int reg = 0; reg < 4; ++reg) { o[reg * 32] = acc0[reg]; o[reg * 32 + 16] = acc1[reg]; }
}

__device__ __forceinline__ void dn_gated_norm(const float* O, const bf16* proj, const float* wn, bf16* ON, int gtid, int NT) {
    for (int idx = gtid; idx < M * NH * 16; idx += NT) {
        const int pair = idx >> 4, sub = idx & 15, row = pair >> 4, h = pair & 15, c = h * HD + sub * 8;
        const f32x4 o0 = *(const f32x4*)(O + (size_t)row * DNW + c), o1 = *(const f32x4*)(O + (size_t)row * DNW + c + 4);
        float ss = (o0.x * o0.x + o0.y * o0.y) + (o0.z * o0.z + o0.w * o0.w) + (o1.x * o1.x + o1.y * o1.y) + (o1.z * o1.z + o1.w * o1.w);
        ss += __shfl_xor(ss, 1); ss += __shfl_xor(ss, 2); ss += __shfl_xor(ss, 4); ss += __shfl_xor(ss, 8);
        const float rstd = 1.0f / sqrtf(ss * (1.0f / HD) + EPS);
        const v4u z = *(const v4u*)(proj + (size_t)row * NPP + OFF_Z + c);
        const f32x4 w0 = *(const f32x4*)(wn + sub * 8), w1 = *(const f32x4*)(wn + sub * 8 + 4);
        const float z0 = bfl(z.x), z1 = bfh(z.x), z2 = bfl(z.y), z3 = bfh(z.y), z4 = bfl(z.z), z5 = bfh(z.z), z6 = bfl(z.w), z7 = bfh(z.w);
        v4u o; o.x = pk2(o0.x * rstd * w0.x * (z0 * sigm(z0)), o0.y * rstd * w0.y * (z1 * sigm(z1))); o.y = pk2(o0.z * rstd * w0.z * (z2 * sigm(z2)), o0.w * rstd * w0.w * (z3 * sigm(z3)));
        o.z = pk2(o1.x * rstd * w1.x * (z4 * sigm(z4)), o1.y * rstd * w1.y * (z5 * sigm(z5))); o.w = pk2(o1.z * rstd * w1.z * (z6 * sigm(z6)), o1.w * rstd * w1.w * (z7 * sigm(z7)));
        *(v4u*)(ON + (size_t)row * DNW + c) = o;
    }
}

__device__ __forceinline__ void xattn_unit(const float* QP, const unsigned long long* ssq, const bf16* KB, const bf16* VT, bf16* XO, LAS unsigned char* lds, int unit, int tid) {
    const int lane = tid & 63, wave = __builtin_amdgcn_readfirstlane(tid >> 6), r = lane & 15, kq = lane >> 4;
    const int b = unit >> 6, hd = (unit >> 4) & 3, qt = unit & 15;
    LAS unsigned char* Ksm = lds; LAS unsigned char* Vtm = lds + 256 * 272;
    {
        const int seg = tid & 15, rr = tid >> 4;
#pragma unroll
        for (int p = 0; p < 8; ++p) { const int key = rr + 32 * p; const v4u v = *(const v4u*)(KB + (size_t)(b * MEMT + key) * XW + hd * HD + seg * 8); *(LAS v4u*)(Ksm + key * 272 + seg * 16) = v; }
        const int seg2 = tid & 31, r2 = tid >> 5;
#pragma unroll
        for (int p = 0; p < 8; ++p) { const int d = r2 + 16 * p; const v4u v = *(const v4u*)(VT + ((size_t)(b * 4 + hd) * HD + d) * MEMT + seg2 * 8); *(LAS v4u*)(Vtm + d * 528 + seg2 * 16) = v; }
    }
    const size_t qrow = (size_t)b * SEQ + qt * 128 + wave * 16 + r;
    bf16x8 qf[4];
    const float qs = 0.08838834764831845f * 1.4426950408889634f / sqrtf((float)ssq[qrow] * SSQ_INVK + EPS);
#pragma unroll
    for (int ks = 0; ks < 4; ++ks) { const float* qp = QP + qrow * XW + hd * HD + 32 * ks + 8 * kq; f32x4 a = {0.f, 0.f, 0.f, 0.f}, c = {0.f, 0.f, 0.f, 0.f};
#pragma unroll
        for (int g = 0; g < 4; ++g) { a += *(const f32x4*)(qp + (size_t)g * M * XW); c += *(const f32x4*)(qp + (size_t)g * M * XW + 4); }
        a = a * qs; c = c * qs;
        v4u w; w.x = pk2(a.x, a.y); w.y = pk2(a.z, a.w); w.z = pk2(c.x, c.y); w.w = pk2(c.z, c.w); qf[ks] = __builtin_bit_cast(bf16x8, w); }
    __syncthreads();
    f32x4 sc[16];
#pragma unroll
    for (int t = 0; t < 16; ++t) { sc[t] = (f32x4){0.f, 0.f, 0.f, 0.f};
#pragma unroll
        for (int ks = 0; ks < 4; ++ks) { const bf16x8 kf = *(const LAS bf16x8*)(Ksm + (16 * t + r) * 272 + (32 * ks + 8 * kq) * 2);
            sc[t] = __builtin_amdgcn_mfma_f32_16x16x32_bf16(kf, qf[ks], sc[t], 0, 0, 0); } }
    float mx = -3.0e38f;
#pragma unroll
    for (int t = 0; t < 16; ++t) mx = fmaxf(mx, fmaxf(fmaxf(sc[t].x, sc[t].y), fmaxf(sc[t].z, sc[t].w)));
    mx = fmaxf(mx, __shfl_xor(mx, 16)); mx = fmaxf(mx, __shfl_xor(mx, 32));
    float sum = 0.f;
#pragma unroll
    for (int t = 0; t < 16; ++t) {
#pragma unroll
        for (int e = 0; e < 4; ++e) { sc[t][e] = __builtin_amdgcn_exp2f(sc[t][e] - mx); sum += sc[t][e]; } }
    sum += __shfl_xor(sum, 16); sum += __shfl_xor(sum, 32);
    const float inv = 1.0f / sum;
    bf16x8 pf[8];
#pragma unroll
    for (int s = 0; s < 8; ++s) { v4u w; w.x = pk2(sc[2 * s].x, sc[2 * s].y); w.y = pk2(sc[2 * s].z, sc[2 * s].w); w.z = pk2(sc[2 * s + 1].x, sc[2 * s + 1].y); w.w = pk2(sc[2 * s + 1].z, sc[2 * s + 1].w);
        pf[s] = __builtin_bit_cast(bf16x8, w); }
#pragma unroll
    for (int dt = 0; dt < 8; ++dt) { f32x4 o = {0.f, 0.f, 0.f, 0.f};
#pragma unroll
        for (int s = 0; s < 8; ++s) { const LAS unsigned char* vp = Vtm + (16 * dt + r) * 528 + (32 * s + 4 * kq) * 2;
            const unsigned long long lo = *(const LAS unsigned long long*)vp, hi = *(const LAS unsigned long long*)(vp + 32);
            v4u w; w.x = (unsigned)lo; w.y = (unsigned)(lo >> 32); w.z = (unsigned)hi; w.w = (unsigned)(hi >> 32);
            o = __builtin_amdgcn_mfma_f32_16x16x32_bf16(__builtin_bit_cast(bf16x8, w), pf[s], o, 0, 0, 0); }
        o = o * inv;
        *(unsigned long long*)(XO + qrow * XW + hd * HD + 16 * dt + 4 * kq) = (unsigned long long)pk2(o.x, o.y) | ((unsigned long long)pk2(o.z, o.w) << 32); }
    __syncthreads();
}

struct Args { const float* in[27]; float* out; unsigned char* ws; int ph_lo, ph_hi; };
enum { I_X = 0, I_MEM, I_F1N, I_F1G, I_F1U, I_F1D, I_MIXN, I_WIN, I_CONVW, I_QKVW, I_ALOG, I_DTB, I_DNN, I_WOC, I_WOD, I_WO, I_XAN, I_MEMN, I_XWQ, I_XWK, I_XWV, I_XWO, I_F2N, I_F2G, I_F2U, I_F2D, I_FINN };

typedef const __attribute__((address_space(4))) Args* KArgs;
__device__ __forceinline__ KArgs kargs() { KArgs p = (KArgs)__builtin_amdgcn_kernarg_segment_ptr(); asm volatile("" : "+s"(p)); return p; }
#define PH_BEGIN KArgs A = kargs(); unsigned char* const ws = A->ws; (void)ws;
#define W1GU ((bf16*)(ws + WS_W1GU))
#define W1D ((bf16*)(ws + WS_W1D))
#define W2GU ((bf16*)(ws + WS_W2GU))
#define W2D ((bf16*)(ws + WS_W2D))
#define WIN ((bf16*)(ws + WS_WIN))
#define WA ((bf16*)(ws + WS_WA))
#define WB ((bf16*)(ws + WS_WB))
#define WO ((bf16*)(ws + WS_WO))
#define WQ ((bf16*)(ws + WS_WQ))
#define WKV ((bf16*)(ws + WS_WKV))
#define WXO ((bf16*)(ws + WS_WXO))
#define XN ((bf16*)(ws + WS_XN))
#define ACT ((bf16*)(ws + WS_R))
#define PROJ ((bf16*)(ws + WS_R))
#define MN ((bf16*)(ws + WS_MN))
#define KB ((bf16*)(ws + WS_KB))
#define VT ((bf16*)(ws + WS_VT))
#define OB ((float*)(ws + WS_O))
#define CONVA ((bf16*)(ws + WS_CONVA))
#define ON ((bf16*)(ws + WS_ON))
#define QP ((float*)(ws + WS_QP))
#define AB ((float*)(ws + WS_AB))
#define HB ((bf16*)(ws + WS_XNB))
#define SSQ(i) ((unsigned long long*)(ws + WS_SSQ) + (i) * M)
#define XO ((bf16*)(ws + WS_XO))
#define H (A->out)
#define INP(i) (A->in[i])
__global__ void __launch_bounds__(NTHREADS, 2) fwd_kernel(Args args) {
    extern __shared__ __attribute__((aligned(16))) unsigned char lds_raw[];
    LAS unsigned char* lds = (LAS unsigned char*)lds_raw;
    volatile LAS unsigned* MISC = (volatile LAS unsigned*)(lds + MISC_OFF);
    const int tid = threadIdx.x, lane = tid & 63, wave = __builtin_amdgcn_readfirstlane(tid >> 6);
    const int G = gridDim.x, bx = blockIdx.x;
    const int vcu = (G % 8 == 0) ? (bx % 8) * (G / 8) + bx / 8 : bx;
    const int gw = vcu * NWAVES + wave, NGW = G * NWAVES, gtid = vcu * NTHREADS + tid, NT = G * NTHREADS;
    gu32* ctl = (gu32*)(args.ws + WS_CTL);
    for (int u = tid; u < (LDS_BYTES - MISC_OFF) / 4; u += NTHREADS) ((LAS unsigned*)(lds + MISC_OFF))[u] = 0u;
    __syncthreads();
    XcdBarrier bar; bar.bar = (unsigned*)(ctl + CW_BAR); bar.x = 0; bar.st = nullptr;
    const int lo = args.ph_lo, hi = args.ph_hi;
    if (hi - lo > 1) bar = xcd_barrier_post((unsigned*)(ctl + CW_BAR), MISC + 8);
#define IN(k) (lo <= (k) && (k) < hi)
#define SEAM(k) do { if (IN(k) && IN((k) + 1)) xcd_barrier(bar); } while (0)
    if (IN(0)) for (int rep_ = 0; rep_ < (PROBE_PHASE == 0 ? PROBE_REPS : 1); ++rep_) { PH_BEGIN
        LAS float* scr = (LAS float*)(lds + wave * 16384); LAS int* tb = (LAS int*)(scr + TW_TABLE);
        constexpr int IW1D = (FF / 64) * (D / 32), IWIN = (D / 64) * (NPROJ / 32), IXW = (D / 64) * (XW / 32), IXO = (XW / 64) * (D / 32), IGU = (D / 64) * (FF / 32);
        constexpr int st[8] = {0, IW1D, IW1D + IWIN, IW1D + IWIN + IXW, IW1D + IWIN + 2 * IXW, IW1D + IWIN + 3 * IXW, IW1D + IWIN + 3 * IXW + IXO, IW1D + IWIN + 3 * IXW + IXO + IGU};
        tw_table_put(tb, 0, tw_job(INP(I_F1D), D, W1D, FF, 0, 0, nullptr, st[0]), lane);
        tw_table_put(tb, 1, tw_job(INP(I_WIN), NPROJ, WIN, D, 3, 0, INP(I_MIXN), st[1]), lane);
        tw_table_put(tb, 2, tw_job(INP(I_XWQ), XW, WQ, D, 0, 0, INP(I_XAN), st[2]), lane);
        tw_table_put(tb, 3, tw_job(INP(I_XWK), XW, WKV, D, 0, 0, nullptr, st[3]), lane);
        tw_table_put(tb, 4, tw_job(INP(I_XWV), XW, WKV, D, 0, XW, nullptr, st[4]), lane);
        tw_table_put(tb, 5, tw_job(INP(I_XWO), D, WXO, XW, 0, 0, nullptr, st[5]), lane);
        tw_table_put(tb, 6, tw_job(INP(I_F1G), FF, W1GU, D, 1, 0, nullptr, st[6]), lane);
        tw_table_put(tb, 7, tw_job(INP(I_F1U), FF, W1GU, D, 2, 0, nullptr, st[7]), lane);
        LDS_WAIT();
        conv_pipe<8>(tb, st, 0, st[7] + IGU, gw, NGW, scr, lane);
        rms_rows<false>(INP(I_X), INP(I_F1N), XN, M, gw, NGW, lane);
        rms_rows<false>(INP(I_MEM), INP(I_MEMN), MN, BATCH * MEMT, gw, NGW, lane);
    }
    SEAM(0);
    if (IN(1)) for (int rep_ = 0; rep_ < (PROBE_PHASE == 1 ? PROBE_REPS : 1); ++rep_) { PH_BEGIN
        pg8::Gemm g{XN, W1GU, M, 2 * FF, D, D, D}; pg8::OrderFfnKv S; S.init(M, 2 * FF, G, bx); S.A1 = MN; S.B1 = WKV;
        pg8::EpiSwiGLUKV E{{ACT, FF, nullptr, 0.f, 0.f}, {KB, VT}};
        pg8::gemm_phase<pg8::EpiSwiGLUKV, pg8::OrderFfnKv, true, true>(lds, g, S, E);
        const int rounds = (S.nwg + 16 + G - 1) / G, first_idle = S.nwg + 16 - (rounds - 1) * G;
        if (first_idle >= G || bx >= first_idle) { const bool part = first_idle < G;
            const int gw2 = part ? (bx - first_idle) * NWAVES + wave : gw, NGW2 = part ? (G - first_idle) * NWAVES : NGW;
            LAS float* scr = (LAS float*)(lds + wave * 16384); LAS int* tb = (LAS int*)(scr + TW_TABLE);
            constexpr int IA = (CW / 64) * (D / 32), IB = (DNW / 64) * (D / 32), IO = (D / 64) * (D / 32);
            constexpr int st[3] = {0, IA, IA + IB};
            tw_table_put(tb, 0, tw_job(INP(I_WOC), D, WA, CW, 0, 0, nullptr, st[0]), lane);
            tw_table_put(tb, 1, tw_job(INP(I_WOD), D, WB, DNW, 0, 0, nullptr, st[1]), lane);
            tw_table_put(tb, 2, tw_job(INP(I_WO), D, WO, D, 0, 0, nullptr, st[2]), lane);
            LDS_WAIT();
            conv_pipe<3>(tb, st, 0, IA + IB + IO, gw2, NGW2, scr, lane); }
    }
    SEAM(1);
    if (IN(2)) { PH_BEGIN
        pg8::Gemm g{ACT, W1D, M, D, FF, FF, FF}; pg8::StaticOrder S; S.init(M, D, G, bx);
        pg8::EpiResidBf<true> E{INP(I_X), HB, D, 0.5f, SSQ(0)};
        pg8::gemm_phase<pg8::EpiResidBf<true>, pg8::StaticOrder, true, true>(lds, g, S, E);
    }
    SEAM(2);
    if (IN(3)) for (int rep_ = 0; rep_ < (PROBE_PHASE == 3 ? PROBE_REPS : 1); ++rep_) { PH_BEGIN
        pg8::Gemm g{HB, WIN, M, NPP, D, D, D}; pg8::StaticOrder S; S.init(M, NPP, G, bx);
        pg8::EpiStoreBf16 E{PROJ, NPP, SSQ(0), SSQ_INVK, EPS};
        pg8::gemm_phase<pg8::EpiStoreBf16, pg8::StaticOrder, true, true>(lds, g, S, E);
        for (int job = gw; job < (M / 16) * 4; job += NGW) ab_logits(HB, WIN + (size_t)NPP * D, AB, job, lane);
    }
    SEAM(3);
    if (IN(4)) for (int rep_ = 0; rep_ < (PROBE_PHASE == 4 ? PROBE_REPS : 1); ++rep_) { PH_BEGIN
        for (int pair = vcu; pair < BATCH * NH * NCH / 2; pair += G) dn_chunk_pair(PROJ, AB, SSQ(0), INP(I_QKVW), INP(I_ALOG), INP(I_DTB), ws, lds, pair, tid, INP(I_CONVW), CONVA);
    }
    SEAM(4);
    if (IN(5)) for (int rep_ = 0; rep_ < (PROBE_PHASE == 5 ? PROBE_REPS : 1); ++rep_) { PH_BEGIN for (int unit = vcu; unit < BATCH * NH * 4; unit += G) { SideJob J{INP(I_F2G), INP(I_F2U), INP(I_F2D), W2GU, W2D, INP(I_F2N), nullptr, (unit * NWAVES + wave) * SIDE_SCAN_STEPS}; dn_scan_unit(ws, lds, OB, unit, tid, J); } }
    SEAM(5);
    if (IN(6)) for (int rep_ = 0; rep_ < (PROBE_PHASE == 6 ? PROBE_REPS : 1); ++rep_) { PH_BEGIN dn_gated_norm(OB, PROJ, INP(I_DNN), ON, gtid, NT); }
    SEAM(6);
    if (IN(7)) for (int rep_ = 0; rep_ < (PROBE_PHASE == 7 ? PROBE_REPS : 1); ++rep_) { PH_BEGIN
        pg8::Gemm g{CONVA, WA, M, D, CW, CW, CW}; pg8::OrderTwoPass S; S.init(M, D, G, bx); S.A1 = ON; S.B1 = WB;
        pg8::EpiGateFused E{XN, D, PROJ + OFF_GA, PROJ + OFF_GB, NPP};
        pg8::gemm_phase<pg8::EpiGateFused, pg8::OrderTwoPass, true, true>(lds, g, S, E);
    }
    SEAM(7);
    if (IN(8)) { PH_BEGIN
        pg8::Gemm g{XN, WO, M, D, D, D, D}; pg8::StaticOrder S; S.init(M, D, G, bx);
        pg8::EpiResidBf<false> E{HB, HB, D, 1.0f, SSQ(1)};
        pg8::gemm_phase<pg8::EpiResidBf<false>, pg8::StaticOrder, true, true>(lds, g, S, E);
    }
    SEAM(8);
    if (IN(9)) for (int rep_ = 0; rep_ < (PROBE_PHASE == 9 ? PROBE_REPS : 1); ++rep_) { PH_BEGIN
        pg8::Gemm g{HB, WQ, M, XW, D / 4, D, D}; pg8::OrderSplitK4 S{G, bx, (D / 4) * 2};
        pg8::EpiPartF32 E{QP, XW, (size_t)M * XW};
        pg8::gemm_phase<pg8::EpiPartF32, pg8::OrderSplitK4, true, true>(lds, g, S, E);
    }
    SEAM(9);
    if (IN(10)) for (int rep_ = 0; rep_ < (PROBE_PHASE == 10 ? PROBE_REPS : 1); ++rep_) { PH_BEGIN for (int unit = vcu; unit < BATCH * 4 * (SEQ / 128); unit += G) xattn_unit(QP, SSQ(1), KB, VT, XO, lds, unit, tid); }
    SEAM(10);
    if (IN(11)) { PH_BEGIN
        pg8::Gemm g{XO, WXO, M, D, XW, XW, XW}; pg8::StaticOrder S; S.init(M, D, G, bx);
        pg8::EpiResidBf<false> E{HB, HB, D, 1.0f, SSQ(2)};
        pg8::gemm_phase<pg8::EpiResidBf<false>, pg8::StaticOrder, true, true>(lds, g, S, E);
    }
    SEAM(11);
    if (IN(12)) for (int rep_ = 0; rep_ < (PROBE_PHASE == 12 ? PROBE_REPS : 1); ++rep_) { PH_BEGIN
        const int NCONV = (G == 256) ? 5 : 0, GG = G - NCONV;
        if (bx < GG) {
            pg8::Gemm g{HB, W2GU, M, 2 * FF, D, D, D}; pg8::StaticOrder S; S.init(M, 2 * FF, GG, bx);
            pg8::EpiSwiGLUrs E{ACT, FF, SSQ(2), SSQ_INVK, EPS};
            pg8::gemm_phase<pg8::EpiSwiGLUrs, pg8::StaticOrder, true, true>(lds, g, S, E);
        }
        if (bx >= GG || NCONV == 0) { LAS float* scr = (LAS float*)(lds + wave * 16384); LAS int* tb = (LAS int*)(scr + TW_TABLE);
            constexpr int st[3] = {0, SIDE_IG, 2 * SIDE_IG};
            tw_table_put(tb, 0, tw_job(INP(I_F2G), FF, W2GU, D, 1, 0, INP(I_F2N), st[0]), lane);
            tw_table_put(tb, 1, tw_job(INP(I_F2U), FF, W2GU, D, 2, 0, INP(I_F2N), st[1]), lane);
            tw_table_put(tb, 2, tw_job(INP(I_F2D), D, W2D, FF, 0, 0, nullptr, st[2]), lane);
            LDS_WAIT();
            conv_pipe<3>(tb, st, SIDE_ITEMS, 3 * SIDE_IG, NCONV ? (bx - GG) * NWAVES + wave : gw, NCONV ? NCONV * NWAVES : NGW, scr, lane);
        }
    }
    SEAM(12);
    if (IN(13)) { PH_BEGIN
        pg8::Gemm g{ACT, W2D, M, D, FF, FF, FF}; pg8::StaticOrder S; S.init(M, D, G, bx);
        pg8::EpiResidBf<false> E{HB, HB, D, 0.5f, SSQ(3)};
        pg8::gemm_phase<pg8::EpiResidBf<false>, pg8::StaticOrder, true, true>(lds, g, S, E);
    }
    SEAM(13);
    if (IN(14)) { PH_BEGIN final_norm(HB, SSQ(3), INP(I_FINN), H, gw, NGW, lane); }
#undef IN
#undef SEAM
}

extern "C" void kernel_launch(void* const* d_in, const int* in_sizes, int n_in, void* d_out, int out_size, void* d_ws, size_t ws_size, hipStream_t stream) {
    static int grid = 0;
    if (grid == 0) {
        if (n_in != 27 || out_size != M * D || ws_size < WS_END) { fprintf(stderr, "kernel_launch: unexpected problem (n_in %d, out %d, ws %zu < %zu)\n", n_in, out_size, ws_size, (size_t)WS_END); grid = -1; return; }
        int dev = 0, cus = 0, per_cu = 0;
        if (hipGetDevice(&dev) != hipSuccess || hipDeviceGetAttribute(&cus, hipDeviceAttributeMultiprocessorCount, dev) != hipSuccess) { grid = -1; return; }
        if (hipFuncSetAttribute((const void*)fwd_kernel, hipFuncAttributeMaxDynamicSharedMemorySize, LDS_BYTES) != hipSuccess) { fprintf(stderr, "kernel_launch: hipFuncSetAttribute failed\n"); grid = -1; return; }
        if (hipOccupancyMaxActiveBlocksPerMultiprocessor(&per_cu, (const void*)fwd_kernel, NTHREADS, LDS_BYTES) != hipSuccess || per_cu < 1) { fprintf(stderr, "kernel_launch: occupancy query reports %d blocks per CU\n", per_cu); (void)hipGetLastError(); grid = -1; return; }
        grid = cus;
    }
    if (grid < 0) return;
    (void)hipMemsetAsync((char*)d_ws + WS_CTL, 0, CTL_ZERO_BYTES, stream);
    Args a{};
    for (int i = 0; i < 27; ++i) a.in[i] = (const float*)d_in[i];
    a.out = (float*)d_out; a.ws = (unsigned char*)d_ws;
#if MK_N_LAUNCHES == 1
    a.ph_lo = 0; a.ph_hi = NPH;
    hipLaunchKernelGGL(fwd_kernel, dim3(grid), dim3(NTHREADS), LDS_BYTES, stream, a);
#else
    for (int p = 0; p < NPH; ++p) { a.ph_lo = p; a.ph_hi = p + 1; hipLaunchKernelGGL(fwd_kernel, dim3(grid), dim3(NTHREADS), LDS_BYTES, stream, a); }
#endif
}
```

```cpp
#include <hip/hip_runtime.h>
#include <cstdio>
#include <cstdint>
#ifndef MK_N_LAUNCHES
#define MK_N_LAUNCHES 1
#endif
namespace pg8 {
#define PG8_LAS __attribute__((address_space(3)))
typedef unsigned short bf16_t;
typedef short bf16x8 __attribute__((ext_vector_type(8)));
typedef float f32x4 __attribute__((ext_vector_type(4)));
typedef unsigned u32x4 __attribute__((ext_vector_type(4)));
constexpr int BM = 256, BK = 64, HALF = 128, HTB = HALF * BK * 2  , STAGE_BYTES = 8 * HTB, NXCD = 8, WGM = 8;

__host__ __device__ __forceinline__ int lds_byte(int r, int c) { const int st = (r >> 4) * 2 + (c >> 5), rr = r & 15, cc = c & 31, ob = rr * 64 + cc * 2; return st * 1024 + (ob ^ (((ob >> 9) & 1) << 5)); }
__host__ __device__ __forceinline__ void stage_rc(int b, int& R, int& C) { const int st = b / 1024, sb = b % 1024, swz = sb ^ (((sb >> 9) & 1) << 5); R = (st >> 1) * 16 + swz / 64; C = (st & 1) * 32 + (swz % 64) / 2; }
__host__ __device__ __forceinline__ int perm32(int rho) { const int n = rho >> 4, i = rho & 15; return 8 * (i >> 2) + 4 * n + (i & 3); }

struct Unit { int pm, pn, g; };
struct Gemm { const bf16_t* A; const bf16_t* Bt; int M, N, K, lda, ldb; };

struct StaticOrder {
    int nM, nN, nwg, G, c;
    __host__ __device__ void init(int M, int N, int G_, int c_) { nM = M / BM; nN = N / BM; nwg = nM * nN; G = G_; c = c_; }
    __host__ __device__ bool next(int i, Unit& u) const {
        const long L = (long)i * G + c; if (L >= nwg) return false;
        int wgid = (int)L; { const int q = nwg / NXCD, r = nwg % NXCD, xcd = wgid % NXCD, off = wgid / NXCD; wgid = (xcd < r ? xcd * (q + 1) : r * (q + 1) + (xcd - r) * q) + off; }
        const int nig = WGM * nN, gid = wgid / nig, fm = gid * WGM, gsz = (nM - fm) < WGM ? (nM - fm) : WGM;
        u.pm = fm + ((wgid % nig) % gsz); u.pn = (wgid % nig) / gsz; u.g = 0; return true;
    }
    __device__ __forceinline__ const char* pa(const Gemm& g, const Unit& u, size_t tstepA) const { return (const char*)g.A + (size_t)u.pm * tstepA; }
    __device__ __forceinline__ const char* pb(const Gemm& g, const Unit& u, size_t tstepB) const { return (const char*)g.Bt + (size_t)u.pn * tstepB; }
    __device__ __forceinline__ bool keep(const Unit&) const { return false; }
    __device__ __forceinline__ void a_ready(const Unit&) const {}
    __device__ __forceinline__ void done(const Unit&) const {}
};

__device__ __forceinline__ unsigned cvt_pk_bf16(float lo, float hi) { unsigned r; asm volatile("v_cvt_pk_bf16_f32 %0, %1, %2" : "=v"(r) : "v"(lo), "v"(hi)); return r; }
__device__ __forceinline__ float bf_lo(unsigned w) { return __uint_as_float(w << 16); }
__device__ __forceinline__ float bf_hi(unsigned w) { return __uint_as_float(w & 0xffff0000u); }
__device__ __forceinline__ float fast_sigmoid(float x) { return __builtin_amdgcn_rcpf(1.0f + __builtin_amdgcn_exp2f(-1.4426950408889634f * x)); }
__device__ __forceinline__ float fast_silu(float x) { return x * fast_sigmoid(x); }

template <bool RS> struct EpiSwiGLUT {
    static constexpr bool PERM = true, AFTER_DRAIN = false, PRE = RS;
    bf16_t* O; int ldc; const unsigned long long* ssq; float inv_k, eps;
    __device__ __forceinline__ float pre_load(const Unit& u, int tid) const { return (tid < BM) ? (float)ssq[u.pm * BM + tid] : 0.f; }
    __device__ __forceinline__ void pre_store(PG8_LAS float* slot, int tid, float v) const { if (tid < BM) slot[tid] = 1.0f / sqrtf(v * inv_k + eps); }
    static __device__ __forceinline__ f32x4 silu_mul(const f32x4 g, const f32x4 u, float c1, float s2) {
        if (!RS) asm("" : "+v"(c1));
        const f32x4 t = g * c1; f32x4 e, onev = {1.0f, 1.0f, 1.0f, 1.0f};
#pragma unroll
        for (int j = 0; j < 4; ++j) e[j] = __builtin_amdgcn_exp2f(t[j]);
        asm("" : "+v"(e)); asm("" : "+v"(onev));
        const f32x4 d = e + onev; f32x4 r;
#pragma unroll
        for (int j = 0; j < 4; ++j) r[j] = __builtin_amdgcn_rcpf(d[j]);
        asm("" : "+v"(r));
        f32x4 p = g * u; if (RS) p = p * s2;
        return p * r;
    }
    __device__ __forceinline__ void operator()(const f32x4 (&acc)[2][2][4][2], const Unit& u, int wr, int wc, int fr, int fq, const PG8_LAS float* rsl = nullptr) const {
        const int row0 = u.pm * BM + wr * 64 + fr, col0 = u.pn * HALF + wc * 32 + 8 * fq;
#pragma unroll
        for (int ai = 0; ai < 2; ++ai)
#pragma unroll
            for (int m = 0; m < 4; ++m) { bf16_t* rowp = O + (size_t)(row0 + ai * HALF + m * 16) * ldc + col0;
                const float rs = RS ? rsl[wr * 64 + fr + ai * HALF + m * 16] : 1.0f;
                const float c1 = -1.4426950408889634f * rs, s2 = rs * rs;
                const f32x4 v0 = silu_mul(acc[ai][0][m][0], acc[ai][1][m][0], c1, s2), v1 = silu_mul(acc[ai][0][m][1], acc[ai][1][m][1], c1, s2);
                u32x4 w; w.x = cvt_pk_bf16(v0[0], v0[1]); w.y = cvt_pk_bf16(v0[2], v0[3]); w.z = cvt_pk_bf16(v1[0], v1[1]); w.w = cvt_pk_bf16(v1[2], v1[3]);
                *(u32x4*)rowp = w; }
    }
};
typedef EpiSwiGLUT<false> EpiSwiGLU;
typedef EpiSwiGLUT<true> EpiSwiGLUrs;
template <bool XF32> struct EpiResidBf {
    static constexpr bool PERM = true, AFTER_DRAIN = false, PRE = false;
    const void* base; bf16_t* out; int ldc; float alpha; unsigned long long* ssq;
    __device__ __forceinline__ void operator()(const f32x4 (&acc)[2][2][4][2], const Unit& u, int wr, int wc, int fr, int fq) const {
        const int row0 = u.pm * BM + wr * 64 + fr, col0 = u.pn * BM + wc * 32 + 8 * fq;
#pragma unroll
        for (int ai = 0; ai < 2; ++ai) {
            f32x4 b[4][2][2];
#pragma unroll
            for (int m = 0; m < 4; ++m) { const size_t off = (size_t)(row0 + ai * HALF + m * 16) * ldc + col0;
#pragma unroll
                for (int bj = 0; bj < 2; ++bj) {
                    if (XF32) { b[m][bj][0] = *(const f32x4*)((const float*)base + off + bj * HALF); b[m][bj][1] = *(const f32x4*)((const float*)base + off + bj * HALF + 4); }
                    else { const u32x4 w = *(const u32x4*)((const bf16_t*)base + off + bj * HALF);
                        b[m][bj][0] = (f32x4){bf_lo(w.x), bf_hi(w.x), bf_lo(w.y), bf_hi(w.y)}; b[m][bj][1] = (f32x4){bf_lo(w.z), bf_hi(w.z), bf_lo(w.w), bf_hi(w.w)}; } } }
#pragma unroll
            for (int m = 0; m < 4; ++m) { const size_t off = (size_t)(row0 + ai * HALF + m * 16) * ldc + col0; float ss = 0.f;
#pragma unroll
                for (int bj = 0; bj < 2; ++bj) { const f32x4 o0 = b[m][bj][0] + acc[ai][bj][m][0] * alpha, o1 = b[m][bj][1] + acc[ai][bj][m][1] * alpha;
                    ss += ((o0[0] * o0[0] + o0[1] * o0[1]) + (o0[2] * o0[2] + o0[3] * o0[3])) + ((o1[0] * o1[0] + o1[1] * o1[1]) + (o1[2] * o1[2] + o1[3] * o1[3]));
                    u32x4 w; w.x = cvt_pk_bf16(o0[0], o0[1]); w.y = cvt_pk_bf16(o0[2], o0[3]); w.z = cvt_pk_bf16(o1[0], o1[1]); w.w = cvt_pk_bf16(o1[2], o1[3]);
                    *(u32x4*)(out + off + bj * HALF) = w; }
                ss += __shfl_xor(ss, 16); ss += __shfl_xor(ss, 32);
                if (fq == 0) __hip_atomic_fetch_add(ssq + row0 + ai * HALF + m * 16, (unsigned long long)(ss * 1048576.0f + 0.5f), __ATOMIC_RELAXED, __HIP_MEMORY_SCOPE_AGENT); }
        }
    }
};
struct EpiStoreBf16 {
    static constexpr bool PERM = true, AFTER_DRAIN = false, PRE = true;
    bf16_t* O; int ldc; const unsigned long long* ssq; float inv_k, eps;
    __device__ __forceinline__ float pre_load(const Unit& u, int tid) const { return (tid < BM) ? (float)ssq[u.pm * BM + tid] : 0.f; }
    __device__ __forceinline__ void pre_store(PG8_LAS float* slot, int tid, float v) const { if (tid < BM) slot[tid] = 1.0f / sqrtf(v * inv_k + eps); }
    __device__ __forceinline__ void operator()(const f32x4 (&acc)[2][2][4][2], const Unit& u, int wr, int wc, int fr, int fq, const PG8_LAS float* rsl) const {
        const int row0 = u.pm * BM + wr * 64 + fr, col0 = u.pn * BM + wc * 32 + 8 * fq;
#pragma unroll
        for (int ai = 0; ai < 2; ++ai)
#pragma unroll
            for (int m = 0; m < 4; ++m) { bf16_t* rowp = O + (size_t)(row0 + ai * HALF + m * 16) * ldc + col0;
                const float scale = rsl[wr * 64 + fr + ai * HALF + m * 16];
#pragma unroll
                for (int bj = 0; bj < 2; ++bj) { const f32x4 v0 = acc[ai][bj][m][0] * scale, v1 = acc[ai][bj][m][1] * scale;
                    u32x4 w; w.x = cvt_pk_bf16(v0[0], v0[1]); w.y = cvt_pk_bf16(v0[2], v0[3]); w.z = cvt_pk_bf16(v1[0], v1[1]); w.w = cvt_pk_bf16(v1[2], v1[3]);
                    *(u32x4*)(rowp + bj * HALF) = w; } }
    }
};
struct EpiKV {
    static constexpr bool PERM = true, AFTER_DRAIN = false, PRE = false;
    bf16_t* KB; bf16_t* VT;
    __device__ __forceinline__ void operator()(const f32x4 (&acc)[2][2][4][2], const Unit& u, int wr, int wc, int fr, int fq) const {
        const int rl0 = wr * 64 + fr;
        if (u.pn < 2) {
            const int col0 = u.pn * BM + wc * 32 + 8 * fq;
#pragma unroll
            for (int ai = 0; ai < 2; ++ai)
#pragma unroll
                for (int m = 0; m < 4; ++m) { bf16_t* rowp = KB + (size_t)(u.pm * BM + rl0 + ai * HALF + m * 16) * 512 + col0;
#pragma unroll
                    for (int bj = 0; bj < 2; ++bj) { const f32x4 v0 = acc[ai][bj][m][0], v1 = acc[ai][bj][m][1];
                        u32x4 w; w.x = cvt_pk_bf16(v0[0], v0[1]); w.y = cvt_pk_bf16(v0[2], v0[3]); w.z = cvt_pk_bf16(v1[0], v1[1]); w.w = cvt_pk_bf16(v1[2], v1[3]);
                        *(u32x4*)(rowp + bj * HALF) = w; } }
        } else {
            const int colv0 = (u.pn - 2) * BM + wc * 32 + 8 * fq;
#pragma unroll
            for (int ai = 0; ai < 2; ++ai)
#pragma unroll
                for (int m = 0; m < 4; ++m) { const int key = rl0 + ai * HALF + m * 16;
#pragma unroll
                    for (int bj = 0; bj < 2; ++bj)
#pragma unroll
                        for (int n = 0; n < 2; ++n)
#pragma unroll
                            for (int e = 0; e < 4; ++e) { const int cv = colv0 + bj * HALF + 4 * n + e;
                                VT[((size_t)u.pm * 512 + cv) * 256 + key] = (bf16_t)(cvt_pk_bf16(acc[ai][bj][m][n][e], 0.f) & 0xffffu); } }
        }
    }
};
struct EpiGateA {
    static constexpr bool PERM = true, AFTER_DRAIN = false, PRE = false;
    float* T; int ldc; const bf16_t* G; int ldg;
    __device__ __forceinline__ void operator()(const f32x4 (&acc)[2][2][4][2], const Unit& u, int wr, int wc, int fr, int fq) const {
        const int row0 = u.pm * BM + wr * 64 + fr, col0 = u.pn * BM + wc * 32 + 8 * fq;
#pragma unroll
        for (int ai = 0; ai < 2; ++ai)
#pragma unroll
            for (int m = 0; m < 4; ++m) { const size_t row = (size_t)(row0 + ai * HALF + m * 16);
#pragma unroll
                for (int bj = 0; bj < 2; ++bj) { const int c = col0 + bj * HALF; const u32x4 gw = *(const u32x4*)(G + row * ldg + c);
                    f32x4 v0 = acc[ai][bj][m][0], v1 = acc[ai][bj][m][1];
                    v0[0] *= fast_sigmoid(bf_lo(gw.x)); v0[1] *= fast_sigmoid(bf_hi(gw.x)); v0[2] *= fast_sigmoid(bf_lo(gw.y)); v0[3] *= fast_sigmoid(bf_hi(gw.y));
                    v1[0] *= fast_sigmoid(bf_lo(gw.z)); v1[1] *= fast_sigmoid(bf_hi(gw.z)); v1[2] *= fast_sigmoid(bf_lo(gw.w)); v1[3] *= fast_sigmoid(bf_hi(gw.w));
                    *(f32x4*)(T + row * ldc + c) = v0; *(f32x4*)(T + row * ldc + c + 4) = v1; } }
    }
};
struct EpiGateB {
    static constexpr bool PERM = true, AFTER_DRAIN = false, PRE = false;
    const float* T; bf16_t* O; int ldc; const bf16_t* G; int ldg;
    __device__ __forceinline__ void operator()(const f32x4 (&acc)[2][2][4][2], const Unit& u, int wr, int wc, int fr, int fq) const {
        const int row0 = u.pm * BM + wr * 64 + fr, col0 = u.pn * BM + wc * 32 + 8 * fq;
#pragma unroll
        for (int ai = 0; ai < 2; ++ai)
#pragma unroll
            for (int m = 0; m < 4; ++m) { const size_t row = (size_t)(row0 + ai * HALF + m * 16);
#pragma unroll
                for (int bj = 0; bj < 2; ++bj) { const int c = col0 + bj * HALF; const u32x4 gw = *(const u32x4*)(G + row * ldg + c);
                    const f32x4 t0 = *(const f32x4*)(T + row * ldc + c), t1 = *(const f32x4*)(T + row * ldc + c + 4);
                    f32x4 v0 = acc[ai][bj][m][0], v1 = acc[ai][bj][m][1];
                    v0[0] = t0[0] + v0[0] * fast_sigmoid(bf_lo(gw.x)); v0[1] = t0[1] + v0[1] * fast_sigmoid(bf_hi(gw.x)); v0[2] = t0[2] + v0[2] * fast_sigmoid(bf_lo(gw.y)); v0[3] = t0[3] + v0[3] * fast_sigmoid(bf_hi(gw.y));
                    v1[0] = t1[0] + v1[0] * fast_sigmoid(bf_lo(gw.z)); v1[1] = t1[1] + v1[1] * fast_sigmoid(bf_hi(gw.z)); v1[2] = t1[2] + v1[2] * fast_sigmoid(bf_lo(gw.w)); v1[3] = t1[3] + v1[3] * fast_sigmoid(bf_hi(gw.w));
                    u32x4 w; w.x = cvt_pk_bf16(v0[0], v0[1]); w.y = cvt_pk_bf16(v0[2], v0[3]); w.z = cvt_pk_bf16(v1[0], v1[1]); w.w = cvt_pk_bf16(v1[2], v1[3]);
                    *(u32x4*)(O + row * ldc + c) = w; } }
    }
};

struct OrderFfnKv : StaticOrder {
    const bf16_t* A1; const bf16_t* B1;
    __device__ __forceinline__ bool next(int i, Unit& u) const {
        if (StaticOrder::next(i, u)) return true;
        const long L = (long)i * G + c - nwg; if (L < 0 || L >= 16) return false;
        u.g = 1; u.pm = (int)(L >> 2); u.pn = (int)(L & 3); return true; }
    __device__ __forceinline__ const char* pa(const Gemm& g, const Unit& u, size_t tstepA) const { return (const char*)(u.g ? A1 : g.A) + (size_t)u.pm * tstepA; }
    __device__ __forceinline__ const char* pb(const Gemm& g, const Unit& u, size_t tstepB) const { return (const char*)(u.g ? B1 : g.Bt) + (size_t)u.pn * tstepB; }
};
struct EpiSwiGLUKV {
    static constexpr bool PERM = true, AFTER_DRAIN = false, PRE = false;
    EpiSwiGLU e0; EpiKV e1;
    __device__ __forceinline__ void operator()(const f32x4 (&acc)[2][2][4][2], const Unit& u, int wr, int wc, int fr, int fq) const { if (u.g == 0) e0(acc, u, wr, wc, fr, fq); else e1(acc, u, wr, wc, fr, fq); }
};
struct OrderSplitK4 {
    int G, c, ks_bytes;
    __device__ __forceinline__ bool next(int i, Unit& u) const { const long L = (long)i * G + c; if (L >= 256) return false; u.pm = (int)(L >> 3); u.pn = (int)((L >> 2) & 1); u.g = (int)(L & 3); return true; }
    __device__ __forceinline__ const char* pa(const Gemm& g, const Unit& u, size_t tstepA) const { return (const char*)g.A + (size_t)u.pm * tstepA + (size_t)u.g * ks_bytes; }
    __device__ __forceinline__ const char* pb(const Gemm& g, const Unit& u, size_t tstepB) const { return (const char*)g.Bt + (size_t)u.pn * tstepB + (size_t)u.g * ks_bytes; }
    __device__ __forceinline__ bool keep(const Unit&) const { return false; }
    __device__ __forceinline__ void a_ready(const Unit&) const {}
    __device__ __forceinline__ void done(const Unit&) const {}
};
struct EpiPartBf16 {
    static constexpr bool PERM = true, AFTER_DRAIN = false, PRE = false;
    bf16_t* P; int ldc; size_t gstride;
    typedef __bf16 b2_t __attribute__((ext_vector_type(2))); typedef float f2_t __attribute__((ext_vector_type(2)));
    static __device__ __forceinline__ unsigned cv(float lo, float hi) { const f2_t f = {lo, hi}; return __builtin_bit_cast(unsigned, __builtin_convertvector(f, b2_t)); }
    __device__ __forceinline__ void operator()(const f32x4 (&acc)[2][2][4][2], const Unit& u, int wr, int wc, int fr, int fq) const {
        const int row0 = u.pm * BM + wr * 64 + fr, col0 = u.pn * BM + wc * 32 + 8 * fq; bf16_t* out = P + (size_t)u.g * gstride;
#pragma unroll
        for (int ai = 0; ai < 2; ++ai)
#pragma unroll
            for (int m = 0; m < 4; ++m) { bf16_t* rowp = out + (size_t)(row0 + ai * HALF + m * 16) * ldc + col0;
#pragma unroll
                for (int bj = 0; bj < 2; ++bj) { const f32x4 v0 = acc[ai][bj][m][0], v1 = acc[ai][bj][m][1];
                    u32x4 w; w.x = cv(v0[0], v0[1]); w.y = cv(v0[2], v0[3]); w.z = cv(v1[0], v1[1]); w.w = cv(v1[2], v1[3]);
                    *(u32x4*)(rowp + bj * HALF) = w; } }
    }
};
struct OrderTwoPass : StaticOrder {
    const bf16_t* A1; const bf16_t* B1;
    __device__ __forceinline__ bool next(int i, Unit& u) const { if (!StaticOrder::next(i >> 1, u)) return false; u.g = i & 1; return true; }
    __device__ __forceinline__ const char* pa(const Gemm& g, const Unit& u, size_t tstepA) const { return (const char*)(u.g ? A1 : g.A) + (size_t)u.pm * tstepA; }
    __device__ __forceinline__ const char* pb(const Gemm& g, const Unit& u, size_t tstepB) const { return (const char*)(u.g ? B1 : g.Bt) + (size_t)u.pn * tstepB; }
    __device__ __forceinline__ bool keep(const Unit& u) const { return u.g == 0; }
};
struct EpiGateFused {
    static constexpr bool PERM = true, AFTER_DRAIN = false, PRE = false;
    bf16_t* O; int ldc; const bf16_t* GA; const bf16_t* GB; int ldg;
    static __device__ __forceinline__ f32x4 opexp(const f32x4 x, float c, const f32x4 onev) { const f32x4 t = x * c; f32x4 e;
#pragma unroll
        for (int j = 0; j < 4; ++j) e[j] = __builtin_amdgcn_exp2f(t[j]);
        asm("" : "+v"(e)); return e + onev; }
    static __device__ __forceinline__ f32x4 rcp4(const f32x4 d) { f32x4 r;
#pragma unroll
        for (int j = 0; j < 4; ++j) r[j] = __builtin_amdgcn_rcpf(d[j]);
        asm("" : "+v"(r)); return r; }
    __device__ __forceinline__ void operator()(f32x4 (&acc)[2][2][4][2], const Unit& u, int wr, int wc, int fr, int fq) const {
        const int row0 = u.pm * BM + wr * 64 + fr, col0 = u.pn * BM + wc * 32 + 8 * fq;
        float c = -1.4426950408889634f; f32x4 onev = {1.0f, 1.0f, 1.0f, 1.0f}; asm("" : "+v"(c)); asm("" : "+v"(onev));
#pragma unroll
        for (int ai = 0; ai < 2; ++ai) {
            u32x4 gbv[4][2], gav[4][2];
#pragma unroll
            for (int m = 0; m < 4; ++m) { const size_t row = (size_t)(row0 + ai * HALF + m * 16);
#pragma unroll
                for (int bj = 0; bj < 2; ++bj) { gbv[m][bj] = *(const u32x4*)(GB + row * ldg + col0 + bj * HALF); if (u.g == 0) gav[m][bj] = *(const u32x4*)(GA + row * ldg + col0 + bj * HALF); } }
#pragma unroll
            for (int m = 0; m < 4; ++m) { const size_t row = (size_t)(row0 + ai * HALF + m * 16);
#pragma unroll
                for (int bj = 0; bj < 2; ++bj) { const int cc = col0 + bj * HALF; const u32x4 gb = gbv[m][bj];
                    const f32x4 eb0 = opexp((f32x4){bf_lo(gb.x), bf_hi(gb.x), bf_lo(gb.y), bf_hi(gb.y)}, c, onev), eb1 = opexp((f32x4){bf_lo(gb.z), bf_hi(gb.z), bf_lo(gb.w), bf_hi(gb.w)}, c, onev);
                    if (u.g == 0) { const u32x4 ga = gav[m][bj];
                        const f32x4 ea0 = opexp((f32x4){bf_lo(ga.x), bf_hi(ga.x), bf_lo(ga.y), bf_hi(ga.y)}, c, onev), ea1 = opexp((f32x4){bf_lo(ga.z), bf_hi(ga.z), bf_lo(ga.w), bf_hi(ga.w)}, c, onev);
                        acc[ai][bj][m][0] = acc[ai][bj][m][0] * (eb0 * rcp4(ea0)); acc[ai][bj][m][1] = acc[ai][bj][m][1] * (eb1 * rcp4(ea1));
                    } else { const f32x4 v0 = acc[ai][bj][m][0] * rcp4(eb0), v1 = acc[ai][bj][m][1] * rcp4(eb1);
                        u32x4 w; w.x = cvt_pk_bf16(v0[0], v0[1]); w.y = cvt_pk_bf16(v0[2], v0[3]); w.z = cvt_pk_bf16(v1[0], v1[1]); w.w = cvt_pk_bf16(v1[2], v1[3]);
                        *(u32x4*)(O + row * ldc + cc) = w; } } }
        }
    }
};


template <class Epi, class Sched, bool ALIGN_EPI = false, bool SP2 = false>
__device__ __forceinline__ void gemm_phase(PG8_LAS unsigned char* lds, const Gemm g, const Sched& S, const Epi& E) {
    const int tid = threadIdx.x, wid = __builtin_amdgcn_readfirstlane(tid >> 6), lane = tid & 63, wr = wid >> 2, wc = wid & 3, fr = lane & 15, fq = lane >> 4;
    const int K = g.K, nt = K / BK;
    unsigned voffA[2], voffB[2];
#pragma unroll
    for (int i = 0; i < 2; ++i) { int R, C; stage_rc(tid * 16 + i * 8192, R, C); const int Rb = Epi::PERM ? ((R & ~31) + perm32(R & 31)) : R;
        voffA[i] = (unsigned)(R * g.lda + C) * 2u; voffB[i] = (unsigned)(Rb * g.ldb + C) * 2u; }
    const size_t kstep = (size_t)(BK * 2);
    const size_t hstepA = (size_t)HALF * g.lda * 2, hstepB = (size_t)HALF * g.ldb * 2;
    const size_t tstepA = 2 * hstepA, tstepB = 2 * hstepB;
    const unsigned ldsw = (unsigned)wid * 1024u;
    const int aoff = lds_byte(wr * 64 + fr, fq * 8), boff = lds_byte(wc * 32 + fr, fq * 8);
#define PG8_SA(b, h) (((b) * 2 + (h)) * HTB)
#define PG8_SB(b, h) ((4 + (b) * 2 + (h)) * HTB)
#define PG8_STAGE(bufoff, gbase, voff) do { _Pragma("unroll") for (int _i = 0; _i < 2; ++_i) \
        __builtin_amdgcn_global_load_lds((const unsigned*)((const char*)(gbase) + (voff)[_i]), (PG8_LAS unsigned*)(lds + (bufoff) + ldsw + _i * 8192), 16, 0, 0); } while (0)
#define PG8_LDA(dst, b, h) do { _Pragma("unroll") for (int m = 0; m < 4; ++m) _Pragma("unroll") for (int k = 0; k < 2; ++k) dst[m][k] = *(const PG8_LAS bf16x8*)(lds + PG8_SA(b, h) + aoff + m * 2048 + k * 1024); } while (0)
#define PG8_LDB(dst, b, h) do { _Pragma("unroll") for (int n = 0; n < 2; ++n) _Pragma("unroll") for (int k = 0; k < 2; ++k) dst[n][k] = *(const PG8_LAS bf16x8*)(lds + PG8_SB(b, h) + boff + n * 2048 + k * 1024); } while (0)
#define PG8_MMA(ai, bj, At, Bt) do { __builtin_amdgcn_s_setprio(1); _Pragma("unroll") for (int m = 0; m < 4; ++m) _Pragma("unroll") for (int n = 0; n < 2; ++n) _Pragma("unroll") for (int k = 0; k < 2; ++k) \
        acc[ai][bj][m][n] = __builtin_amdgcn_mfma_f32_16x16x32_bf16(Bt[n][k], At[m][k], acc[ai][bj][m][n], 0, 0, 0); __builtin_amdgcn_s_setprio(0); } while (0)
#define PG8_WAIT_V(n) asm volatile("s_waitcnt vmcnt(" #n ")" ::: "memory")
#define PG8_WAIT_L(n) asm volatile("s_waitcnt lgkmcnt(" #n ")" ::: "memory")
#define PG8_BAR __builtin_amdgcn_s_barrier()
#define PG8_SCHED __builtin_amdgcn_sched_barrier(0)
    Unit cur, nxt; int ui = 0;
    if (!S.next(0, cur)) return;
    f32x4 acc[2][2][4][2];
#pragma unroll
    for (int a = 0; a < 2; ++a)
#pragma unroll
        for (int b = 0; b < 2; ++b)
#pragma unroll
            for (int m = 0; m < 4; ++m)
#pragma unroll
                for (int n = 0; n < 2; ++n) acc[a][b][m][n] = (f32x4){0.f, 0.f, 0.f, 0.f};
    bf16x8 At[4][2], B0[2][2], B1[2][2];
    const char* cA = S.pa(g, cur, tstepA); const char* cB = S.pb(g, cur, tstepB);
    PG8_LAS float* const rsl = (PG8_LAS float*)(lds + STAGE_BYTES); float pv = 0.f; int slot = 0;
    if constexpr (Epi::PRE) pv = E.pre_load(cur, tid);
    S.a_ready(cur);
    if constexpr (SP2) {
        PG8_STAGE(PG8_SB(0, 0), cB, voffB); PG8_STAGE(PG8_SB(0, 1), cB + hstepB, voffB); PG8_STAGE(PG8_SA(0, 0), cA, voffA); PG8_STAGE(PG8_SA(0, 1), cA + hstepA, voffA);
        if (wr == 1) PG8_BAR;
        PG8_WAIT_V(2); if constexpr (Epi::PRE) E.pre_store(rsl, tid, pv); PG8_BAR;
        PG8_STAGE(PG8_SB(1, 0), cB + kstep, voffB); PG8_STAGE(PG8_SA(1, 0), cA + kstep, voffA); PG8_STAGE(PG8_SB(1, 1), cB + hstepB + kstep, voffB);
        PG8_WAIT_V(6); PG8_BAR;
    } else {
        PG8_STAGE(PG8_SB(0, 0), cB, voffB); PG8_STAGE(PG8_SA(0, 0), cA, voffA); PG8_STAGE(PG8_SB(0, 1), cB + hstepB, voffB); PG8_STAGE(PG8_SA(0, 1), cA + hstepA, voffA);
        if (wr == 1) PG8_BAR;
        PG8_WAIT_V(4); if constexpr (Epi::PRE) E.pre_store(rsl, tid, pv); PG8_BAR;
        PG8_STAGE(PG8_SB(1, 0), cB + kstep, voffB); PG8_STAGE(PG8_SA(1, 0), cA + kstep, voffA); PG8_STAGE(PG8_SB(1, 1), cB + hstepB + kstep, voffB);
        PG8_WAIT_V(6); PG8_BAR;
    }
    for (;;) {
        const bool has_next = S.next(ui + 1, nxt);
        const char* nA = has_next ? S.pa(g, nxt, tstepA) : cA; const char* nB = has_next ? S.pb(g, nxt, tstepB) : cB;
        for (int t = 0; t < nt; t += 2) {
            const bool last = (t == nt - 2);
            const char* a1 = cA + (size_t)(t + 1) * kstep;
            const char* a2 = last ? nA : cA + (size_t)(t + 2) * kstep; const char* b2 = last ? nB : cB + (size_t)(t + 2) * kstep;
            const char* a3 = a2 + kstep; const char* b3 = b2 + kstep;
            if (last && has_next) S.a_ready(nxt);
            if constexpr (SP2) {
            PG8_LDB(B0, 0, 0); PG8_LDB(B1, 0, 1); PG8_SCHED; PG8_LDA(At, 0, 0); PG8_STAGE(PG8_SA(1, 1), a1 + hstepA, voffA);
            PG8_WAIT_V(8); PG8_WAIT_L(0); PG8_BAR; PG8_MMA(0, 0, At, B0); PG8_MMA(0, 1, At, B1); PG8_BAR; PG8_SCHED;
            PG8_LDA(At, 0, 1); PG8_STAGE(PG8_SB(0, 0), b2, voffB); PG8_STAGE(PG8_SB(0, 1), b2 + hstepB, voffB); PG8_STAGE(PG8_SA(0, 0), a2, voffA);
            PG8_WAIT_V(8); PG8_WAIT_L(0); PG8_BAR; PG8_MMA(1, 0, At, B0); PG8_MMA(1, 1, At, B1); PG8_BAR; PG8_SCHED;
            PG8_LDB(B0, 1, 0); PG8_LDB(B1, 1, 1); PG8_SCHED; PG8_LDA(At, 1, 0); PG8_STAGE(PG8_SA(0, 1), a2 + hstepA, voffA);
            PG8_WAIT_V(8); PG8_WAIT_L(0); PG8_BAR; PG8_MMA(0, 0, At, B0); PG8_MMA(0, 1, At, B1); PG8_BAR; PG8_SCHED;
            PG8_LDA(At, 1, 1); PG8_STAGE(PG8_SB(1, 0), b3, voffB); PG8_STAGE(PG8_SB(1, 1), b3 + hstepB, voffB); PG8_STAGE(PG8_SA(1, 0), a3, voffA);
            PG8_WAIT_V(8); PG8_WAIT_L(0); PG8_BAR; PG8_MMA(1, 0, At, B0); PG8_MMA(1, 1, At, B1); PG8_BAR; PG8_SCHED;
            } else {
            PG8_LDB(B0, 0, 0); PG8_SCHED; PG8_LDA(At, 0, 0); PG8_STAGE(PG8_SA(1, 1), a1 + hstepA, voffA);
            PG8_WAIT_L(8); PG8_BAR; PG8_WAIT_L(0); PG8_MMA(0, 0, At, B0); PG8_BAR; PG8_SCHED;
            PG8_LDB(B1, 0, 1); PG8_STAGE(PG8_SB(0, 0), b2, voffB);
            PG8_BAR; PG8_WAIT_L(0); PG8_MMA(0, 1, At, B1); PG8_BAR;
            PG8_LDA(At, 0, 1); PG8_STAGE(PG8_SA(0, 0), a2, voffA);
            PG8_BAR; PG8_WAIT_L(0); PG8_MMA(1, 0, At, B0); PG8_BAR; PG8_SCHED;
            PG8_STAGE(PG8_SB(0, 1), b2 + hstepB, voffB);
            PG8_WAIT_V(6); PG8_BAR; PG8_MMA(1, 1, At, B1); PG8_BAR;
            PG8_LDB(B0, 1, 0); PG8_SCHED; PG8_LDA(At, 1, 0); PG8_STAGE(PG8_SA(0, 1), a2 + hstepA, voffA);
            PG8_WAIT_L(8); PG8_BAR; PG8_WAIT_L(0); PG8_MMA(0, 0, At, B0); PG8_BAR; PG8_SCHED;
            PG8_LDB(B1, 1, 1); PG8_STAGE(PG8_SB(1, 0), b3, voffB);
            PG8_BAR; PG8_WAIT_L(0); PG8_MMA(0, 1, At, B1); PG8_BAR;
            PG8_LDA(At, 1, 1); PG8_STAGE(PG8_SA(1, 0), a3, voffA);
            PG8_BAR; PG8_WAIT_L(0); PG8_MMA(1, 0, At, B0); PG8_BAR; PG8_SCHED;
            PG8_STAGE(PG8_SB(1, 1), b3 + hstepB, voffB);
            PG8_WAIT_V(6); PG8_BAR; PG8_MMA(1, 1, At, B1); PG8_BAR;
            }
        }
        if constexpr (ALIGN_EPI) { if (wr == 0) PG8_BAR; }
        if constexpr (!Epi::AFTER_DRAIN) {
            if constexpr (Epi::PRE) { float pn_ = 0.f; if (has_next) pn_ = E.pre_load(nxt, tid); E(acc, cur, wr, wc, fr, fq, rsl + slot * 256); if (has_next) E.pre_store(rsl + (slot ^ 1) * 256, tid, pn_); slot ^= 1; }
            else E(acc, cur, wr, wc, fr, fq);
            S.done(cur); }
        if (!has_next) break;
        if (!S.keep(cur))
#pragma unroll
        for (int a = 0; a < 2; ++a)
#pragma unroll
            for (int b = 0; b < 2; ++b)
#pragma unroll
                for (int m = 0; m < 4; ++m)
#pragma unroll
                    for (int n = 0; n < 2; ++n) acc[a][b][m][n] = (f32x4){0.f, 0.f, 0.f, 0.f};
        cur = nxt; cA = nA; cB = nB; ++ui;
        if constexpr (ALIGN_EPI) { if (wr == 1) PG8_BAR; }
    }
    PG8_WAIT_V(0);
    if constexpr (!ALIGN_EPI) { if (wr == 0) PG8_BAR; }
    PG8_BAR;
    if constexpr (Epi::AFTER_DRAIN) { E.fused(acc, cur, wr, wc, fr, fq, lds, wid, lane); S.done(cur); }
#undef PG8_SA
#undef PG8_SB
#undef PG8_STAGE
#undef PG8_LDA
#undef PG8_LDB
#undef PG8_MMA
#undef PG8_WAIT_V
#undef PG8_WAIT_L
#undef PG8_BAR
#undef PG8_SCHED
}
}
#define GAS __attribute__((address_space(1)))
#define LAS __attribute__((address_space(3)))
typedef unsigned short bf16;
typedef unsigned v4u __attribute__((ext_vector_type(4)));
typedef float f32x4 __attribute__((ext_vector_type(4)));
typedef short bf16x8 __attribute__((ext_vector_type(8)));
typedef GAS unsigned gu32;
typedef GAS unsigned long long gu64;
#define RLX_AGENT __ATOMIC_RELAXED, __HIP_MEMORY_SCOPE_AGENT
#define LDS_WAIT() asm volatile("s_waitcnt lgkmcnt(0)" ::: "memory")
#define VM_WAIT() asm volatile("s_waitcnt vmcnt(0)" ::: "memory")
__device__ __forceinline__ unsigned long long rt() { return __builtin_amdgcn_s_memrealtime(); }
__device__ __forceinline__ unsigned f2bf(float f) { unsigned u = __builtin_bit_cast(unsigned, f); return (u + 0x7fffu + ((u >> 16) & 1u)) >> 16; }
typedef __bf16 pk2_b2 __attribute__((ext_vector_type(2))); typedef float pk2_f2 __attribute__((ext_vector_type(2)));
__device__ __forceinline__ unsigned pk2(float lo, float hi) { const pk2_f2 f = {lo, hi}; return __builtin_bit_cast(unsigned, __builtin_convertvector(f, pk2_b2)); }

#define XB_TMO      128
#define XB_XCNT(j)  (256  + 64 * (j))
#define XB_XSUB(j)  (1280 + 64 * (j))
#define XB_XGEN(j)  (2304 + 64 * (j))
#define XB_TOP      3328
#define XB_TOPGEN   3392
#define XCD_BAR_WORDS 3456
#define XB_SPIN_CAP (1u << 18)

__device__ __forceinline__ unsigned xb_ld(unsigned* p)              { return __hip_atomic_load(p, __ATOMIC_RELAXED, __HIP_MEMORY_SCOPE_AGENT); }
__device__ __forceinline__ unsigned xb_add(unsigned* p, unsigned v) { return __hip_atomic_fetch_add(p, v, __ATOMIC_RELAXED, __HIP_MEMORY_SCOPE_AGENT); }
__device__ __forceinline__ unsigned xb_xcc_id() { return (unsigned)__builtin_amdgcn_s_getreg((3 << 11) | 20) & 0xFu; }
#define XB_SPIN(cond, bar) do { unsigned _sp = 0; while (cond) { __builtin_amdgcn_s_sleep(1); \
    if ((++_sp & 255u) == 0u) { if (xb_ld(&(bar)[XB_TMO])) break; if (_sp > XB_SPIN_CAP) { atomicAdd(&(bar)[XB_TMO], 1u); break; } } } } while (0)

struct XcdBarrier {
    unsigned* bar; unsigned x;
    volatile LAS unsigned* st;
};

__device__ __forceinline__ XcdBarrier xcd_barrier_post(unsigned* bar, volatile LAS unsigned* st) {
    XcdBarrier b; b.bar = bar; b.x = xb_xcc_id(); b.st = st;
    if (threadIdx.x == 0) (void)xb_add(&bar[XB_XCNT(b.x)], 1u);
    return b;
}
__device__ __forceinline__ void xcd_barrier_complete(unsigned* bar, unsigned x, unsigned& nloc, unsigned& nx) {
    const unsigned G = gridDim.x * gridDim.y * gridDim.z;
    unsigned sum, cnt, mine, sp = 0u;
    for (;;) {
        sum = 0u; cnt = 0u; mine = 0u;
#pragma unroll
        for (unsigned j = 0; j < 16; ++j) { const unsigned c = xb_ld(&bar[XB_XCNT(j)]); sum += c; cnt += (c > 0u) ? 1u : 0u; mine = (j == x) ? c : mine; }
        if (sum == G) break;
        __builtin_amdgcn_s_sleep(1);
        if ((++sp & 255u) == 0u) { if (xb_ld(&bar[XB_TMO])) break; if (sp > XB_SPIN_CAP) { atomicAdd(&bar[XB_TMO], 1u); break; } }
    }
    nloc = mine > 0u ? mine : 1u; nx = cnt > 0u ? cnt : 1u;
}

__device__ __forceinline__ void xcd_barrier(const XcdBarrier& b) {
    asm volatile("s_waitcnt vmcnt(0)" ::: "memory");
    __syncthreads();
    if (threadIdx.x == 0) {
        unsigned* bar = b.bar;
        __builtin_amdgcn_s_waitcnt(0);
        unsigned nloc = b.st[0], nx = b.st[1];
        if (nloc == 0u) { xcd_barrier_complete(bar, b.x, nloc, nx); b.st[0] = nloc; b.st[1] = nx; }
        const unsigned old = xb_add(&bar[XB_XSUB(b.x)], 1u);
        const unsigned gen = old / nloc;
        if (old + 1u == (gen + 1u) * nloc) {
            __builtin_amdgcn_fence(__ATOMIC_RELEASE, "agent");
            asm volatile("s_waitcnt vmcnt(0)" ::: "memory");
            const unsigned og = xb_add(&bar[XB_TOP], 1u);
            const unsigned tg = og / nx;
            if (og + 1u == (tg + 1u) * nx) xb_add(&bar[XB_TOPGEN], 1u);
            else XB_SPIN(xb_ld(&bar[XB_TOPGEN]) == tg, bar);
            __builtin_amdgcn_fence(__ATOMIC_ACQUIRE, "agent");
            xb_add(&bar[XB_XGEN(b.x)], 1u);
            asm volatile("s_waitcnt vmcnt(0)" ::: "memory");
        } else {
            XB_SPIN(xb_ld(&bar[XB_XGEN(b.x)]) == gen, bar);
            __builtin_amdgcn_fence(__ATOMIC_ACQUIRE, "agent");
            asm volatile("s_waitcnt vmcnt(0)" ::: "memory");
        }
    }
    __syncthreads();
}

constexpr int NWAVES = 8, NTHREADS = NWAVES * 64;
constexpr int BATCH = 4, SEQ = 2048, D = 4096, FF = 11008, M = BATCH * SEQ;
constexpr int CW = 2048, DNW = 2048, NH = 16, HD = 128, CH = 64, NCH = SEQ / CH;
constexpr int NPROJ = 22560, NPP = 22528;
constexpr int OFF_CX = 0, OFF_CC = 2048, OFF_CB = 4096, OFF_Q = 6144, OFF_Z = 12288, OFF_GA = 14336, OFF_GB = 18432;
constexpr int MEMT = 256, XW = 512;
constexpr float EPS = 1e-6f;
constexpr float SSQ_INVK = 1.0f / (4096.0f * 1048576.0f);
#ifndef PROBE_PHASE
#define PROBE_REPS 3
#define PROBE_SUB 0
#define PROBE_PHASE -1
#endif
constexpr int NPH = 15;

constexpr size_t MiB = 1u << 20;
constexpr size_t WS_CTL = 0, CTL_ZERO_BYTES = 1 * MiB;
constexpr size_t WS_W1GU = 1 * MiB, WS_W1D = 173 * MiB, WS_W2GU = 259 * MiB, WS_W2D = 431 * MiB, WS_WIN = 517 * MiB;
constexpr size_t WS_WA = 695 * MiB, WS_WB = 711 * MiB, WS_WO = 727 * MiB, WS_WQ = 759 * MiB, WS_WKV = 763 * MiB, WS_WXO = 771 * MiB;
constexpr size_t WS_XN = 775 * MiB;
constexpr size_t WS_R = 839 * MiB;
constexpr size_t WS_DN = 1195 * MiB;
constexpr size_t WS_WC = WS_DN, WS_UB = WS_DN + 64 * MiB, WS_QD = WS_DN + 128 * MiB, WS_KTT = WS_DN + 192 * MiB, WS_AQK = WS_DN + 256 * MiB, WS_GL = WS_DN + 288 * MiB;
constexpr size_t WS_TMP = WS_DN;
constexpr size_t WS_MN = 1484 * MiB, WS_KB = 1492 * MiB, WS_VT = 1493 * MiB, WS_AB = 1494 * MiB, WS_XNB = 1498 * MiB, WS_END = 1562 * MiB;
constexpr size_t WS_O = WS_W1GU, WS_CONVA = WS_W1GU + 64 * MiB, WS_ON = WS_W1GU + 96 * MiB, WS_XO = WS_W1GU + 136 * MiB;
constexpr size_t WS_QP = WS_O;
constexpr int CW_TMO = 0, CW_BAR = 4096;
constexpr size_t WS_SSQ = 65536;
constexpr int RING_BYTES = 131072;
constexpr int ATT_LDS = 256 * 272 + 128 * 528;
constexpr int MISC_OFF = 147456;
constexpr int LDS_BYTES = 151552;
static_assert(ATT_LDS <= MISC_OFF && MISC_OFF + 128 <= LDS_BYTES, "LDS map");

struct OrderPanel : pg8::StaticOrder {
    __device__ __forceinline__ bool next(int i, pg8::Unit& u) const { if (i >= 2) return false; const int x = c & 7, j = c >> 3; u.pm = 16 * i + 8 * (x >> 2) + (j & 7); u.pn = 4 * (x & 3) + (j >> 3); u.g = 0; return true; }
};
constexpr int CW_PANEL = 8192;
struct EpiFinalNorm {
    static constexpr bool PERM = true, AFTER_DRAIN = false, PRE = false;
    const pg8::bf16_t* base; float* out; int ldc; float alpha; unsigned long long* ssq; unsigned* cnt; unsigned* bar; const float* gain;
    __device__ __forceinline__ void operator()(pg8::f32x4 (&acc)[2][2][4][2], const pg8::Unit& u, int wr, int wc, int fr, int fq) const {
        using pg8::f32x4; using pg8::u32x4; using pg8::bf_lo; using pg8::bf_hi;
        constexpr int BM = pg8::BM, HALF = pg8::HALF;
        const int row0 = u.pm * BM + wr * 64 + fr, col0 = u.pn * BM + wc * 32 + 8 * fq;
#pragma unroll
        for (int ai = 0; ai < 2; ++ai) {
            f32x4 b[4][2][2];
#pragma unroll
            for (int m = 0; m < 4; ++m) { const size_t off = (size_t)(row0 + ai * HALF + m * 16) * ldc + col0;
#pragma unroll
                for (int bj = 0; bj < 2; ++bj) { const u32x4 w = *(const u32x4*)(base + off + bj * HALF);
                    b[m][bj][0] = (f32x4){bf_lo(w.x), bf_hi(w.x), bf_lo(w.y), bf_hi(w.y)}; b[m][bj][1] = (f32x4){bf_lo(w.z), bf_hi(w.z), bf_lo(w.w), bf_hi(w.w)}; } }
#pragma unroll
            for (int m = 0; m < 4; ++m) { float ss = 0.f;
#pragma unroll
                for (int bj = 0; bj < 2; ++bj) { const f32x4 o0 = b[m][bj][0] + acc[ai][bj][m][0] * alpha, o1 = b[m][bj][1] + acc[ai][bj][m][1] * alpha;
                    ss += ((o0[0] * o0[0] + o0[1] * o0[1]) + (o0[2] * o0[2] + o0[3] * o0[3])) + ((o1[0] * o1[0] + o1[1] * o1[1]) + (o1[2] * o1[2] + o1[3] * o1[3]));
                    acc[ai][bj][m][0] = o0; acc[ai][bj][m][1] = o1; }
                ss += __shfl_xor(ss, 16); ss += __shfl_xor(ss, 32);
                if (fq == 0) __hip_atomic_fetch_add(ssq + row0 + ai * HALF + m * 16, (unsigned long long)(ss * 1048576.0f + 0.5f), __ATOMIC_RELAXED, __HIP_MEMORY_SCOPE_AGENT); }
        }
        asm volatile("s_waitcnt vmcnt(0)" ::: "memory");
        __builtin_amdgcn_s_barrier();
        if (threadIdx.x == 0) { unsigned* p = cnt + 64 * u.pm; (void)xb_add(p, 1u); XB_SPIN(xb_ld(p) < 16u, bar); }
        __builtin_amdgcn_s_barrier();
        f32x4 gv[2][2];
#pragma unroll
        for (int bj = 0; bj < 2; ++bj) { gv[bj][0] = *(const f32x4*)(gain + col0 + bj * HALF); gv[bj][1] = *(const f32x4*)(gain + col0 + bj * HALF + 4); }
#pragma unroll
        for (int ai = 0; ai < 2; ++ai) {
            float rs[4];
#pragma unroll
            for (int m = 0; m < 4; ++m) rs[m] = (float)__hip_atomic_load(ssq + row0 + ai * HALF + m * 16, __ATOMIC_RELAXED, __HIP_MEMORY_SCOPE_AGENT);
#pragma unroll
            for (int m = 0; m < 4; ++m) { const float r = 1.0f / sqrtf(rs[m] * SSQ_INVK + EPS); float* o = out + (size_t)(row0 + ai * HALF + m * 16) * ldc + col0;
#pragma unroll
                for (int bj = 0; bj < 2; ++bj) { *(f32x4*)(o + bj * HALF) = acc[ai][bj][m][0] * r * gv[bj][0]; *(f32x4*)(o + bj * HALF + 4) = acc[ai][bj][m][1] * r * gv[bj][1]; } }
        }
    }
};

__device__ __forceinline__ float bfl(unsigned w) { return __uint_as_float(w << 16); }
__device__ __forceinline__ float bfh(unsigned w) { return __uint_as_float(w & 0xffff0000u); }
__device__ __forceinline__ float bf1(bf16 v) { return __uint_as_float(((unsigned)v) << 16); }
__device__ __forceinline__ float sigm(float x) { return __builtin_amdgcn_rcpf(1.0f + __builtin_amdgcn_exp2f(-1.4426950408889634f * x)); }
__device__ __forceinline__ float wave_sum(float v) {
#pragma unroll
    for (int o = 1; o < 64; o <<= 1) v += __shfl_xor(v, o);
    return v;
}

#define TW_GAS __attribute__((address_space(1)))
struct TwItem { int k0, n0, drow0; };
__device__ __forceinline__ TwItem tw_item(int kb, int nb, int mode, int roff) {
    TwItem t; t.k0 = 64 * kb; t.n0 = 32 * nb;
    t.drow0 = (mode == 0) ? (roff + t.n0) : (mode == 3) ? ((t.n0 < 14336) ? t.n0 : (t.n0 < 14368) ? (NPP + t.n0 - 14336) : (t.n0 - 32))
                                          : (256 * (t.n0 >> 7) + 128 * (mode - 1) + (t.n0 & 127));
    return t;
}
struct TwDesc { const float* W; bf16* WT; const float* gain; int N, ldk; TwItem t; };
struct TwSet { f32x4 r[10]; bf16* dst; int ldk; int hg; };
__device__ __forceinline__ void tw_load4(TwSet& s, const TwDesc& d, int lane) {
    const float* p = d.W + (size_t)(d.t.k0 + (lane >> 3)) * d.N + d.t.n0 + 4 * (lane & 7);
#pragma unroll
    for (int i = 0; i < 8; ++i) s.r[i] = __builtin_nontemporal_load((const TW_GAS f32x4*)(p + (size_t)(8 * i) * d.N));
    const float* gp = (d.gain ? d.gain : d.W) + d.t.k0 + 8 * (lane & 7);
    s.r[8] = *(const TW_GAS f32x4*)gp; s.r[9] = *(const TW_GAS f32x4*)(gp + 4);
    s.dst = d.WT + (size_t)(d.t.drow0 + (lane >> 3)) * d.ldk + d.t.k0 + 8 * (lane & 7); s.ldk = d.ldk; s.hg = d.gain != nullptr;
}
__device__ __forceinline__ void tw_store4(const TwSet& s, LAS float* scr, int lane) {
#pragma unroll
    for (int i = 0; i < 8; ++i) { LAS float* w = scr + (8 * i + (lane >> 3)) * 33 + 4 * (lane & 7); w[0] = s.r[i].x; w[1] = s.r[i].y; w[2] = s.r[i].z; w[3] = s.r[i].w; }
    LDS_WAIT(); asm volatile("" ::: "memory");
    const int c = lane & 7; const f32x4 one = {1.f, 1.f, 1.f, 1.f};
    const f32x4 g0 = s.hg ? s.r[8] : one, g1 = s.hg ? s.r[9] : one;
#pragma unroll
    for (int j = 0; j < 4; ++j) { const LAS float* t = scr + (8 * c) * 33 + (lane >> 3) + 8 * j;
        v4u o; o.x = pk2(t[0 * 33] * g0.x, t[1 * 33] * g0.y); o.y = pk2(t[2 * 33] * g0.z, t[3 * 33] * g0.w); o.z = pk2(t[4 * 33] * g1.x, t[5 * 33] * g1.y); o.w = pk2(t[6 * 33] * g1.z, t[7 * 33] * g1.w);
        *(TW_GAS v4u*)(s.dst + (size_t)(8 * j) * s.ldk) = o; }
    LDS_WAIT(); asm volatile("" ::: "memory");
}
struct TwJob { const float* W; bf16* WT; const float* gain; int N, ldk, mode, roff, start; };
__device__ __forceinline__ TwJob tw_job(const float* W, int N, bf16* WT, int ldk, int mode, int roff, const float* gain, int start) { TwJob j; j.W = W; j.WT = WT; j.gain = gain; j.N = N; j.ldk = ldk; j.mode = mode; j.roff = roff; j.start = start; return j; }
__device__ __forceinline__ void tw_table_put(LAS int* tb, int idx, const TwJob& j, int lane) {
    if (lane == 0) { LAS int* e = tb + 16 * idx; const unsigned long long w = (unsigned long long)j.W, t = (unsigned long long)j.WT, g = (unsigned long long)j.gain; const unsigned nblk = (unsigned)j.N / 32u;
        e[0] = (int)(unsigned)w; e[1] = (int)(unsigned)(w >> 32); e[2] = (int)(unsigned)t; e[3] = (int)(unsigned)(t >> 32); e[4] = (int)(unsigned)g; e[5] = (int)(unsigned)(g >> 32);
        e[6] = j.N; e[7] = j.ldk; e[8] = j.mode; e[9] = j.roff; e[10] = (int)nblk; e[11] = j.start; e[12] = (int)(0xFFFFFFFFu / nblk + 1u); }
}
template <int NJ>
__device__ __forceinline__ void tw_lookup(const LAS int* tb, const int (&st)[NJ], int q, TwDesc& d) {
    int seg = 0;
#pragma unroll
    for (int j = 1; j < NJ; ++j) seg += (q >= st[j]) ? 1 : 0;
    const LAS int* e = tb + 16 * seg;
#define TW_RF(i) __builtin_amdgcn_readfirstlane(e[i])
    const unsigned wl = TW_RF(0), wh = TW_RF(1), tl = TW_RF(2), th = TW_RF(3), gl = TW_RF(4), gh = TW_RF(5);
    d.W = (const float*)(((unsigned long long)wh << 32) | wl); d.WT = (bf16*)(((unsigned long long)th << 32) | tl); d.gain = (const float*)(((unsigned long long)gh << 32) | gl);
    d.N = TW_RF(6); d.ldk = TW_RF(7);
    const int mode = TW_RF(8), roff = TW_RF(9), nblk = TW_RF(10), start = TW_RF(11); const unsigned magic = TW_RF(12);
#undef TW_RF
    const int item = q - start, kb = (int)__umulhi((unsigned)item, magic), nb = item - kb * nblk;
    d.t = tw_item(kb, nb, mode, roff);
}
template <int NJ>
__device__ __forceinline__ void conv_pipe(const LAS int* tb, const int (&st)[NJ], int q_begin, int q_end, int gw2, int NGW2, LAS float* scr, int lane) {
    const int q0 = q_begin + gw2; if (q0 >= q_end) return;
    const int cnt = (q_end - 1 - q0) / NGW2 + 1;
    TwSet a, b, c, e; TwDesc d;
#define CP_LD(S, idx) { const int i_ = (idx); tw_lookup<NJ>(tb, st, i_ < cnt ? q0 + i_ * NGW2 : q_begin, d); tw_load4(S, d, lane); }
    CP_LD(a, 0) CP_LD(b, 1) CP_LD(c, 2)
    int j = 0;
    for (; j + 4 <= cnt; j += 4) {
        CP_LD(e, j + 3) tw_store4(a, scr, lane);
        CP_LD(a, j + 4) tw_store4(b, scr, lane);
        CP_LD(b, j + 5) tw_store4(c, scr, lane);
        CP_LD(c, j + 6) tw_store4(e, scr, lane);
    }
    const int rem = cnt - j;
    if (rem >= 1) tw_store4(a, scr, lane);
    if (rem >= 2) tw_store4(b, scr, lane);
    if (rem >= 3) tw_store4(c, scr, lane);
#undef CP_LD
}
constexpr int TW_TABLE = 2304;
template <bool OUT_F32>
__device__ __forceinline__ void rms_rows(const float* X, const float* w, void* out, int nrows, int gw, int NGW, int lane) {
    for (int m = gw; m < nrows; m += NGW) {
        const f32x4* xr = (const f32x4*)(X + (size_t)m * D) + lane;
        f32x4 v[16]; float s = 0.f;
#pragma unroll
        for (int j = 0; j < 16; ++j) { v[j] = xr[64 * j]; s += (v[j].x * v[j].x + v[j].y * v[j].y) + (v[j].z * v[j].z + v[j].w * v[j].w); }
        const float rstd = 1.0f / sqrtf(wave_sum(s) * (1.0f / D) + EPS);
        const f32x4* wr = (const f32x4*)w + lane;
        if (OUT_F32) { f32x4* o = (f32x4*)((float*)out + (size_t)m * D) + lane;
#pragma unroll
            for (int j = 0; j < 16; ++j) { const f32x4 g = wr[64 * j]; o[64 * j] = v[j] * rstd * g; }
        } else { unsigned long long* o8 = (unsigned long long*)((bf16*)out + (size_t)m * D) + lane;
#pragma unroll
            for (int j = 0; j < 16; ++j) { const f32x4 g = wr[64 * j]; const f32x4 y = v[j] * rstd * g;
                o8[64 * j] = (unsigned long long)pk2(y.x, y.y) | ((unsigned long long)pk2(y.z, y.w) << 32); } }
    }
}

__device__ __forceinline__ void final_norm(const bf16* HBp, const unsigned long long* ssq, const float* w, float* out, int gw, int NGW, int lane) {
    for (int m = gw; m < M; m += NGW) {
        const float rstd = 1.0f / sqrtf((float)ssq[m] * SSQ_INVK + EPS);
        const v4u* hr = (const v4u*)(HBp + (size_t)m * D) + lane; f32x4* o = (f32x4*)(out + (size_t)m * D) + 2 * lane; const f32x4* wr = (const f32x4*)w + 2 * lane;
#pragma unroll
        for (int j = 0; j < 8; ++j) { const v4u h = hr[64 * j]; const f32x4 g0 = wr[128 * j], g1 = wr[128 * j + 1];
            o[128 * j] = (f32x4){bfl(h.x), bfh(h.x), bfl(h.y), bfh(h.y)} * rstd * g0; o[128 * j + 1] = (f32x4){bfl(h.z), bfh(h.z), bfl(h.w), bfh(h.w)} * rstd * g1; }
    }
}

__device__ __forceinline__ void conv_branch_a(const bf16* proj, const float* conv_w, bf16* outA, int idx0, int idx1, int stride) {
    for (int idx = idx0; idx < idx1; idx += stride) {
        const int row = idx >> 8, c0 = (idx & 255) * 8, s = row & (SEQ - 1);
        float y[8];
#pragma unroll
        for (int e = 0; e < 8; ++e) y[e] = 0.f;
#pragma unroll
        for (int k = 0; k < 3; ++k) {
            const int sk = s - 2 + k; const float mk = (sk >= 0) ? 1.f : 0.f;
            const bf16* pr = proj + (size_t)(sk >= 0 ? row - 2 + k : row) * NPP;
            const v4u xc = *(const v4u*)(pr + OFF_CX + c0), cc = *(const v4u*)(pr + OFF_CC + c0);
            const f32x4 w0 = *(const f32x4*)(conv_w + k * CW + c0) * mk, w1 = *(const f32x4*)(conv_w + k * CW + c0 + 4) * mk;
            y[0] += w0.x * (bfl(xc.x) * bfl(cc.x)); y[1] += w0.y * (bfh(xc.x) * bfh(cc.x)); y[2] += w0.z * (bfl(xc.y) * bfl(cc.y)); y[3] += w0.w * (bfh(xc.y) * bfh(cc.y));
            y[4] += w1.x * (bfl(xc.z) * bfl(cc.z)); y[5] += w1.y * (bfh(xc.z) * bfh(cc.z)); y[6] += w1.z * (bfl(xc.w) * bfl(cc.w)); y[7] += w1.w * (bfh(xc.w) * bfh(cc.w));
        }
        const v4u cb = *(const v4u*)(proj + (size_t)row * NPP + OFF_CB + c0);
        v4u o; o.x = pk2(y[0] * bfl(cb.x), y[1] * bfh(cb.x)); o.y = pk2(y[2] * bfl(cb.y), y[3] * bfh(cb.y)); o.z = pk2(y[4] * bfl(cb.z), y[5] * bfh(cb.z)); o.w = pk2(y[6] * bfl(cb.w), y[7] * bfh(cb.w));
        *(v4u*)(outA + (size_t)row * CW + c0) = o;
    }
}

constexpr int XS = 136, LS = 68;
constexpr int CH_LDS = 3 * 64 * XS * 2 + 64 * LS * 4 + 4 * 64 * 4;
static_assert(2 * CH_LDS <= MISC_OFF, "two chunks per workgroup");
__device__ __forceinline__ void dn_chunk_pair(const bf16* proj, const float* AB, const unsigned long long* ssq, const float* qkv_w, const float* a_log, const float* dt_bias, unsigned char* ws, LAS unsigned char* lds, int pair, int tid, const float* conv_w, bf16* convA) {
    const int lane = tid & 63, wave = __builtin_amdgcn_readfirstlane(tid >> 6), half = wave >> 2, wv = wave & 3, th = tid & 255;
    const int cid = pair * 2 + half, bh = cid >> 5, n = cid & 31, b = bh >> 4, h = bh & 15;
    LAS unsigned char* hb = lds + half * CH_LDS;
    LAS bf16* Qb = (LAS bf16*)hb; LAS bf16* Kb = Qb + 64 * XS; LAS bf16* Vb = Kb + 64 * XS; LAS float* Lt = (LAS float*)(Vb + 64 * XS);
    LAS float* GC = Lt + 64 * LS; LAS float* BETA = GC + 64; LAS float* EGC = BETA + 64; LAS float* ETAIL = EGC + 64;
    const size_t rowb = (size_t)b * SEQ;
    bf16* WC = (bf16*)(ws + WS_WC) + (size_t)cid * 8192; bf16* UB = (bf16*)(ws + WS_UB) + (size_t)cid * 8192; bf16* QD = (bf16*)(ws + WS_QD) + (size_t)cid * 8192;
    bf16* KTT = (bf16*)(ws + WS_KTT) + (size_t)cid * 8192; bf16* AQK = (bf16*)(ws + WS_AQK) + (size_t)cid * 4096; float* GL = (float*)(ws + WS_GL);
    const int c0 = (th & 15) * 8, i0 = (th >> 4) * 4;
    v4u raw[3][7];
#pragma unroll
    for (int mat = 0; mat < 3; ++mat)
#pragma unroll
        for (int t = 0; t < 7; ++t) { const int st = n * CH + i0 - 3 + t; raw[mat][t] = *(const v4u*)(proj + (rowb + (st >= 0 ? st : 0)) * NPP + OFF_Q + mat * DNW + h * HD + c0); }
    float abv[8];
    { const size_t row = rowb + n * CH + lane;
#pragma unroll
      for (int q = 0; q < 4; ++q) { abv[2 * q] = AB[(size_t)q * M * 32 + row * 32 + 16 + h]; abv[2 * q + 1] = AB[(size_t)q * M * 32 + row * 32 + h]; } }
    float egc_l, etail_l, glast_e;
    {
        const size_t row = rowb + n * CH + lane;
        float al = 0.f, bl = 0.f;
#pragma unroll
        for (int q = 0; q < 4; ++q) { al += abv[2 * q]; bl += abv[2 * q + 1]; }
        const float rs = 1.0f / sqrtf((float)ssq[row] * SSQ_INVK + EPS); al *= rs; bl *= rs;
        const float xx = al + dt_bias[h];
        const float sp = fmaxf(xx, 0.f) + log1pf(expf(-fabsf(xx)));
        float g = -expf(a_log[h]) * sp;
#pragma unroll
        for (int d = 1; d < 64; d <<= 1) { const float t = __shfl_up(g, d); if (lane >= d) g += t; }
        const float glast = __shfl(g, 63);
        egc_l = expf(g); etail_l = expf(glast - g);
        glast_e = expf(glast);
        if (wv == 0) { GC[lane] = g; BETA[lane] = 1.0f / (1.0f + expf(-bl)); EGC[lane] = egc_l; ETAIL[lane] = etail_l; }
    }
    {
        v4u qdv[4];
#pragma unroll
        for (int mat = 0; mat < 3; ++mat) {
            const int wcol = mat * DNW + h * HD + c0;
            f32x4 w[4][2];
#pragma unroll
            for (int j = 0; j < 4; ++j) { w[j][0] = *(const f32x4*)(qkv_w + j * (3 * DNW) + wcol); w[j][1] = *(const f32x4*)(qkv_w + j * (3 * DNW) + wcol + 4); }
#pragma unroll
            for (int t = 0; t < 7; ++t) { const int st = n * CH + i0 - 3 + t; if (st < 0) raw[mat][t] = (v4u){0u, 0u, 0u, 0u}; }
            LAS bf16* X = (mat == 0) ? Qb : (mat == 1) ? Kb : Vb;
#pragma unroll
            for (int j4 = 0; j4 < 4; ++j4) {
                const int i = i0 + j4;
                f32x4 a0 = {0.f, 0.f, 0.f, 0.f}, a1 = {0.f, 0.f, 0.f, 0.f};
#pragma unroll
                for (int j = 0; j < 4; ++j) { const v4u r = raw[mat][j4 + j];
                    a0.x += w[j][0].x * bfl(r.x); a0.y += w[j][0].y * bfh(r.x); a0.z += w[j][0].z * bfl(r.y); a0.w += w[j][0].w * bfh(r.y);
                    a1.x += w[j][1].x * bfl(r.z); a1.y += w[j][1].y * bfh(r.z); a1.z += w[j][1].z * bfl(r.w); a1.w += w[j][1].w * bfh(r.w); }
#pragma unroll
                for (int e = 0; e < 4; ++e) { a0[e] = a0[e] * sigm(a0[e]); a1[e] = a1[e] * sigm(a1[e]); }
                if (mat < 2) {
                    float ss = (a0.x * a0.x + a0.y * a0.y) + (a0.z * a0.z + a0.w * a0.w) + (a1.x * a1.x + a1.y * a1.y) + (a1.z * a1.z + a1.w * a1.w);
                    ss += __shfl_xor(ss, 1); ss += __shfl_xor(ss, 2); ss += __shfl_xor(ss, 4); ss += __shfl_xor(ss, 8);
                    float sc = 1.0f / sqrtf(ss + EPS); if (mat == 0) sc *= 0.08838834764831845f;
                    a0 = a0 * sc; a1 = a1 * sc;
                }
                v4u o; o.x = pk2(a0.x, a0.y); o.y = pk2(a0.z, a0.w); o.z = pk2(a1.x, a1.y); o.w = pk2(a1.z, a1.w);
                *(LAS v4u*)(X + i * XS + c0) = o;
                if (mat == 0) { const float eg = __shfl(egc_l, i); a0 = a0 * eg; a1 = a1 * eg;
                    v4u q; q.x = pk2(a0.x, a0.y); q.y = pk2(a0.z, a0.w); q.z = pk2(a1.x, a1.y); q.w = pk2(a1.z, a1.w); qdv[j4] = q; }
            }
        }
#pragma unroll
        for (int j4 = 0; j4 < 4; ++j4) *(v4u*)(QD + (i0 + j4) * 128 + c0) = qdv[j4];
        if (wv == 0 && lane == 63) GL[cid] = glast_e;
    }
    __syncthreads();
    {
        const int r = lane & 15, kq = lane >> 4;
        for (int job = wv; job < 26; job += 4) {
            int prod, it, jt;
            if (job < 10) { prod = 0; it = (job >= 6) ? 3 : (job >= 3) ? 2 : (job >= 1) ? 1 : 0; jt = job - (it * (it + 1)) / 2; }
            else { prod = 1; it = (job - 10) >> 2; jt = (job - 10) & 3; }
            f32x4 acc = {0.f, 0.f, 0.f, 0.f};
            if (jt <= it) {
                const LAS bf16* Ab = (prod ? Qb : Kb) + (16 * it + r) * XS + 8 * kq; const LAS bf16* Bb = Kb + (16 * jt + r) * XS + 8 * kq;
#pragma unroll
                for (int ks = 0; ks < 4; ++ks) acc = __builtin_amdgcn_mfma_f32_16x16x32_bf16(*(const LAS bf16x8*)(Ab + 32 * ks), *(const LAS bf16x8*)(Bb + 32 * ks), acc, 0, 0, 0);
            }
            const int jx = 16 * jt + r; const float gcj = GC[jx];
            f32x4 o;
#pragma unroll
            for (int reg = 0; reg < 4; ++reg) { const int ix = 16 * it + 4 * kq + reg; const float dec = expf(GC[ix] - gcj);
                if (prod == 0) o[reg] = (ix > jx) ? BETA[ix] * acc[reg] * dec : 0.f;
                else o[reg] = (ix >= jx) ? acc[reg] * dec : 0.f; }
            if (prod == 0) *(LAS f32x4*)(Lt + jx * LS + 16 * it + 4 * kq) = o;
            else {
#pragma unroll
                for (int reg = 0; reg < 4; ++reg) AQK[(16 * it + 4 * kq + reg) * 64 + jx] = (bf16)f2bf(o[reg]); }
        }
    }
    __syncthreads();
    constexpr int TS = 68;
    LAS bf16* Tv = Qb; LAS bf16* Tk = Qb + 64 * TS;
    if (wv == half) {
        int zv = 0; asm volatile("" : "+v"(zv));
        const LAS float* LtV = Lt + zv;
        float x[64];
#pragma unroll
        for (int i = 0; i < 64; ++i) x[i] = (i == lane) ? 1.0f : 0.0f;
        f32x4 lr[16];
#define DN_FMAQ(J, Q) { _Pragma("unroll") for (int ii = 4 * (Q); ii < 4 * (Q) + 4; ++ii) { if (ii >= (((J) + 1) >> 2)) { _Pragma("unroll") for (int e = 0; e < 4; ++e) { if (4 * ii + e > (J)) x[4 * ii + e] -= lr[ii][e] * xj; } } } }
#define DN_LDQ(J, Q) { _Pragma("unroll") for (int ii = 4 * (Q); ii < 4 * (Q) + 4; ++ii) { if ((J) < 63 && ii >= (((J) + 1) >> 2)) lr[ii] = *(const LAS f32x4*)(LtV + (J) * LS + 4 * ii); } __builtin_amdgcn_sched_barrier(0); }
#define DN_ROW(J) { const float xj = x[J]; DN_FMAQ(J, 0) DN_LDQ((J) + 1, 0) DN_FMAQ(J, 1) DN_LDQ((J) + 1, 1) DN_FMAQ(J, 2) DN_LDQ((J) + 1, 2) DN_FMAQ(J, 3) DN_LDQ((J) + 1, 3) }
        DN_LDQ(0, 0) DN_LDQ(0, 1) DN_LDQ(0, 2) DN_LDQ(0, 3)
        DN_ROW(0)
        DN_ROW(1)
        DN_ROW(2)
        DN_ROW(3)
        DN_ROW(4)
        DN_ROW(5)
        DN_ROW(6)
        DN_ROW(7)
        DN_ROW(8)
        DN_ROW(9)
        DN_ROW(10)
        DN_ROW(11)
        DN_ROW(12)
        DN_ROW(13)
        DN_ROW(14)
        DN_ROW(15)
        DN_ROW(16)
        DN_ROW(17)
        DN_ROW(18)
        DN_ROW(19)
        DN_ROW(20)
        DN_ROW(21)
        DN_ROW(22)
        DN_ROW(23)
        DN_ROW(24)
        DN_ROW(25)
        DN_ROW(26)
        DN_ROW(27)
        DN_ROW(28)
        DN_ROW(29)
        DN_ROW(30)
        DN_ROW(31)
        DN_ROW(32)
        DN_ROW(33)
        DN_ROW(34)
        DN_ROW(35)
        DN_ROW(36)
        DN_ROW(37)
        DN_ROW(38)
        DN_ROW(39)
        DN_ROW(40)
        DN_ROW(41)
        DN_ROW(42)
        DN_ROW(43)
        DN_ROW(44)
        DN_ROW(45)
        DN_ROW(46)
        DN_ROW(47)
        DN_ROW(48)
        DN_ROW(49)
        DN_ROW(50)
        DN_ROW(51)
        DN_ROW(52)
        DN_ROW(53)
        DN_ROW(54)
        DN_ROW(55)
        DN_ROW(56)
        DN_ROW(57)
        DN_ROW(58)
        DN_ROW(59)
        DN_ROW(60)
        DN_ROW(61)
        DN_ROW(62)
#undef DN_FMAQ
#undef DN_LDQ
#undef DN_ROW
        const float bv = BETA[lane], bk = bv * EGC[lane];
#pragma unroll
        for (int i = 0; i < 64; ++i) { Tv[i * TS + lane] = (bf16)f2bf(x[i] * bv); Tk[i * TS + lane] = (bf16)f2bf(x[i] * bk); }
    } else {
        const int w3 = (wv > half) ? wv - 1 : wv; const float et = etail_l; const int i = lane;
#pragma unroll 4
        for (int d = w3; d < 128; d += 3) KTT[d * 64 + i] = (bf16)f2bf(bf1(Kb[i * XS + d]) * et);
        conv_branch_a(proj, conv_w, convA, pair * 2048 + (half * 3 + w3) * 64 + lane, (pair + 1) * 2048, 384);
    }
    __syncthreads();
    {
        typedef short v4i16_t __attribute__((ext_vector_type(4)));
        const int r = lane & 15, kq = lane >> 4, q4 = r >> 2, p4 = r & 3;
        bf16x8 av[2], ak[2];
#pragma unroll
        for (int ks = 0; ks < 2; ++ks) { const LAS unsigned long long* pv = (const LAS unsigned long long*)(Tv + (16 * wv + r) * TS + 32 * ks + 8 * kq); const LAS unsigned long long* pk = (const LAS unsigned long long*)(Tk + (16 * wv + r) * TS + 32 * ks + 8 * kq);
            const unsigned long long v0 = pv[0], v1 = pv[1], k0 = pk[0], k1 = pk[1];
            v4u wv4; wv4.x = (unsigned)v0; wv4.y = (unsigned)(v0 >> 32); wv4.z = (unsigned)v1; wv4.w = (unsigned)(v1 >> 32); av[ks] = __builtin_bit_cast(bf16x8, wv4);
            v4u wk4; wk4.x = (unsigned)k0; wk4.y = (unsigned)(k0 >> 32); wk4.z = (unsigned)k1; wk4.w = (unsigned)(k1 >> 32); ak[ks] = __builtin_bit_cast(bf16x8, wk4); }
#pragma unroll
        for (int part = 0; part < 2; ++part) {
            const LAS bf16* Bsrc = part ? Kb : Vb;
#pragma unroll
            for (int ct = 0; ct < 8; ++ct) {
                f32x4 acc = {0.f, 0.f, 0.f, 0.f};
#pragma unroll
                for (int ks = 0; ks < 2; ++ks) {
                    const LAS bf16* bp = Bsrc + (32 * ks + 8 * kq + q4) * XS + 16 * ct + 4 * p4;
                    const v4i16_t t0 = __builtin_amdgcn_ds_read_tr16_b64_v4i16((LAS v4i16_t*)bp), t1 = __builtin_amdgcn_ds_read_tr16_b64_v4i16((LAS v4i16_t*)(bp + 4 * XS));
                    bf16x8 bfrag; bfrag[0] = t0[0]; bfrag[1] = t0[1]; bfrag[2] = t0[2]; bfrag[3] = t0[3]; bfrag[4] = t1[0]; bfrag[5] = t1[1]; bfrag[6] = t1[2]; bfrag[7] = t1[3];
                    acc = __builtin_amdgcn_mfma_f32_16x16x32_bf16(bfrag, part ? ak[ks] : av[ks], acc, 0, 0, 0);
                }
                const int o = (16 * wv + r) * 128 + 16 * ct + 4 * kq;
                if (part == 0) *(unsigned long long*)(UB + o) = (unsigned long long)pk2(acc.x, acc.y) | ((unsigned long long)pk2(acc.z, acc.w) << 32);
                else *(unsigned long long*)(WC + o) = (unsigned long long)pk2(-acc.x, -acc.y) | ((unsigned long long)pk2(-acc.z, -acc.w) << 32);
            }
        }
    }
    __syncthreads();
}

constexpr int SSB = 136, USB = 72;
#define LDS_BARRIER() do { asm volatile("s_waitcnt lgkmcnt(0)" ::: "memory"); __builtin_amdgcn_s_barrier(); asm volatile("" ::: "memory"); } while (0)
__device__ __forceinline__ unsigned long long pk4(const f32x4 v) { return (unsigned long long)pk2(v.x, v.y) | ((unsigned long long)pk2(v.z, v.w) << 32); }
struct ScanOps { bf16x8 wcf[4], qdf[4], aqf[2], ktf[2]; f32x4 ubv; };
struct SideJob { const float* Wg; const float* Wu; const float* Wd; bf16* Tgu; bf16* Td; const float* gain; LAS float* scr; int q0; };
constexpr int SIDE_IG = (D / 64) * (FF / 32);
__device__ __forceinline__ void side_desc(const SideJob& J, int q, TwDesc& d) {
    if (q < SIDE_IG) { d.W = J.Wg; d.N = FF; d.WT = J.Tgu; d.ldk = D; d.gain = J.gain; d.t = tw_item(q / (FF / 32), q % (FF / 32), 1, 0); }
    else if (q < 2 * SIDE_IG) { const int i = q - SIDE_IG; d.W = J.Wu; d.N = FF; d.WT = J.Tgu; d.ldk = D; d.gain = J.gain; d.t = tw_item(i / (FF / 32), i % (FF / 32), 2, 0); }
    else { const int i = q - 2 * SIDE_IG; d.W = J.Wd; d.N = D; d.WT = J.Td; d.ldk = FF; d.gain = nullptr; d.t = tw_item(i / (D / 32), i % (D / 32), 0, 0); }
}
constexpr int SIDE_SCAN_STEPS = 24, SIDE_ITEMS = 2048 * SIDE_SCAN_STEPS;
struct ScanPtrs { const bf16* WCb; const bf16* QDb; const bf16* KTb; const bf16* AQb; const bf16* UBb; const float* GLb; int offW, offA, offK, offU; };
__device__ __forceinline__ void scan_load_a(ScanOps& o, const ScanPtrs& p, int n) {
#pragma unroll
    for (int ks = 0; ks < 4; ++ks) { o.wcf[ks] = *(const bf16x8*)(p.WCb + (size_t)n * 8192 + p.offW + 32 * ks); o.qdf[ks] = *(const bf16x8*)(p.QDb + (size_t)n * 8192 + p.offW + 32 * ks); }
#pragma unroll
    for (int reg = 0; reg < 4; ++reg) o.ubv[reg] = bf1(p.UBb[(size_t)n * 8192 + p.offU + reg * 128]);
}
__device__ __forceinline__ void scan_load_b(ScanOps& o, const ScanPtrs& p, int n) {
#pragma unroll
    for (int ks = 0; ks < 2; ++ks) { o.aqf[ks] = *(const bf16x8*)(p.AQb + (size_t)n * 4096 + p.offA + 32 * ks); o.ktf[ks] = *(const bf16x8*)(p.KTb + (size_t)n * 8192 + p.offK + 32 * ks); }
}
__device__ __forceinline__ void scan_step(const ScanOps& cur, ScanOps& nxt, const ScanPtrs& p, LAS bf16* St, LAS bf16* Ut, f32x4& s0, f32x4& s1, bf16* orow, float gl, int nn, int r, int kq, int rt, int ct, int wave,
                                          const SideJob& J, const TwSet& sc_cur, TwSet& sc_nxt, int qcur, int qnxt, int lane) {
    f32x4 accU = cur.ubv, accO = {0.f, 0.f, 0.f, 0.f};
    const LAS bf16* srow = St + (16 * ct + r) * SSB + 8 * kq;
#pragma unroll
    for (int ks = 0; ks < 4; ++ks) { const bf16x8 sf = *(const LAS bf16x8*)(srow + 32 * ks);
        accU = __builtin_amdgcn_mfma_f32_16x16x32_bf16(cur.wcf[ks], sf, accU, 0, 0, 0); accO = __builtin_amdgcn_mfma_f32_16x16x32_bf16(sf, cur.qdf[ks], accO, 0, 0, 0); }
    *(LAS unsigned long long*)(Ut + (16 * ct + r) * USB + 16 * rt + 4 * kq) = pk4(accU);
    scan_load_a(nxt, p, nn);
    if (qnxt >= 0) { TwDesc d; side_desc(J, qnxt, d); tw_load4(sc_nxt, d, lane); }
    LDS_BARRIER();
    const LAS bf16* urow = Ut + (16 * ct + r) * USB + 8 * kq;
#pragma unroll
    for (int ks = 0; ks < 2; ++ks) { const bf16x8 uf = *(const LAS bf16x8*)(urow + 32 * ks); accO = __builtin_amdgcn_mfma_f32_16x16x32_bf16(uf, cur.aqf[ks], accO, 0, 0, 0); }
    *(unsigned long long*)orow = pk4(accO);
    s0 = s0 * gl; s1 = s1 * gl;
    const LAS bf16* u0 = Ut + r * USB + 8 * kq; const LAS bf16* u1 = Ut + (16 + r) * USB + 8 * kq;
#pragma unroll
    for (int ks = 0; ks < 2; ++ks) { const bf16x8 a8 = *(const LAS bf16x8*)(u0 + 32 * ks), b8 = *(const LAS bf16x8*)(u1 + 32 * ks);
        s0 = __builtin_amdgcn_mfma_f32_16x16x32_bf16(cur.ktf[ks], a8, s0, 0, 0, 0); s1 = __builtin_amdgcn_mfma_f32_16x16x32_bf16(cur.ktf[ks], b8, s1, 0, 0, 0); }
    scan_load_b(nxt, p, nn);
    if (qcur >= 0) tw_store4(sc_cur, J.scr, lane);
    *(LAS unsigned long long*)(St + r * SSB + 16 * wave + 4 * kq) = pk4(s0); *(LAS unsigned long long*)(St + (16 + r) * SSB + 16 * wave + 4 * kq) = pk4(s1);
    LDS_BARRIER();
}
__device__ __forceinline__ void dn_scan_unit(unsigned char* ws, LAS unsigned char* lds, bf16* O, int unit, int tid, SideJob J) {
    const int lane = tid & 63, wave = __builtin_amdgcn_readfirstlane(tid >> 6), r = lane & 15, kq = lane >> 4;
    const int bh = unit >> 2, vs = unit & 3, b = bh >> 4, h = bh & 15;
    const int rt = wave >> 1, ct = wave & 1;
    LAS bf16* St = (LAS bf16*)lds; LAS bf16* Ut = St + 32 * SSB;
    { int tz = tid; asm volatile("" : "+v"(tz));
      for (int i = tz; i < 32 * SSB / 2; i += NTHREADS) ((LAS unsigned*)St)[i] = 0u; }
    f32x4 s0 = {0.f, 0.f, 0.f, 0.f}, s1 = {0.f, 0.f, 0.f, 0.f};
    ScanPtrs p;
    p.offW = (16 * rt + r) * 128 + 8 * kq; p.offA = (16 * rt + r) * 64 + 8 * kq; p.offK = (16 * wave + r) * 64 + 8 * kq; p.offU = (16 * rt + 4 * kq) * 128 + vs * 32 + 16 * ct + r;
    p.WCb = (const bf16*)(ws + WS_WC) + (size_t)bh * NCH * 8192; p.UBb = (const bf16*)(ws + WS_UB) + (size_t)bh * NCH * 8192; p.QDb = (const bf16*)(ws + WS_QD) + (size_t)bh * NCH * 8192;
    p.KTb = (const bf16*)(ws + WS_KTT) + (size_t)bh * NCH * 8192; p.AQb = (const bf16*)(ws + WS_AQK) + (size_t)bh * NCH * 4096; p.GLb = (const float*)(ws + WS_GL) + (size_t)bh * NCH;
    ScanOps A, B;
    scan_load_a(A, p, 0); scan_load_b(A, p, 0);
    TwSet scA, scB;
    J.scr = (LAS float*)(lds + 16384 + wave * 8704);
    { TwDesc d; side_desc(J, J.q0, d); tw_load4(scA, d, lane); }
    const int glall = __float_as_int(p.GLb[lane & 31]);
    LDS_BARRIER();
    bf16* orow = O + ((size_t)b * SEQ + 16 * rt + r) * DNW + h * HD + vs * 32 + 16 * ct + 4 * kq;
#pragma unroll
    for (int n = 0; n < NCH; n += 2) {
        scan_step(A, B, p, St, Ut, s0, s1, orow + (size_t)n * CH * DNW, __int_as_float(__builtin_amdgcn_readlane(glall, n)), n + 1, r, kq, rt, ct, wave, J, scA, scB, (n < SIDE_SCAN_STEPS) ? J.q0 + n * 2048 : -1, (n + 1 < SIDE_SCAN_STEPS) ? J.q0 + (n + 1) * 2048 : -1, lane);
        scan_step(B, A, p, St, Ut, s0, s1, orow + (size_t)(n + 1) * CH * DNW, __int_as_float(__builtin_amdgcn_readlane(glall, n + 1)), (n + 2 < NCH) ? n + 2 : n + 1, r, kq, rt, ct, wave, J, scB, scA, (n + 1 < SIDE_SCAN_STEPS) ? J.q0 + (n + 1) * 2048 : -1, (n + 2 < SIDE_SCAN_STEPS) ? J.q0 + (n + 2) * 2048 : -1, lane);
    }
    __syncthreads();
}

__device__ __forceinline__ void ab_logits(const bf16* XN, const bf16* Wab, float* ABP, int job, int lane) {
    const int r = lane & 15, kq = lane >> 4, tile = job >> 2, q = job & 3;
    const bf16* ap = XN + (size_t)(16 * tile + r) * D + q * (D / 4) + 8 * kq; const bf16* b0p = Wab + (size_t)r * D + q * (D / 4) + 8 * kq; const bf16* b1p = b0p + (size_t)16 * D;
    f32x4 acc0 = {0.f, 0.f, 0.f, 0.f}, acc1 = {0.f, 0.f, 0.f, 0.f};
#pragma unroll 16
    for (int ks = 0; ks < D / 128; ++ks) { const bf16x8 a = *(const bf16x8*)(ap + 32 * ks), b0 = *(const bf16x8*)(b0p + 32 * ks), b1 = *(const bf16x8*)(b1p + 32 * ks);
        acc0 = __builtin_amdgcn_mfma_f32_16x16x32_bf16(a, b0, acc0, 0, 0, 0); acc1 = __builtin_amdgcn_mfma_f32_16x16x32_bf16(a, b1, acc1, 0, 0, 0); }
    float* o = ABP + (size_t)q * M * 32 + (size_t)(16 * tile + 4 * kq) * 32 + r;
#pragma unroll
    for (int reg = 0; reg < 4; ++reg) { o[reg * 32] = acc0[reg]; o[reg * 32 + 16] = acc1[reg]; }
}

__device__ __forceinline__ void dn_gated_norm(const bf16* O, const bf16* proj, const float* wn, bf16* ON, int gtid, int NT) {
    constexpr int TOTAL = M * NH * 16;
    const int sub = gtid & 15;
    const f32x4 w0 = *(const f32x4*)(wn + sub * 8), w1 = *(const f32x4*)(wn + sub * 8 + 4);
    for (int idx = gtid; idx < TOTAL; idx += 4 * NT) {
        v4u ow[4], zw[4]; size_t oo[4];
#pragma unroll
        for (int u = 0; u < 4; ++u) { const int i = (idx + u * NT < TOTAL) ? idx + u * NT : idx, pair = i >> 4, row = pair >> 4, h = pair & 15, c = h * HD + sub * 8;
            oo[u] = (size_t)row * DNW + c; ow[u] = *(const v4u*)(O + oo[u]); zw[u] = *(const v4u*)(proj + (size_t)row * NPP + OFF_Z + c); }
#pragma unroll
        for (int u = 0; u < 4; ++u) {
            const f32x4 o0 = {bfl(ow[u].x), bfh(ow[u].x), bfl(ow[u].y), bfh(ow[u].y)}, o1 = {bfl(ow[u].z), bfh(ow[u].z), bfl(ow[u].w), bfh(ow[u].w)};
            float ss = (o0.x * o0.x + o0.y * o0.y) + (o0.z * o0.z + o0.w * o0.w) + (o1.x * o1.x + o1.y * o1.y) + (o1.z * o1.z + o1.w * o1.w);
            ss += __shfl_xor(ss, 1); ss += __shfl_xor(ss, 2); ss += __shfl_xor(ss, 4); ss += __shfl_xor(ss, 8);
            const float rstd = 1.0f / sqrtf(ss * (1.0f / HD) + EPS);
            const v4u z = zw[u];
            const float z0 = bfl(z.x), z1 = bfh(z.x), z2 = bfl(z.y), z3 = bfh(z.y), z4 = bfl(z.z), z5 = bfh(z.z), z6 = bfl(z.w), z7 = bfh(z.w);
            v4u o; o.x = pk2(o0.x * rstd * w0.x * (z0 * sigm(z0)), o0.y * rstd * w0.y * (z1 * sigm(z1))); o.y = pk2(o0.z * rstd * w0.z * (z2 * sigm(z2)), o0.w * rstd * w0.w * (z3 * sigm(z3)));
            o.z = pk2(o1.x * rstd * w1.x * (z4 * sigm(z4)), o1.y * rstd * w1.y * (z5 * sigm(z5))); o.w = pk2(o1.z * rstd * w1.z * (z6 * sigm(z6)), o1.w * rstd * w1.w * (z7 * sigm(z7)));
            if (idx + u * NT < TOTAL) *(v4u*)(ON + oo[u]) = o;
        }
    }
}

__device__ __forceinline__ void xattn_unit(const bf16* QP, const unsigned long long* ssq, const bf16* KB, const bf16* VT, bf16* XO, LAS unsigned char* lds, int unit, int tid) {
    const int lane = tid & 63, wave = __builtin_amdgcn_readfirstlane(tid >> 6), r = lane & 15, kq = lane >> 4;
    const int b = unit >> 6, hd = (unit >> 4) & 3, qt = unit & 15;
    LAS unsigned char* Ksm = lds; LAS unsigned char* Vtm = lds + 256 * 272;
    {
        const int seg = tid & 15, rr = tid >> 4;
#pragma unroll
        for (int p = 0; p < 8; ++p) { const int key = rr + 32 * p; const v4u v = *(const v4u*)(KB + (size_t)(b * MEMT + key) * XW + hd * HD + seg * 8); *(LAS v4u*)(Ksm + key * 272 + seg * 16) = v; }
        const int seg2 = tid & 31, r2 = tid >> 5;
#pragma unroll
        for (int p = 0; p < 8; ++p) { const int d = r2 + 16 * p; const v4u v = *(const v4u*)(VT + ((size_t)(b * 4 + hd) * HD + d) * MEMT + seg2 * 8); *(LAS v4u*)(Vtm + d * 528 + seg2 * 16) = v; }
    }
    const size_t qrow = (size_t)b * SEQ + qt * 128 + wave * 16 + r;
    bf16x8 qf[4];
    const float qs = 0.08838834764831845f * 1.4426950408889634f / sqrtf((float)ssq[qrow] * SSQ_INVK + EPS);
#pragma unroll
    for (int ks = 0; ks < 4; ++ks) { const bf16* qp = QP + qrow * XW + hd * HD + 32 * ks + 8 * kq; f32x4 a = {0.f, 0.f, 0.f, 0.f}, c = {0.f, 0.f, 0.f, 0.f};
#pragma unroll
        for (int g = 0; g < 4; ++g) { const v4u p = *(const v4u*)(qp + (size_t)g * M * XW); a += (f32x4){bfl(p.x), bfh(p.x), bfl(p.y), bfh(p.y)}; c += (f32x4){bfl(p.z), bfh(p.z), bfl(p.w), bfh(p.w)}; }
        a = a * qs; c = c * qs;
        v4u w; w.x = pk2(a.x, a.y); w.y = pk2(a.z, a.w); w.z = pk2(c.x, c.y); w.w = pk2(c.z, c.w); qf[ks] = __builtin_bit_cast(bf16x8, w); }
    __syncthreads();
    f32x4 sc[16];
#pragma unroll
    for (int t = 0; t < 16; ++t) { sc[t] = (f32x4){0.f, 0.f, 0.f, 0.f};
#pragma unroll
        for (int ks = 0; ks < 4; ++ks) { const bf16x8 kf = *(const LAS bf16x8*)(Ksm + (16 * t + r) * 272 + (32 * ks + 8 * kq) * 2);
            sc[t] = __builtin_amdgcn_mfma_f32_16x16x32_bf16(kf, qf[ks], sc[t], 0, 0, 0); } }
    float mx = -3.0e38f;
#pragma unroll
    for (int t = 0; t < 16; ++t) mx = fmaxf(mx, fmaxf(fmaxf(sc[t].x, sc[t].y), fmaxf(sc[t].z, sc[t].w)));
    mx = fmaxf(mx, __shfl_xor(mx, 16)); mx = fmaxf(mx, __shfl_xor(mx, 32));
    float sum = 0.f;
#pragma unroll
    for (int t = 0; t < 16; ++t) {
#pragma unroll
        for (int e = 0; e < 4; ++e) { sc[t][e] = __builtin_amdgcn_exp2f(sc[t][e] - mx); sum += sc[t][e]; } }
    sum += __shfl_xor(sum, 16); sum += __shfl_xor(sum, 32);
    const float inv = 1.0f / sum;
    bf16x8 pf[8];
#pragma unroll
    for (int s = 0; s < 8; ++s) { v4u w; w.x = pk2(sc[2 * s].x, sc[2 * s].y); w.y = pk2(sc[2 * s].z, sc[2 * s].w); w.z = pk2(sc[2 * s + 1].x, sc[2 * s + 1].y); w.w = pk2(sc[2 * s + 1].z, sc[2 * s + 1].w);
        pf[s] = __builtin_bit_cast(bf16x8, w); }
#pragma unroll
    for (int dt = 0; dt < 8; ++dt) { f32x4 o = {0.f, 0.f, 0.f, 0.f};
#pragma unroll
        for (int s = 0; s < 8; ++s) { const LAS unsigned char* vp = Vtm + (16 * dt + r) * 528 + (32 * s + 4 * kq) * 2;
            const unsigned long long lo = *(const LAS unsigned long long*)vp, hi = *(const LAS unsigned long long*)(vp + 32);
            v4u w; w.x = (unsigned)lo; w.y = (unsigned)(lo >> 32); w.z = (unsigned)hi; w.w = (unsigned)(hi >> 32);
            o = __builtin_amdgcn_mfma_f32_16x16x32_bf16(__builtin_bit_cast(bf16x8, w), pf[s], o, 0, 0, 0); }
        o = o * inv;
        *(unsigned long long*)(XO + qrow * XW + hd * HD + 16 * dt + 4 * kq) = (unsigned long long)pk2(o.x, o.y) | ((unsigned long long)pk2(o.z, o.w) << 32); }
    __syncthreads();
}

struct Args { const float* in[27]; float* out; unsigned char* ws; int ph_lo, ph_hi; };
enum { I_X = 0, I_MEM, I_F1N, I_F1G, I_F1U, I_F1D, I_MIXN, I_WIN, I_CONVW, I_QKVW, I_ALOG, I_DTB, I_DNN, I_WOC, I_WOD, I_WO, I_XAN, I_MEMN, I_XWQ, I_XWK, I_XWV, I_XWO, I_F2N, I_F2G, I_F2U, I_F2D, I_FINN };

typedef const __attribute__((address_space(4))) Args* KArgs;
__device__ __forceinline__ KArgs kargs() { KArgs p = (KArgs)__builtin_amdgcn_kernarg_segment_ptr(); asm volatile("" : "+s"(p)); return p; }
#define PH_BEGIN KArgs A = kargs(); unsigned char* const ws = A->ws; (void)ws;
#define W1GU ((bf16*)(ws + WS_W1GU))
#define W1D ((bf16*)(ws + WS_W1D))
#define W2GU ((bf16*)(ws + WS_W2GU))
#define W2D ((bf16*)(ws + WS_W2D))
#define WIN ((bf16*)(ws + WS_WIN))
#define WA ((bf16*)(ws + WS_WA))
#define WB ((bf16*)(ws + WS_WB))
#define WO ((bf16*)(ws + WS_WO))
#define WQ ((bf16*)(ws + WS_WQ))
#define WKV ((bf16*)(ws + WS_WKV))
#define WXO ((bf16*)(ws + WS_WXO))
#define XN ((bf16*)(ws + WS_XN))
#define ACT ((bf16*)(ws + WS_R))
#define PROJ ((bf16*)(ws + WS_R))
#define MN ((bf16*)(ws + WS_MN))
#define KB ((bf16*)(ws + WS_KB))
#define VT ((bf16*)(ws + WS_VT))
#define OB ((bf16*)(ws + WS_O))
#define CONVA ((bf16*)(ws + WS_CONVA))
#define ON ((bf16*)(ws + WS_ON))
#define QP ((bf16*)(ws + WS_QP))
#define AB ((float*)(ws + WS_AB))
#define HB ((bf16*)(ws + WS_XNB))
#define SSQ(i) ((unsigned long long*)(ws + WS_SSQ) + (i) * M)
#define XO ((bf16*)(ws + WS_XO))
#define H (A->out)
#define INP(i) (A->in[i])
__global__ void __launch_bounds__(NTHREADS, 2) fwd_kernel(Args args) {
    extern __shared__ __attribute__((aligned(16))) unsigned char lds_raw[];
    LAS unsigned char* lds = (LAS unsigned char*)lds_raw;
    volatile LAS unsigned* MISC = (volatile LAS unsigned*)(lds + MISC_OFF);
    const int tid = threadIdx.x, lane = tid & 63, wave = __builtin_amdgcn_readfirstlane(tid >> 6);
    const int G = gridDim.x, bx = blockIdx.x;
    const int vcu = (G % 8 == 0) ? (bx % 8) * (G / 8) + bx / 8 : bx;
    const int gw = vcu * NWAVES + wave, NGW = G * NWAVES, gtid = vcu * NTHREADS + tid, NT = G * NTHREADS;
    gu32* ctl = (gu32*)(args.ws + WS_CTL);
    for (int u = tid; u < (LDS_BYTES - MISC_OFF) / 4; u += NTHREADS) ((LAS unsigned*)(lds + MISC_OFF))[u] = 0u;
    __syncthreads();
    XcdBarrier bar; bar.bar = (unsigned*)(ctl + CW_BAR); bar.x = 0; bar.st = nullptr;
    const int lo = args.ph_lo, hi = args.ph_hi;
    if (hi - lo > 1) bar = xcd_barrier_post((unsigned*)(ctl + CW_BAR), MISC + 8);
#define IN(k) (lo <= (k) && (k) < hi)
#define FUSED_FINAL ((G == 256) && (PROBE_PHASE != 13) && IN(13) && IN(14))
#define SEAM(k) do { if (IN(k) && IN((k) + 1)) xcd_barrier(bar); } while (0)
    if (IN(0)) for (int rep_ = 0; rep_ < (PROBE_PHASE == 0 ? PROBE_REPS : 1); ++rep_) { PH_BEGIN
        LAS float* scr = (LAS float*)(lds + wave * 16384); LAS int* tb = (LAS int*)(scr + TW_TABLE);
        constexpr int IW1D = (FF / 64) * (D / 32), IWIN = (D / 64) * (NPROJ / 32), IXW = (D / 64) * (XW / 32), IXO = (XW / 64) * (D / 32), IGU = (D / 64) * (FF / 32);
        constexpr int st[8] = {0, IW1D, IW1D + IWIN, IW1D + IWIN + IXW, IW1D + IWIN + 2 * IXW, IW1D + IWIN + 3 * IXW, IW1D + IWIN + 3 * IXW + IXO, IW1D + IWIN + 3 * IXW + IXO + IGU};
        tw_table_put(tb, 0, tw_job(INP(I_F1D), D, W1D, FF, 0, 0, nullptr, st[0]), lane);
        tw_table_put(tb, 1, tw_job(INP(I_WIN), NPROJ, WIN, D, 3, 0, INP(I_MIXN), st[1]), lane);
        tw_table_put(tb, 2, tw_job(INP(I_XWQ), XW, WQ, D, 0, 0, INP(I_XAN), st[2]), lane);
        tw_table_put(tb, 3, tw_job(INP(I_XWK), XW, WKV, D, 0, 0, nullptr, st[3]), lane);
        tw_table_put(tb, 4, tw_job(INP(I_XWV), XW, WKV, D, 0, XW, nullptr, st[4]), lane);
        tw_table_put(tb, 5, tw_job(INP(I_XWO), D, WXO, XW, 0, 0, nullptr, st[5]), lane);
        tw_table_put(tb, 6, tw_job(INP(I_F1G), FF, W1GU, D, 1, 0, nullptr, st[6]), lane);
        tw_table_put(tb, 7, tw_job(INP(I_F1U), FF, W1GU, D, 2, 0, nullptr, st[7]), lane);
        LDS_WAIT();
        conv_pipe<8>(tb, st, 0, st[7] + IGU, gw, NGW, scr, lane);
        rms_rows<false>(INP(I_X), INP(I_F1N), XN, M, gw, NGW, lane);
        rms_rows<false>(INP(I_MEM), INP(I_MEMN), MN, BATCH * MEMT, gw, NGW, lane);
    }
    SEAM(0);
    if (IN(1)) for (int rep_ = 0; rep_ < (PROBE_PHASE == 1 ? PROBE_REPS : 1); ++rep_) { PH_BEGIN
        pg8::Gemm g{XN, W1GU, M, 2 * FF, D, D, D}; pg8::OrderFfnKv S; S.init(M, 2 * FF, G, bx); S.A1 = MN; S.B1 = WKV;
        pg8::EpiSwiGLUKV E{{ACT, FF, nullptr, 0.f, 0.f}, {KB, VT}};
        pg8::gemm_phase<pg8::EpiSwiGLUKV, pg8::OrderFfnKv, true, true>(lds, g, S, E);
        const int rounds = (S.nwg + 16 + G - 1) / G, first_idle = S.nwg + 16 - (rounds - 1) * G;
        if (first_idle >= G || bx >= first_idle) { const bool part = first_idle < G;
            const int gw2 = part ? (bx - first_idle) * NWAVES + wave : gw, NGW2 = part ? (G - first_idle) * NWAVES : NGW;
            LAS float* scr = (LAS float*)(lds + wave * 16384); LAS int* tb = (LAS int*)(scr + TW_TABLE);
            constexpr int IA = (CW / 64) * (D / 32), IB = (DNW / 64) * (D / 32), IO = (D / 64) * (D / 32);
            constexpr int st[3] = {0, IA, IA + IB};
            tw_table_put(tb, 0, tw_job(INP(I_WOC), D, WA, CW, 0, 0, nullptr, st[0]), lane);
            tw_table_put(tb, 1, tw_job(INP(I_WOD), D, WB, DNW, 0, 0, nullptr, st[1]), lane);
            tw_table_put(tb, 2, tw_job(INP(I_WO), D, WO, D, 0, 0, nullptr, st[2]), lane);
            LDS_WAIT();
            conv_pipe<3>(tb, st, 0, IA + IB + IO, gw2, NGW2, scr, lane); }
        if (PROBE_PHASE == 1) __syncthreads();
    }
    SEAM(1);
    if (IN(2)) for (int rep_ = 0; rep_ < (PROBE_PHASE == 2 ? PROBE_REPS : 1); ++rep_) { PH_BEGIN const bool dummy_ = (PROBE_PHASE == 2) && rep_ + 1 < PROBE_REPS;
        pg8::Gemm g{ACT, W1D, M, D, FF, FF, FF}; pg8::StaticOrder S; S.init(M, D, G, bx);
        pg8::EpiResidBf<true> E{INP(I_X), dummy_ ? (pg8::bf16_t*)(ws + WS_DN) : HB, D, 0.5f, dummy_ ? (unsigned long long*)(ws + WS_DN + 128 * MiB) : SSQ(0)};
        pg8::gemm_phase<pg8::EpiResidBf<true>, pg8::StaticOrder, true, true>(lds, g, S, E);
    }
    SEAM(2);
    if (IN(3)) for (int rep_ = 0; rep_ < (PROBE_PHASE == 3 ? PROBE_REPS : 1); ++rep_) { PH_BEGIN
        pg8::Gemm g{HB, WIN, M, NPP, D, D, D}; pg8::StaticOrder S; S.init(M, NPP, G, bx);
        pg8::EpiStoreBf16 E{PROJ, NPP, SSQ(0), SSQ_INVK, EPS};
        pg8::gemm_phase<pg8::EpiStoreBf16, pg8::StaticOrder, true, true>(lds, g, S, E);
        for (int job = gw; job < (M / 16) * 4; job += NGW) ab_logits(HB, WIN + (size_t)NPP * D, AB, job, lane);
    }
    SEAM(3);
    if (IN(4)) for (int rep_ = 0; rep_ < (PROBE_PHASE == 4 ? PROBE_REPS : 1); ++rep_) { PH_BEGIN
        for (int pair = vcu; pair < BATCH * NH * NCH / 2; pair += G) dn_chunk_pair(PROJ, AB, SSQ(0), INP(I_QKVW), INP(I_ALOG), INP(I_DTB), ws, lds, pair, tid, INP(I_CONVW), CONVA);
    }
    SEAM(4);
    if (IN(5)) for (int rep_ = 0; rep_ < (PROBE_PHASE == 5 ? PROBE_REPS : 1); ++rep_) { PH_BEGIN for (int unit = vcu; unit < BATCH * NH * 4; unit += G) { SideJob J{INP(I_F2G), INP(I_F2U), INP(I_F2D), W2GU, W2D, INP(I_F2N), nullptr, unit * NWAVES + wave};     dn_scan_unit(ws, lds, OB, unit, tid, J); } }
    SEAM(5);
    if (IN(6)) for (int rep_ = 0; rep_ < (PROBE_PHASE == 6 ? PROBE_REPS : 1); ++rep_) { PH_BEGIN dn_gated_norm(OB, PROJ, INP(I_DNN), ON, gtid, NT); }
    SEAM(6);
    if (IN(7)) for (int rep_ = 0; rep_ < (PROBE_PHASE == 7 ? PROBE_REPS : 1); ++rep_) { PH_BEGIN
        pg8::Gemm g{CONVA, WA, M, D, CW, CW, CW}; pg8::OrderTwoPass S; S.init(M, D, G, bx); S.A1 = ON; S.B1 = WB;
        pg8::EpiGateFused E{XN, D, PROJ + OFF_GA, PROJ + OFF_GB, NPP};
        pg8::gemm_phase<pg8::EpiGateFused, pg8::OrderTwoPass, true, true>(lds, g, S, E);
    }
    SEAM(7);
    if (IN(8)) for (int rep_ = 0; rep_ < (PROBE_PHASE == 8 ? PROBE_REPS : 1); ++rep_) { PH_BEGIN const bool dummy_ = (PROBE_PHASE == 8) && rep_ + 1 < PROBE_REPS;
        pg8::Gemm g{XN, WO, M, D, D, D, D}; pg8::StaticOrder S; S.init(M, D, G, bx);
        pg8::EpiResidBf<false> E{HB, dummy_ ? (pg8::bf16_t*)(ws + WS_DN) : HB, D, 1.0f, dummy_ ? (unsigned long long*)(ws + WS_DN + 128 * MiB) : SSQ(1)};
        pg8::gemm_phase<pg8::EpiResidBf<false>, pg8::StaticOrder, true, true>(lds, g, S, E);
    }
    SEAM(8);
    if (IN(9)) for (int rep_ = 0; rep_ < (PROBE_PHASE == 9 ? PROBE_REPS : 1); ++rep_) { PH_BEGIN
        pg8::Gemm g{HB, WQ, M, XW, D / 4, D, D}; pg8::OrderSplitK4 S{G, bx, (D / 4) * 2};
        pg8::EpiPartBf16 E{QP, XW, (size_t)M * XW};
        pg8::gemm_phase<pg8::EpiPartBf16, pg8::OrderSplitK4, true, true>(lds, g, S, E);
    }
    SEAM(9);
    if (IN(10)) for (int rep_ = 0; rep_ < (PROBE_PHASE == 10 ? PROBE_REPS : 1); ++rep_) { PH_BEGIN for (int unit = vcu; unit < BATCH * 4 * (SEQ / 128); unit += G) xattn_unit(QP, SSQ(1), KB, VT, XO, lds, unit, tid); }
    SEAM(10);
    if (IN(11)) for (int rep_ = 0; rep_ < (PROBE_PHASE == 11 ? PROBE_REPS : 1); ++rep_) { PH_BEGIN const bool dummy_ = (PROBE_PHASE == 11) && rep_ + 1 < PROBE_REPS;
        pg8::Gemm g{XO, WXO, M, D, XW, XW, XW}; pg8::StaticOrder S; S.init(M, D, G, bx);
        pg8::EpiResidBf<false> E{HB, dummy_ ? (pg8::bf16_t*)(ws + WS_DN) : HB, D, 1.0f, dummy_ ? (unsigned long long*)(ws + WS_DN + 128 * MiB) : SSQ(2)};
        pg8::gemm_phase<pg8::EpiResidBf<false>, pg8::StaticOrder, true, true>(lds, g, S, E);
    }
    SEAM(11);
    if (IN(12)) for (int rep_ = 0; rep_ < (PROBE_PHASE == 12 ? PROBE_REPS : 1); ++rep_) { PH_BEGIN
        const int NCONV = (G == 256) ? 5 : 0, GG = G - NCONV;
        if (bx < GG) {
            pg8::Gemm g{HB, W2GU, M, 2 * FF, D, D, D}; pg8::StaticOrder S; S.init(M, 2 * FF, GG, bx);
            pg8::EpiSwiGLUrs E{ACT, FF, SSQ(2), SSQ_INVK, EPS};
            pg8::gemm_phase<pg8::EpiSwiGLUrs, pg8::StaticOrder, true, true>(lds, g, S, E);
        }
        if (bx >= GG || NCONV == 0) { LAS float* scr = (LAS float*)(lds + wave * 16384); LAS int* tb = (LAS int*)(scr + TW_TABLE);
            constexpr int st[3] = {0, SIDE_IG, 2 * SIDE_IG};
            tw_table_put(tb, 0, tw_job(INP(I_F2G), FF, W2GU, D, 1, 0, INP(I_F2N), st[0]), lane);
            tw_table_put(tb, 1, tw_job(INP(I_F2U), FF, W2GU, D, 2, 0, INP(I_F2N), st[1]), lane);
            tw_table_put(tb, 2, tw_job(INP(I_F2D), D, W2D, FF, 0, 0, nullptr, st[2]), lane);
            LDS_WAIT();
            conv_pipe<3>(tb, st, SIDE_ITEMS, 3 * SIDE_IG, NCONV ? (bx - GG) * NWAVES + wave : gw, NCONV ? NCONV * NWAVES : NGW, scr, lane);
        }
    }
    SEAM(12);
    if (IN(13)) for (int rep_ = 0; rep_ < (PROBE_PHASE == 13 ? PROBE_REPS : 1); ++rep_) { PH_BEGIN const bool dummy_ = (PROBE_PHASE == 13) && rep_ + 1 < PROBE_REPS;
        pg8::Gemm g{ACT, W2D, M, D, FF, FF, FF};
        if (FUSED_FINAL) {
            OrderPanel S; S.init(M, D, G, bx);
            EpiFinalNorm E{HB, H, D, 0.5f, SSQ(3), (unsigned*)(ctl + CW_PANEL), (unsigned*)(ctl + CW_BAR), INP(I_FINN)};
            pg8::gemm_phase<EpiFinalNorm, OrderPanel, true, true>(lds, g, S, E);
        } else {
            pg8::StaticOrder S; S.init(M, D, G, bx);
            pg8::EpiResidBf<false> E{HB, dummy_ ? (pg8::bf16_t*)(ws + WS_DN) : HB, D, 0.5f, dummy_ ? (unsigned long long*)(ws + WS_DN + 128 * MiB) : SSQ(3)};
            pg8::gemm_phase<pg8::EpiResidBf<false>, pg8::StaticOrder, true, true>(lds, g, S, E);
        }
    }
    if (!FUSED_FINAL) SEAM(13);
    if (IN(14) && !FUSED_FINAL) { PH_BEGIN final_norm(HB, SSQ(3), INP(I_FINN), H, gw, NGW, lane); }
#undef FUSED_FINAL
#undef IN
#undef SEAM
}

extern "C" void kernel_launch(void* const* d_in, const int* in_sizes, int n_in, void* d_out, int out_size, void* d_ws, size_t ws_size, hipStream_t stream) {
    static int grid = 0;
    if (grid == 0) {
        if (n_in != 27 || out_size != M * D || ws_size < WS_END) { fprintf(stderr, "kernel_launch: unexpected problem (n_in %d, out %d, ws %zu < %zu)\n", n_in, out_size, ws_size, (size_t)WS_END); grid = -1; return; }
        int dev = 0, cus = 0, per_cu = 0;
        if (hipGetDevice(&dev) != hipSuccess || hipDeviceGetAttribute(&cus, hipDeviceAttributeMultiprocessorCount, dev) != hipSuccess) { grid = -1; return; }
        if (hipFuncSetAttribute((const void*)fwd_kernel, hipFuncAttributeMaxDynamicSharedMemorySize, LDS_BYTES) != hipSuccess) { fprintf(stderr, "kernel_launch: hipFuncSetAttribute failed\n"); grid = -1; return; }
        if (hipOccupancyMaxActiveBlocksPerMultiprocessor(&per_cu, (const void*)fwd_kernel, NTHREADS, LDS_BYTES) != hipSuccess || per_cu < 1) { fprintf(stderr, "kernel_launch: occupancy query reports %d blocks per CU\n", per_cu); (void)hipGetLastError(); grid = -1; return; }
        grid = cus;
    }
    if (grid < 0) return;
    (void)hipMemsetAsync((char*)d_ws + WS_CTL, 0, CTL_ZERO_BYTES, stream);
    Args a{};
    for (int i = 0; i < 27; ++i) a.in[i] = (const float*)d_in[i];
    a.out = (float*)d_out; a.ws = (unsigned char*)d_ws;
#if MK_N_LAUNCHES == 1
    a.ph_lo = 0; a.ph_hi = NPH;
    hipLaunchKernelGGL(fwd_kernel, dim3(grid), dim3(NTHREADS), LDS_BYTES, stream, a);
#else
    for (int p = 0; p < NPH; ++p) { a.ph_lo = p; a.ph_hi = p + 1; hipLaunchKernelGGL(fwd_kernel, dim3(grid), dim3(NTHREADS), LDS_BYTES, stream, a); }
#endif
}
```
